# Optimizing an MI355X kernel written in HIP

```python
import jax
import jax.numpy as jnp
from jax import lax
import numpy as np

D_MODEL = 2048
BATCH = 1
SEQ = 16384
DEPTH = 4
DEC_BATCH = 8
DEC_SEQ = 4096
PAST_LEN = 128

D_FF = 5632
ALPHA = (2 * DEPTH) ** 0.25
BETA = (8 * DEPTH) ** -0.25
LN_EPS = 1e-5
POOL_WINDOWS = (2, 4, 8, 16)
POOL_GROUPS = 4
POOL_W = D_MODEL // 4
POOL_GC = POOL_W // POOL_GROUPS
ATT_DH = 128
ATT_HQ = (D_MODEL // 2) // ATT_DH
ATT_HKV = 2
ATT_GQ = ATT_HQ // ATT_HKV
ATT_WINDOW = 128
ATT_BLOCK = 128
ROPE_THETA = 10000.0
ATT_QW = ATT_HQ * ATT_DH
ATT_KVW = ATT_HKV * ATT_DH
RWKV_K = 64
RWKV_W = D_MODEL // 4
RWKV_H = RWKV_W // RWKV_K
DECAY_LORA = 64
AAA_LORA = 64
GATE_LORA = 128
GN_EPS = 64e-5
RWKV_COLS = 3 * RWKV_W + 2 * DECAY_LORA + 2 * AAA_LORA + GATE_LORA
N_BRANCH = 3
IN_COLS = POOL_W + ATT_QW + 2 * ATT_KVW + RWKV_COLS + N_BRANCH * D_MODEL
BRANCH_ROWS = POOL_W + ATT_QW + RWKV_W
MEM_LEN = 256
X_HEADS = 4
X_DH = 128
X_W = X_HEADS * X_DH

kernel_name = 'hybrid_bidir_encoder_pool_swa_rwkv7'


def layer_norm(x, g, b):
    xf = x.astype(jnp.float32)
    xc = xf - jnp.mean(xf, axis=-1, keepdims=True)
    var = jnp.mean(xc * xc, axis=-1, keepdims=True)
    return (xc * lax.rsqrt(var + LN_EPS) * g + b).astype(x.dtype)


def swiglu(x, w_in, w_out):
    gate, up = jnp.split(x @ w_in, 2, axis=-1)
    return (jax.nn.silu(gate) * up) @ w_out


def rope(t):
    s, dh = t.shape[1], t.shape[-1]
    half = dh // 2
    inv = ROPE_THETA ** (-jnp.arange(half, dtype=jnp.float32) / half)
    ang = jnp.arange(s, dtype=jnp.float32)[:, None] * inv[None, :]
    cos = jnp.cos(ang)[None, :, None, :]
    sin = jnp.sin(ang)[None, :, None, :]
    tf = t.astype(jnp.float32)
    t1, t2 = tf[..., :half], tf[..., half:]
    return jnp.concatenate([t1 * cos - t2 * sin, t2 * cos + t1 * sin], axis=-1).astype(t.dtype)


def pool_mixer(u, pool_w, pool_scale):
    n, s, _ = u.shape
    ug = u.astype(jnp.float32).reshape(n, s, POOL_GROUPS, POOL_GC)
    csum = jnp.pad(jnp.cumsum(ug, axis=1), ((0, 0), (1, 0), (0, 0), (0, 0)))
    t = jnp.arange(s)
    outs = []
    for g, win in enumerate(POOL_WINDOWS):
        lo = jnp.clip(t - win // 2, 0, s)
        hi = jnp.clip(t + win // 2, 0, s)
        cg = csum[:, :, g]
        mean = (cg[:, hi] - cg[:, lo]) / (hi - lo).astype(jnp.float32)[None, :, None]
        outs.append(mean - ug[:, :, g])
    d = jnp.stack(outs, axis=2).astype(u.dtype)
    y = jnp.einsum('nsgc,gce->nsge', d, pool_w).reshape(n, s, POOL_W)
    return y * pool_scale


def window_attention(q, k, v, sink):
    n, s = q.shape[:2]
    nb = s // ATT_BLOCK
    qb = q.reshape(n, nb, ATT_BLOCK, ATT_HKV, ATT_GQ, ATT_DH)

    def band(t):
        tp = jnp.pad(t, ((0, 0), (ATT_BLOCK, ATT_BLOCK), (0, 0), (0, 0)))
        tp = tp.reshape(n, nb + 2, ATT_BLOCK, ATT_HKV, ATT_DH)
        return jnp.concatenate([tp[:, :-2], tp[:, 1:-1], tp[:, 2:]], axis=2)

    kb, vb = band(k), band(v)
    sc = jnp.einsum('nbqhgd,nbkhd->nbhgqk', qb, kb, preferred_element_type=jnp.float32) * (ATT_DH ** -0.5)
    qpos = jnp.arange(nb)[:, None] * ATT_BLOCK + jnp.arange(ATT_BLOCK)[None, :]
    kpos = (jnp.arange(nb)[:, None] - 1) * ATT_BLOCK + jnp.arange(3 * ATT_BLOCK)[None, :]
    valid = ((jnp.abs(qpos[:, :, None] - kpos[:, None, :]) <= ATT_WINDOW)
             & (kpos[:, None, :] >= 0) & (kpos[:, None, :] < s))
    sc = jnp.where(valid[None, :, None, None], sc, -1e30)
    snk = sink.astype(jnp.float32).reshape(ATT_HKV, ATT_GQ)[None, None, :, :, None, None]
    m = jnp.maximum(jnp.max(sc, axis=-1, keepdims=True), snk)
    p = jnp.exp(sc - m)
    p = p / (jnp.sum(p, axis=-1, keepdims=True) + jnp.exp(snk - m))
    o = jnp.einsum('nbhgqk,nbkhd->nbqhgd', p.astype(v.dtype), vb)
    return o.reshape(n, s, ATT_QW)


def wkv_scan(r, w, k, v, kk, a):
    def step(state, inp):
        r_t, w_t, k_t, v_t, kk_t, a_t = inp
        sa = jnp.einsum('nehij,nehj->nehi', state, -kk_t)
        state = (state * w_t[..., None, :] + sa[..., None] * (kk_t * a_t)[..., None, :]
                 + v_t[..., None] * k_t[..., None, :])
        return state, jnp.einsum('nehij,nehj->nehi', state, r_t)

    xs = tuple(jnp.moveaxis(t, 1, 0) for t in (r, w, k, v, kk, a))
    s0 = jnp.zeros((r.shape[0], 2, RWKV_H, RWKV_K, RWKV_K), jnp.float32)
    _, ys = lax.scan(step, s0, xs)
    return jnp.moveaxis(ys, 0, 1)


def rwkv_mixer(u, mu, w0, w2, a0, a2, g2, k_k, k_a, r_k, gn_g, gn_b):
    n, s, _ = u.shape
    f = u.astype(jnp.float32)
    prev = jnp.pad(f, ((0, 0), (1, 0), (0, 0)))[:, :-1]
    nxt = jnp.pad(f, ((0, 0), (0, 1), (0, 0)))[:, 1:]
    xs = f + mu[0] * (prev - f) + mu[1] * (nxt - f)
    o3 = 3 * RWKV_W
    o4 = o3 + 2 * DECAY_LORA
    o5 = o4 + 2 * AAA_LORA
    r, k, v, wd, ad, gd = jnp.split(xs, [RWKV_W, 2 * RWKV_W, o3, o4, o5], axis=-1)
    wd = wd.reshape(n, s, 2, DECAY_LORA)
    ad = ad.reshape(n, s, 2, AAA_LORA)
    wlog = -jax.nn.softplus(-(w0 + jnp.einsum('nsel,elc->nsec', jnp.tanh(wd), w2))) - 0.5
    decay = jnp.exp(-jnp.exp(wlog))
    a = jax.nn.sigmoid(a0 + jnp.einsum('nsel,elc->nsec', ad, a2))
    g = jax.nn.sigmoid(gd) @ g2

    def heads(t):
        return t.reshape(t.shape[:-1] + (RWKV_H, RWKV_K))

    kk = heads(k * k_k)
    kk = kk / jnp.maximum(jnp.linalg.norm(kk, axis=-1, keepdims=True), 1e-12)
    kd = heads(k[:, :, None, :] * (1.0 + (a - 1.0) * k_a))
    rh, vh = heads(r), heads(v)

    def shared(t):
        return jnp.stack([t, t[:, ::-1]], axis=2)

    def per_dir(t):
        return jnp.stack([t[:, :, 0], t[:, ::-1, 1]], axis=2)

    ys = wkv_scan(shared(rh), per_dir(heads(decay)), per_dir(kd), shared(vh), shared(kk), per_dir(heads(a)))
    y = ys[:, :, 0] + ys[:, ::-1, 1]
    yc = y - jnp.mean(y, axis=-1, keepdims=True)
    y = yc * lax.rsqrt(jnp.mean(yc * yc, axis=-1, keepdims=True) + GN_EPS)
    y = y.reshape(n, s, RWKV_W) * gn_g + gn_b
    bonus = jnp.sum(jnp.sum(rh[:, :, None] * kd * r_k, axis=-1, keepdims=True) * vh[:, :, None], axis=2)
    return ((y + bonus.reshape(n, s, RWKV_W)) * g).astype(u.dtype)


def mixer_block(x, w_in, pool_w, pool_scale, attn_sink, rwkv_mu, rwkv_w0, rwkv_w2, rwkv_a0, rwkv_a2,
                rwkv_g2, rwkv_k_k, rwkv_k_a, rwkv_r_k, rwkv_gn_g, rwkv_gn_b, w_branch, w_out):
    n, s, _ = x.shape
    c1 = POOL_W
    c2 = c1 + ATT_QW
    c3 = c2 + ATT_KVW
    c4 = c3 + ATT_KVW
    c5 = c4 + RWKV_COLS
    u_pool, q, k, v, u_rwkv, gate_logits = jnp.split(x @ w_in, [c1, c2, c3, c4, c5], axis=-1)
    q = rope(q.reshape(n, s, ATT_HQ, ATT_DH))
    k = rope(k.reshape(n, s, ATT_HKV, ATT_DH))
    v = v.reshape(n, s, ATT_HKV, ATT_DH)
    o_pool = pool_mixer(u_pool, pool_w, pool_scale)
    o_att = window_attention(q, k, v, attn_sink)
    o_rwkv = rwkv_mixer(u_rwkv, rwkv_mu, rwkv_w0, rwkv_w2, rwkv_a0, rwkv_a2, rwkv_g2,
                        rwkv_k_k, rwkv_k_a, rwkv_r_k, rwkv_gn_g, rwkv_gn_b)
    b1 = POOL_W
    b2 = b1 + ATT_QW
    gates = jax.nn.sigmoid(gate_logits).reshape(n, s, N_BRANCH, D_MODEL)
    merged = (gates[:, :, 0] * (o_pool @ w_branch[:b1])
              + gates[:, :, 1] * (o_att @ w_branch[b1:b2])
              + gates[:, :, 2] * (o_rwkv @ w_branch[b2:]))
    return merged @ w_out


def cross_attention(x, mem, wq, wkv, wo):
    n, s, _ = x.shape
    q = (x @ wq).reshape(n, s, X_HEADS, X_DH)
    k, v = jnp.split(mem @ wkv, 2, axis=-1)
    k = k.reshape(n, -1, X_HEADS, X_DH)
    v = v.reshape(n, -1, X_HEADS, X_DH)
    sc = jnp.einsum('nshd,nmhd->nhsm', q, k, preferred_element_type=jnp.float32) * (X_DH ** -0.5)
    p = jax.nn.softmax(sc, axis=-1).astype(v.dtype)
    o = jnp.einsum('nhsm,nmhd->nshd', p, v).reshape(n, s, X_W)
    return o @ wo


def setup_inputs(seed: int = 0) -> dict:
    key = jax.random.key(seed)
    ks = jax.random.split(key, 32)
    f32 = jnp.float32
    L, D = DEPTH, D_MODEL

    def nrm(k, shape, scale):
        return jax.random.normal(k, shape, f32) * scale

    w_branch = jnp.concatenate([
        nrm(ks[23], (L, POOL_W, D), POOL_W ** -0.5),
        nrm(ks[24], (L, ATT_QW, D), ATT_QW ** -0.5),
        nrm(ks[25], (L, RWKV_W, D), RWKV_W ** -0.5)], axis=1)
    return {
        'x_prompt': nrm(ks[0], (BATCH, SEQ, D), 1.0),
        'x_sample': nrm(ks[1], (DEC_BATCH, DEC_SEQ, D), 1.0),
        'mem_prompt': nrm(ks[2], (BATCH, MEM_LEN, D), 1.0),
        'mem_sample': nrm(ks[3], (DEC_BATCH, MEM_LEN, D), 1.0),
        'ln_g': 1.0 + nrm(ks[4], (L, 4, D), 0.02),
        'ln_b': nrm(ks[5], (L, 4, D), 0.02),
        'ffn_w_in': nrm(ks[6], (L, 2, D, 2 * D_FF), D ** -0.5),
        'ffn_w_out': nrm(ks[7], (L, 2, D_FF, D), D_FF ** -0.5 * BETA),
        'w_in': nrm(ks[8], (L, D, IN_COLS), D ** -0.5),
        'pool_w': nrm(ks[9], (L, POOL_GROUPS, POOL_GC, POOL_GC), POOL_GC ** -0.5),
        'pool_scale': 1.0 + nrm(ks[10], (L, POOL_W), 0.1),
        'attn_sink': nrm(ks[11], (L, ATT_HQ), 0.5),
        'rwkv_mu': jax.random.uniform(ks[12], (L, 2, RWKV_COLS), f32, 0.0, 0.5),
        'rwkv_w0': jax.random.uniform(ks[13], (L, 2, RWKV_W), f32, -6.0, 1.0),
        'rwkv_w2': nrm(ks[14], (L, 2, DECAY_LORA, RWKV_W), 0.1 * DECAY_LORA ** -0.5),
        'rwkv_a0': nrm(ks[15], (L, 2, RWKV_W), 0.5),
        'rwkv_a2': nrm(ks[16], (L, 2, AAA_LORA, RWKV_W), AAA_LORA ** -0.5),
        'rwkv_g2': nrm(ks[17], (L, GATE_LORA, RWKV_W), GATE_LORA ** -0.5),
        'rwkv_k_k': 0.85 + nrm(ks[18], (L, RWKV_W), 0.05),
        'rwkv_k_a': 1.0 + nrm(ks[19], (L, RWKV_W), 0.05),
        'rwkv_r_k': nrm(ks[20], (L, RWKV_H, RWKV_K), 0.1),
        'rwkv_gn_g': 1.0 + nrm(ks[21], (L, RWKV_W), 0.02),
        'rwkv_gn_b': nrm(ks[22], (L, RWKV_W), 0.02),
        'w_branch': w_branch,
        'w_out': nrm(ks[26], (L, D, D), D ** -0.5 * BETA),
        'xattn_wq': nrm(ks[27], (L, D, X_W), D ** -0.5),
        'xattn_wkv': nrm(ks[28], (L, D, 2 * X_W), D ** -0.5),
        'xattn_wo': nrm(ks[29], (L, X_W, D), X_W ** -0.5 * BETA),
    }


def reference(x_prompt, x_sample, mem_prompt, mem_sample, ln_g, ln_b, ffn_w_in, ffn_w_out, w_in,
              pool_w, pool_scale, attn_sink, rwkv_mu, rwkv_w0, rwkv_w2, rwkv_a0, rwkv_a2, rwkv_g2,
              rwkv_k_k, rwkv_k_a, rwkv_r_k, rwkv_gn_g, rwkv_gn_b, w_branch, w_out,
              xattn_wq, xattn_wkv, xattn_wo):
    def trunk(x, mem):
        for l in range(DEPTH):
            x = layer_norm(ALPHA * x + 0.5 * swiglu(x, ffn_w_in[l, 0], ffn_w_out[l, 0]), ln_g[l, 0], ln_b[l, 0])
            mix = mixer_block(x, w_in[l], pool_w[l], pool_scale[l], attn_sink[l], rwkv_mu[l], rwkv_w0[l],
                              rwkv_w2[l], rwkv_a0[l], rwkv_a2[l], rwkv_g2[l], rwkv_k_k[l], rwkv_k_a[l],
                              rwkv_r_k[l], rwkv_gn_g[l], rwkv_gn_b[l], w_branch[l], w_out[l])
            x = layer_norm(ALPHA * x + mix, ln_g[l, 1], ln_b[l, 1])
            xa = cross_attention(x, mem, xattn_wq[l], xattn_wkv[l], xattn_wo[l])
            x = layer_norm(ALPHA * x + xa, ln_g[l, 2], ln_b[l, 2])
            x = layer_norm(ALPHA * x + 0.5 * swiglu(x, ffn_w_in[l, 1], ffn_w_out[l, 1]), ln_g[l, 3], ln_b[l, 3])
        return x

    y_prompt = trunk(x_prompt, mem_prompt)
    y_sample = trunk(x_sample, mem_sample)
    return (y_prompt, y_sample)
```

```cpp
#include <hip/hip_runtime.h>
#include <cstdio>
#include <cstdint>
#include <cmath>
constexpr int D = 2048, DFF = 5632, DEPTH = 4;
constexpr int SEQP = 16384, SEQS = 4096, NSAMP = 8, NSEQ = 9;
constexpr int MTOK = SEQP + NSAMP * SEQS;
constexpr int MEML = 256, MMEM = NSEQ * MEML;
constexpr int INC = 10112, NWIN = 10240;
constexpr int RWC = 1920;
constexpr float ALPHA = 1.681792830507429f;
constexpr float LN_EPS = 1e-5f, GN_EPS = 64e-5f;
constexpr int CH = 128;
constexpr int NCP = MTOK / CH;
constexpr float LOG2E = 1.4426950408889634f;
constexpr float ATT_C1 = 0.08838834764831845f * 1.4426950408889634f;

constexpr size_t MiB = 1u << 20;
constexpr size_t WS_CTL = 0, CTL_ZERO_BYTES = 1 * MiB;
constexpr size_t WS_CS = 1 * MiB;
constexpr size_t WS_MEMB = 9 * MiB;
constexpr size_t WS_W1T = 18 * MiB;
constexpr size_t WS_W2T = 106 * MiB;
constexpr size_t WS_WINT = 150 * MiB;
constexpr size_t WS_WBR0 = 190 * MiB;
constexpr size_t WS_WBR1 = 192 * MiB;
constexpr size_t WS_WBR2 = 196 * MiB;
constexpr size_t WS_WOUT = 198 * MiB;
constexpr size_t WS_WQ = 206 * MiB;
constexpr size_t WS_WKV = 208 * MiB;
constexpr size_t WS_WO = 212 * MiB;
constexpr size_t WS_BL = 214 * MiB;
constexpr size_t WS_XB = 216 * MiB;
constexpr size_t WS_RA = 408 * MiB;
constexpr size_t WS_Q = WS_RA;
constexpr size_t WS_K = WS_RA + 96 * MiB;
constexpr size_t WS_VT = WS_RA + 120 * MiB;
constexpr size_t WS_UPOOL = WS_RA + 144 * MiB;
constexpr size_t WS_URWKV = WS_RA + 192 * MiB;
constexpr size_t WS_GATES = WS_RA + 576 * MiB;
constexpr size_t WS_PM = WS_RA;
constexpr size_t WS_QM = WS_RA + 96 * MiB;
constexpr size_t WS_Y = WS_RA + 192 * MiB;
constexpr size_t WS_Z = WS_RA + 384 * MiB;
constexpr size_t WS_H = WS_RA;
constexpr size_t WS_QX = WS_RA;
constexpr size_t WS_KX = WS_RA + 48 * MiB;
constexpr size_t WS_VXT = WS_RA + 51 * MiB;
constexpr size_t WS_OX = WS_RA + 54 * MiB;
constexpr size_t WS_OPOOL = 1560 * MiB;
constexpr size_t WS_OATT = 1608 * MiB;
constexpr size_t WS_ORWKV = 1704 * MiB;
constexpr size_t WS_SH = 1752 * MiB;
constexpr size_t WS_MERGED = WS_SH;
constexpr size_t WS_DIR = 2040 * MiB;
constexpr size_t WS_KBUF = 2616 * MiB;
constexpr size_t WS_SST = WS_KBUF;
constexpr size_t WS_G = 2712 * MiB;
constexpr size_t WS_AL = 2760 * MiB;
constexpr size_t WS_END = 2796 * MiB;
static_assert(WS_GATES + 576 * MiB == WS_OPOOL, "region A");

typedef unsigned short bf16;
namespace pg8 {
#define PG8_LAS __attribute__((address_space(3)))
typedef unsigned short bf16_t;
typedef short bf16x8 __attribute__((ext_vector_type(8)));
typedef float f32x4 __attribute__((ext_vector_type(4)));
typedef unsigned u32x4 __attribute__((ext_vector_type(4)));
constexpr int BM = 256, BK = 64, HALF = 128, HTB = HALF * BK * 2  , STAGE_BYTES = 8 * HTB, NXCD = 8, WGM = 8;

__host__ __device__ __forceinline__ int lds_byte(int r, int c) { const int st = (r >> 4) * 2 + (c >> 5), rr = r & 15, cc = c & 31, ob = rr * 64 + cc * 2; return st * 1024 + (ob ^ (((ob >> 9) & 1) << 5)); }
__host__ __device__ __forceinline__ void stage_rc(int b, int& R, int& C) { const int st = b / 1024, sb = b % 1024, swz = sb ^ (((sb >> 9) & 1) << 5); R = (st >> 1) * 16 + swz / 64; C = (st & 1) * 32 + (swz % 64) / 2; }
__host__ __device__ __forceinline__ int perm32(int rho) { const int n = rho >> 4, i = rho & 15; return 8 * (i >> 2) + 4 * n + (i & 3); }

struct Unit { int pm, pn; };
struct Gemm { const bf16_t* A; const bf16_t* Bt; int M, N, K; };

struct StaticOrder {
    int nM, nN, nwg, G, c;
    __host__ __device__ void init(int M, int N, int G_, int c_) { nM = M / BM; nN = N / BM; nwg = nM * nN; G = G_; c = c_; }
    __host__ __device__ bool next(int i, Unit& u) const {
        const long L = (long)i * G + c; if (L >= nwg) return false;
        int wgid = (int)L; { const int q = nwg / NXCD, r = nwg % NXCD, xcd = wgid % NXCD, off = wgid / NXCD; wgid = (xcd < r ? xcd * (q + 1) : r * (q + 1) + (xcd - r) * q) + off; }
        const int nig = WGM * nN, gid = wgid / nig, fm = gid * WGM, gsz = (nM - fm) < WGM ? (nM - fm) : WGM;
        u.pm = fm + ((wgid % nig) % gsz); u.pn = (wgid % nig) / gsz; return true;
    }
    __device__ __forceinline__ void a_ready(const Unit&) const {}
    __device__ __forceinline__ void done(const Unit&) const {}
};

__device__ __forceinline__ unsigned cvt_pk_bf16(float lo, float hi) { unsigned r; asm volatile("v_cvt_pk_bf16_f32 %0, %1, %2" : "=v"(r) : "v"(lo), "v"(hi)); return r; }
typedef float f32x2 __attribute__((ext_vector_type(2)));
typedef unsigned u32x2 __attribute__((ext_vector_type(2)));
__device__ __forceinline__ int lane_now() { int l; asm volatile("v_mbcnt_lo_u32_b32 %0, -1, 0\n\tv_mbcnt_hi_u32_b32 %0, -1, %0" : "=v"(l)); return l; }
__device__ __forceinline__ float sigm(float x) { return __builtin_amdgcn_rcpf(1.f + __builtin_amdgcn_exp2f(-x * LOG2E)); }
__device__ __forceinline__ float bf_lo(unsigned w) { return __uint_as_float(w << 16); }
__device__ __forceinline__ float bf_hi(unsigned w) { return __uint_as_float(w & 0xffff0000u); }

struct EpiSwiglu {
    static constexpr bool PERM = true, AFTER_DRAIN = false;
    bf16_t* H;
    __device__ __forceinline__ void operator()(const f32x4 (&acc)[2][2][4][2], const Unit& u, int wr, int wc, int, int) const {
        const int ln_ = lane_now(), fr = ln_ & 15, fq = ln_ >> 4;
        const int row0 = u.pm * BM + wr * 64 + fr, col0 = u.pn * 128 + wc * 32 + 8 * fq;
#pragma unroll
        for (int ai = 0; ai < 2; ++ai)
#pragma unroll
            for (int m = 0; m < 4; ++m) {
                bf16_t* rowp = H + (size_t)(row0 + ai * HALF + m * 16) * DFF + col0;
                float o[8];
#pragma unroll
                for (int n = 0; n < 2; ++n)
#pragma unroll
                    for (int e = 0; e < 4; ++e) { const float g = acc[ai][0][m][n][e], up = acc[ai][1][m][n][e]; o[4 * n + e] = g * sigm(g) * up; }
                u32x4 w; w.x = cvt_pk_bf16(o[0], o[1]); w.y = cvt_pk_bf16(o[2], o[3]); w.z = cvt_pk_bf16(o[4], o[5]); w.w = cvt_pk_bf16(o[6], o[7]);
                *(u32x4*)rowp = w;
            }
    }
};
struct EpiResid {
    static constexpr bool PERM = false, AFTER_DRAIN = false;
    float* X; float alpha, scale;
    __device__ __forceinline__ void operator()(const f32x4 (&acc)[2][2][4][2], const Unit& u, int wr, int wc, int, int) const {
        const int ln_ = lane_now(), fr = ln_ & 15, fq = ln_ >> 4;
        const int row0 = u.pm * BM + wr * 64 + fr, col0 = u.pn * BM + wc * 32 + 4 * fq;
#pragma unroll
        for (int ai = 0; ai < 2; ++ai)
#pragma unroll
            for (int m = 0; m < 4; ++m) {
                float* rowp = X + (size_t)(row0 + ai * HALF + m * 16) * D + col0;
#pragma unroll
                for (int bj = 0; bj < 2; ++bj)
#pragma unroll
                    for (int n = 0; n < 2; ++n) { f32x4* p = (f32x4*)(rowp + bj * HALF + n * 16); const f32x4 x = *p; *p = x * alpha + acc[ai][bj][m][n] * scale; }
                asm volatile("" ::: "memory");
            }
    }
};
struct EpiPlain {
    static constexpr bool PERM = true, AFTER_DRAIN = false;
    bf16_t* O; int ldc;
    __device__ __forceinline__ void operator()(const f32x4 (&acc)[2][2][4][2], const Unit& u, int wr, int wc, int, int) const {
        const int ln_ = lane_now(), fr = ln_ & 15, fq = ln_ >> 4;
        const int row0 = u.pm * BM + wr * 64 + fr, col0 = u.pn * BM + wc * 32 + 8 * fq;
#pragma unroll
        for (int ai = 0; ai < 2; ++ai)
#pragma unroll
            for (int m = 0; m < 4; ++m) {
                bf16_t* rowp = O + (size_t)(row0 + ai * HALF + m * 16) * ldc + col0;
#pragma unroll
                for (int bj = 0; bj < 2; ++bj) { const f32x4 v0 = acc[ai][bj][m][0], v1 = acc[ai][bj][m][1];
                    u32x4 w; w.x = cvt_pk_bf16(v0[0], v0[1]); w.y = cvt_pk_bf16(v0[2], v0[3]); w.z = cvt_pk_bf16(v1[0], v1[1]); w.w = cvt_pk_bf16(v1[2], v1[3]);
                    *(u32x4*)(rowp + bj * HALF) = w; }
            }
    }
};
struct EpiWin {
    static constexpr bool PERM = true, AFTER_DRAIN = false;
    bf16_t *UP, *Q, *K, *GT; float* UR; const float* CS;
    __device__ __forceinline__ void operator()(const f32x4 (&acc)[2][2][4][2], const Unit& u, int wr, int wc, int, int) const {
        const int ln_ = lane_now(), fr = ln_ & 15, fq = ln_ >> 4;
        const int pn = u.pn, row0 = u.pm * BM + wr * 64 + fr, c8 = wc * 32 + 8 * fq;
        if (pn == 7) return;
#pragma unroll
        for (int ai = 0; ai < 2; ++ai)
#pragma unroll
            for (int m = 0; m < 4; ++m) {
                const int row = row0 + ai * HALF + m * 16;
                if (pn >= 2 && pn < 7) {
                    const int pos = row < SEQP ? row : (row & (SEQS - 1));
                    const f32x4* csp = (const f32x4*)(CS + ((size_t)pos * 64 + 4 * (4 * wc + fq)) * 2);
                    const f32x4 c01 = csp[0], c23 = csp[1];
                    const float cs_[4] = {c01[0], c01[2], c23[0], c23[2]}, sn_[4] = {c01[1], c01[3], c23[1], c23[3]};
#pragma unroll
                    for (int bj = 0; bj < 2; ++bj) {
                        const f32x4 t1 = acc[ai][bj][m][0], t2 = acc[ai][bj][m][1]; float o1[4], o2[4];
#pragma unroll
                        for (int e = 0; e < 4; ++e) { o1[e] = t1[e] * cs_[e] - t2[e] * sn_[e]; o2[e] = t2[e] * cs_[e] + t1[e] * sn_[e]; }
                        u32x4 w; w.x = cvt_pk_bf16(o1[0], o1[1]); w.y = cvt_pk_bf16(o1[2], o1[3]); w.z = cvt_pk_bf16(o2[0], o2[1]); w.w = cvt_pk_bf16(o2[2], o2[3]);
                        bf16_t* dst = (pn == 6) ? K + (size_t)row * 256 + bj * 128 + c8 : Q + (size_t)row * 1024 + ((pn - 2) * 2 + bj) * 128 + c8;
                        *(u32x4*)dst = w;
                    }
                } else if (pn >= 8 && pn < 16) {
#pragma unroll
                    for (int bj = 0; bj < 2; ++bj) { float* p = UR + (size_t)row * 2048 + (pn - 8) * 256 + bj * 128 + c8; *(f32x4*)p = acc[ai][bj][m][0]; *(f32x4*)(p + 4) = acc[ai][bj][m][1]; }
                } else {
#pragma unroll
                    for (int bj = 0; bj < 2; ++bj) {
                        f32x4 v0 = acc[ai][bj][m][0], v1 = acc[ai][bj][m][1]; bf16_t* dst;
                        if (pn < 2) dst = UP + (size_t)row * 512 + pn * 256 + bj * 128 + c8;
                        else { dst = GT + (size_t)row * 6144 + (pn - 16) * 256 + bj * 128 + c8;
#pragma unroll
                            for (int e = 0; e < 4; ++e) { v0[e] = sigm(v0[e]); v1[e] = sigm(v1[e]); } }
                        u32x4 w; w.x = cvt_pk_bf16(v0[0], v0[1]); w.y = cvt_pk_bf16(v0[2], v0[3]); w.z = cvt_pk_bf16(v1[0], v1[1]); w.w = cvt_pk_bf16(v1[2], v1[3]);
                        *(u32x4*)dst = w;
                    }
                }
                asm volatile("" ::: "memory");
            }
    }
};
struct EpiBranch {
    static constexpr bool PERM = true, AFTER_DRAIN = false;
    bf16_t* MG; const bf16_t* GT; int first;
    __device__ __forceinline__ void operator()(const f32x4 (&acc)[2][2][4][2], const Unit& u, int wr, int wc, int, int) const {
        const int ln_ = lane_now(), fr = ln_ & 15, fq = ln_ >> 4;
        const int row0 = u.pm * BM + wr * 64 + fr, col0 = u.pn * BM + wc * 32 + 8 * fq;
#pragma unroll
        for (int ai = 0; ai < 2; ++ai)
#pragma unroll
            for (int m = 0; m < 4; ++m) {
                const int row = row0 + ai * HALF + m * 16;
#pragma unroll
                for (int bj = 0; bj < 2; ++bj) {
                    const int col = col0 + bj * HALF;
                    const u32x4 gw = *(const u32x4*)(GT + (size_t)row * 6144 + col);
                    u32x4* mp = (u32x4*)(MG + (size_t)row * D + col);
                    u32x4 mw = {0u, 0u, 0u, 0u}; if (!first) mw = *mp;
                    const f32x4 v0 = acc[ai][bj][m][0], v1 = acc[ai][bj][m][1];
                    u32x4 w;
                    w.x = cvt_pk_bf16(bf_lo(mw.x) + bf_lo(gw.x) * v0[0], bf_hi(mw.x) + bf_hi(gw.x) * v0[1]);
                    w.y = cvt_pk_bf16(bf_lo(mw.y) + bf_lo(gw.y) * v0[2], bf_hi(mw.y) + bf_hi(gw.y) * v0[3]);
                    w.z = cvt_pk_bf16(bf_lo(mw.z) + bf_lo(gw.z) * v1[0], bf_hi(mw.z) + bf_hi(gw.z) * v1[1]);
                    w.w = cvt_pk_bf16(bf_lo(mw.w) + bf_lo(gw.w) * v1[2], bf_hi(mw.w) + bf_hi(gw.w) * v1[3]);
                    *mp = w;
                }
            }
    }
};
struct EpiLora {
    static constexpr bool PERM = false, AFTER_DRAIN = false;
    const float *w0, *a0, *k_a; const float* SH; const float* KB; float* DIR; bf16_t* G;
    __device__ __forceinline__ void operator()(const f32x4 (&acc)[2][2][4][2], const Unit& u, int wr, int wc, int, int) const {
        const int ln_ = lane_now(), fr = ln_ & 15, fq = ln_ >> 4;
        const int pn = u.pn, row0 = u.pm * BM + wr * 64 + fr, cq = wc * 32 + 4 * fq;
        const int ed = (pn >> 1) & 1;
#pragma unroll
        for (int ai = 0; ai < 2; ++ai)
#pragma unroll
            for (int m = 0; m < 4; ++m) {
                const int row = row0 + ai * HALF + m * 16;
#pragma unroll
                for (int bj = 0; bj < 2; ++bj)
#pragma unroll
                    for (int n = 0; n < 2; ++n) {
                        const int c = pn * BM + bj * HALF + cq + 16 * n; const f32x4 v = acc[ai][bj][m][n];
                        const int ch = c & 511, hh = ch >> 6, j = ch & 63;
                        float* dp = DIR + (((size_t)row * 2 + ed) * 8 + hh) * 192 + j;
                        if (pn < 4) {
                            const f32x4 b = *(const f32x4*)(w0 + ed * 512 + ch); f32x4 o;
#pragma unroll
                            for (int e = 0; e < 4; ++e) { const float x = -(b[e] + v[e]);
                                const float sp = fmaxf(x, 0.f) + 0.6931471805599453f * __builtin_amdgcn_logf(1.f + __builtin_amdgcn_exp2f(-fabsf(x) * LOG2E));
                                o[e] = __builtin_amdgcn_exp2f(-LOG2E * __builtin_amdgcn_exp2f((-sp - 0.5f) * LOG2E)); }
                            *(f32x4*)dp = o;
                        } else if (pn < 8) {
                            const f32x4 b = *(const f32x4*)(a0 + ed * 512 + ch), ka = *(const f32x4*)(k_a + ch);
                            const f32x4 nk = *(const f32x4*)(SH + ((size_t)row * 8 + hh) * 192 + j), kk_ = *(const f32x4*)(KB + (size_t)row * 512 + ch);
                            f32x4 o1, o2;
#pragma unroll
                            for (int e = 0; e < 4; ++e) { const float a = sigm(b[e] + v[e]); o1[e] = -nk[e] * a; o2[e] = kk_[e] * (1.f + (a - 1.f) * ka[e]); }
                            *(f32x4*)(dp + 64) = o1; *(f32x4*)(dp + 128) = o2;
                        } else {
                            u32x2 w; w.x = cvt_pk_bf16(v[0], v[1]); w.y = cvt_pk_bf16(v[2], v[3]);
                            *(u32x2*)(G + (size_t)row * 512 + (c - 2048)) = w;
                        }
                        asm volatile("" ::: "memory");
                    }
            }
    }
};
template <class Epi, class Sched, bool ALIGN_EPI = false, bool SP2 = false>
__device__ __forceinline__ void gemm_phase(PG8_LAS unsigned char* lds, const Gemm g, const Sched& S, const Epi& E, int wid_in) {
    int lane_o; asm volatile("v_mbcnt_lo_u32_b32 %0, -1, 0\n\tv_mbcnt_hi_u32_b32 %0, -1, %0" : "=v"(lane_o));
    const int wid = wid_in, lane = lane_o, tid = wid * 64 + lane, wr = wid >> 2, wc = wid & 3, fr = lane & 15, fq = lane >> 4;
    const int K = g.K, nt = K / BK;
    unsigned voffA[2], voffB[2];
#pragma unroll
    for (int i = 0; i < 2; ++i) { int R, C; stage_rc(tid * 16 + i * 8192, R, C); const int Rb = Epi::PERM ? ((R & ~31) + perm32(R & 31)) : R;
        voffA[i] = (unsigned)(R * K + C) * 2u; voffB[i] = (unsigned)(Rb * K + C) * 2u; }
    const size_t kstep = (size_t)(BK * 2);
    const size_t hstep = (size_t)HALF * K * 2;
    const size_t tstep = 2 * hstep;
    const unsigned ldsw = (unsigned)wid * 1024u;
    const int aoff = lds_byte(wr * 64 + fr, fq * 8), boff = lds_byte(wc * 32 + fr, fq * 8);
#define PG8_SA(b, h) (((b) * 2 + (h)) * HTB)
#define PG8_SB(b, h) ((4 + (b) * 2 + (h)) * HTB)
#define PG8_STAGE(bufoff, gbase, voff) do { _Pragma("unroll") for (int _i = 0; _i < 2; ++_i) \
        __builtin_amdgcn_global_load_lds((const unsigned*)((const char*)(gbase) + (voff)[_i]), (PG8_LAS unsigned*)(lds + (bufoff) + ldsw + _i * 8192), 16, 0, 0); } while (0)
#define PG8_LDA(dst, b, h) do { _Pragma("unroll") for (int m = 0; m < 4; ++m) _Pragma("unroll") for (int k = 0; k < 2; ++k) dst[m][k] = *(const PG8_LAS bf16x8*)(lds + PG8_SA(b, h) + aoff + m * 2048 + k * 1024); } while (0)
#define PG8_LDB(dst, b, h) do { _Pragma("unroll") for (int n = 0; n < 2; ++n) _Pragma("unroll") for (int k = 0; k < 2; ++k) dst[n][k] = *(const PG8_LAS bf16x8*)(lds + PG8_SB(b, h) + boff + n * 2048 + k * 1024); } while (0)
#define PG8_MMA(ai, bj, At, Bt) do { __builtin_amdgcn_s_setprio(1); _Pragma("unroll") for (int m = 0; m < 4; ++m) _Pragma("unroll") for (int n = 0; n < 2; ++n) _Pragma("unroll") for (int k = 0; k < 2; ++k) \
        acc[ai][bj][m][n] = __builtin_amdgcn_mfma_f32_16x16x32_bf16(Bt[n][k], At[m][k], acc[ai][bj][m][n], 0, 0, 0); __builtin_amdgcn_s_setprio(0); } while (0)
#define PG8_WAIT_V(n) asm volatile("s_waitcnt vmcnt(" #n ")" ::: "memory")
#define PG8_WAIT_L(n) asm volatile("s_waitcnt lgkmcnt(" #n ")" ::: "memory")
#define PG8_BAR __builtin_amdgcn_s_barrier()
#define PG8_SCHED __builtin_amdgcn_sched_barrier(0)
    Unit cur, nxt; int ui = 0;
    if (!S.next(0, cur)) return;
    f32x4 acc[2][2][4][2];
#pragma unroll
    for (int a = 0; a < 2; ++a)
#pragma unroll
        for (int b = 0; b < 2; ++b)
#pragma unroll
            for (int m = 0; m < 4; ++m)
#pragma unroll
                for (int n = 0; n < 2; ++n) acc[a][b][m][n] = (f32x4){0.f, 0.f, 0.f, 0.f};
    bf16x8 At[4][2], B0[2][2], B1[2][2];
    const char* cA = (const char*)g.A + (size_t)cur.pm * tstep; const char* cB = (const char*)g.Bt + (size_t)cur.pn * tstep;
    S.a_ready(cur);
    if constexpr (SP2) {
        PG8_STAGE(PG8_SB(0, 0), cB, voffB); PG8_STAGE(PG8_SB(0, 1), cB + hstep, voffB); PG8_STAGE(PG8_SA(0, 0), cA, voffA); PG8_STAGE(PG8_SA(0, 1), cA + hstep, voffA);
        if (wr == 1) PG8_BAR;
        PG8_WAIT_V(2); PG8_BAR;
        PG8_STAGE(PG8_SB(1, 0), cB + kstep, voffB); PG8_STAGE(PG8_SA(1, 0), cA + kstep, voffA); PG8_STAGE(PG8_SB(1, 1), cB + hstep + kstep, voffB);
        PG8_WAIT_V(6); PG8_BAR;
    } else {
        PG8_STAGE(PG8_SB(0, 0), cB, voffB); PG8_STAGE(PG8_SA(0, 0), cA, voffA); PG8_STAGE(PG8_SB(0, 1), cB + hstep, voffB); PG8_STAGE(PG8_SA(0, 1), cA + hstep, voffA);
        if (wr == 1) PG8_BAR;
        PG8_WAIT_V(4); PG8_BAR;
        PG8_STAGE(PG8_SB(1, 0), cB + kstep, voffB); PG8_STAGE(PG8_SA(1, 0), cA + kstep, voffA); PG8_STAGE(PG8_SB(1, 1), cB + hstep + kstep, voffB);
        PG8_WAIT_V(6); PG8_BAR;
    }
    for (;;) {
        const bool has_next = S.next(ui + 1, nxt);
        const char* nA = has_next ? (const char*)g.A + (size_t)nxt.pm * tstep : cA; const char* nB = has_next ? (const char*)g.Bt + (size_t)nxt.pn * tstep : cB;
        for (int t = 0; t < nt; t += 2) {
            const bool last = (t == nt - 2);
            const char* a1 = cA + (size_t)(t + 1) * kstep;
            const char* a2 = last ? nA : cA + (size_t)(t + 2) * kstep; const char* b2 = last ? nB : cB + (size_t)(t + 2) * kstep;
            const char* a3 = a2 + kstep; const char* b3 = b2 + kstep;
            if (last && has_next) S.a_ready(nxt);
            if constexpr (SP2) {
            PG8_LDB(B0, 0, 0); PG8_LDB(B1, 0, 1); PG8_SCHED; PG8_LDA(At, 0, 0); PG8_STAGE(PG8_SA(1, 1), a1 + hstep, voffA);
            PG8_WAIT_V(8); PG8_WAIT_L(0); PG8_BAR; PG8_MMA(0, 0, At, B0); PG8_MMA(0, 1, At, B1); PG8_BAR; PG8_SCHED;
            PG8_LDA(At, 0, 1); PG8_STAGE(PG8_SB(0, 0), b2, voffB); PG8_STAGE(PG8_SB(0, 1), b2 + hstep, voffB); PG8_STAGE(PG8_SA(0, 0), a2, voffA);
            PG8_WAIT_V(8); PG8_WAIT_L(0); PG8_BAR; PG8_MMA(1, 0, At, B0); PG8_MMA(1, 1, At, B1); PG8_BAR; PG8_SCHED;
            PG8_LDB(B0, 1, 0); PG8_LDB(B1, 1, 1); PG8_SCHED; PG8_LDA(At, 1, 0); PG8_STAGE(PG8_SA(0, 1), a2 + hstep, voffA);
            PG8_WAIT_V(8); PG8_WAIT_L(0); PG8_BAR; PG8_MMA(0, 0, At, B0); PG8_MMA(0, 1, At, B1); PG8_BAR; PG8_SCHED;
            PG8_LDA(At, 1, 1); PG8_STAGE(PG8_SB(1, 0), b3, voffB); PG8_STAGE(PG8_SB(1, 1), b3 + hstep, voffB); PG8_STAGE(PG8_SA(1, 0), a3, voffA);
            PG8_WAIT_V(8); PG8_WAIT_L(0); PG8_BAR; PG8_MMA(1, 0, At, B0); PG8_MMA(1, 1, At, B1); PG8_BAR; PG8_SCHED;
            } else {
            PG8_LDB(B0, 0, 0); PG8_SCHED; PG8_LDA(At, 0, 0); PG8_STAGE(PG8_SA(1, 1), a1 + hstep, voffA);
            PG8_WAIT_L(8); PG8_BAR; PG8_WAIT_L(0); PG8_MMA(0, 0, At, B0); PG8_BAR; PG8_SCHED;
            PG8_LDB(B1, 0, 1); PG8_STAGE(PG8_SB(0, 0), b2, voffB);
            PG8_BAR; PG8_WAIT_L(0); PG8_MMA(0, 1, At, B1); PG8_BAR;
            PG8_LDA(At, 0, 1); PG8_STAGE(PG8_SA(0, 0), a2, voffA);
            PG8_BAR; PG8_WAIT_L(0); PG8_MMA(1, 0, At, B0); PG8_BAR; PG8_SCHED;
            PG8_STAGE(PG8_SB(0, 1), b2 + hstep, voffB);
            PG8_WAIT_V(6); PG8_BAR; PG8_MMA(1, 1, At, B1); PG8_BAR;
            PG8_LDB(B0, 1, 0); PG8_SCHED; PG8_LDA(At, 1, 0); PG8_STAGE(PG8_SA(0, 1), a2 + hstep, voffA);
            PG8_WAIT_L(8); PG8_BAR; PG8_WAIT_L(0); PG8_MMA(0, 0, At, B0); PG8_BAR; PG8_SCHED;
            PG8_LDB(B1, 1, 1); PG8_STAGE(PG8_SB(1, 0), b3, voffB);
            PG8_BAR; PG8_WAIT_L(0); PG8_MMA(0, 1, At, B1); PG8_BAR;
            PG8_LDA(At, 1, 1); PG8_STAGE(PG8_SA(1, 0), a3, voffA);
            PG8_BAR; PG8_WAIT_L(0); PG8_MMA(1, 0, At, B0); PG8_BAR; PG8_SCHED;
            PG8_STAGE(PG8_SB(1, 1), b3 + hstep, voffB);
            PG8_WAIT_V(6); PG8_BAR; PG8_MMA(1, 1, At, B1); PG8_BAR;
            }
        }
        if constexpr (ALIGN_EPI) { if (wr == 0) PG8_BAR; }
        if constexpr (!Epi::AFTER_DRAIN) { E(acc, cur, wr, wc, fr, fq); S.done(cur); }
        if (!has_next) break;
#pragma unroll
        for (int a = 0; a < 2; ++a)
#pragma unroll
            for (int b = 0; b < 2; ++b)
#pragma unroll
                for (int m = 0; m < 4; ++m)
#pragma unroll
                    for (int n = 0; n < 2; ++n) acc[a][b][m][n] = (f32x4){0.f, 0.f, 0.f, 0.f};
        cur = nxt; cA = nA; cB = nB; ++ui;
        if constexpr (ALIGN_EPI) { if (wr == 1) PG8_BAR; }
    }
    PG8_WAIT_V(0);
    if constexpr (!ALIGN_EPI) { if (wr == 0) PG8_BAR; }
    PG8_BAR;
    if constexpr (Epi::AFTER_DRAIN) { E.fused(acc, cur, wr, wc, fr, fq, lds, wid, lane); S.done(cur); }
#undef PG8_SA
#undef PG8_SB
#undef PG8_STAGE
#undef PG8_LDA
#undef PG8_LDB
#undef PG8_MMA
#undef PG8_WAIT_V
#undef PG8_WAIT_L
#undef PG8_BAR
#undef PG8_SCHED
}
}

constexpr int NWAVES = 8;
constexpr int RING_OFF = 0, RING_BYTES = 131072;
constexpr int LDSCTL_OFF = RING_BYTES, MISC_OFF = LDSCTL_OFF + 320;
constexpr int LDS_BYTES = 147456;

#define LAS __attribute__((address_space(3)))
typedef unsigned u32x2 __attribute__((ext_vector_type(2)));
typedef unsigned u32x4 __attribute__((ext_vector_type(4)));
typedef float f32x2 __attribute__((ext_vector_type(2)));
typedef float f32x4 __attribute__((ext_vector_type(4)));
typedef short bf16x8 __attribute__((ext_vector_type(8)));
#define LDS_WAIT() asm volatile("s_waitcnt lgkmcnt(0)" ::: "memory")
#define VM_WAIT() asm volatile("s_waitcnt vmcnt(0)" ::: "memory")
__device__ __forceinline__ unsigned pk2(float lo, float hi) { return pg8::cvt_pk_bf16(lo, hi); }
__device__ __forceinline__ float bflo(unsigned w) { return __uint_as_float(w << 16); }
__device__ __forceinline__ float bfhi(unsigned w) { return __uint_as_float(w & 0xffff0000u); }
__device__ __forceinline__ float wave_sum(float v) {
#pragma unroll
    for (int o = 1; o < 64; o <<= 1) v += __shfl_xor(v, o);
    return v;
}
__device__ __forceinline__ int hw_lane() { int l; asm volatile("v_mbcnt_lo_u32_b32 %0, -1, 0\n\tv_mbcnt_hi_u32_b32 %0, -1, %0" : "=v"(l)); return l; }
__device__ __forceinline__ int row_pos(int row) { return row < SEQP ? row : (row & (SEQS - 1)); }
__device__ __forceinline__ int row_slen(int row) { return row < SEQP ? SEQP : SEQS; }

__device__ const float INV_FREQ[64] = {
    1.000000000e+00f, 8.659643531e-01f, 7.498942018e-01f, 6.493816376e-01f,
    5.623413324e-01f, 4.869675338e-01f, 4.216965139e-01f, 3.651741147e-01f,
    3.162277639e-01f, 2.738419771e-01f, 2.371373773e-01f, 2.053525001e-01f,
    1.778279394e-01f, 1.539926529e-01f, 1.333521456e-01f, 1.154781953e-01f,
    1.000000015e-01f, 8.659642935e-02f, 7.498942316e-02f, 6.493816525e-02f,
    5.623413250e-02f, 4.869675264e-02f, 4.216964915e-02f, 3.651741147e-02f,
    3.162277490e-02f, 2.738419548e-02f, 2.371373773e-02f, 2.053525113e-02f,
    1.778279431e-02f, 1.539926510e-02f, 1.333521400e-02f, 1.154781971e-02f,
    9.999999776e-03f, 8.659643121e-03f, 7.498942316e-03f, 6.493816152e-03f,
    5.623413250e-03f, 4.869675264e-03f, 4.216964822e-03f, 3.651741194e-03f,
    3.162277630e-03f, 2.738419687e-03f, 2.371373819e-03f, 2.053525066e-03f,
    1.778279431e-03f, 1.539926510e-03f, 1.333521446e-03f, 1.154782018e-03f,
    1.000000047e-03f, 8.659643354e-04f, 7.498941850e-04f, 6.493816036e-04f,
    5.623413017e-04f, 4.869675322e-04f, 4.216965172e-04f, 3.651741135e-04f,
    3.162277571e-04f, 2.738419571e-04f, 2.371373703e-04f, 2.053525095e-04f,
    1.778279402e-04f, 1.539926598e-04f, 1.333521504e-04f, 1.154782003e-04f
};

#define XB_TMO      128
#define XB_XCNT(j)  (256  + 64 * (j))
#define XB_XSUB(j)  (1280 + 64 * (j))
#define XB_XGEN(j)  (2304 + 64 * (j))
#define XB_TOP      3328
#define XB_TOPGEN   3392
#define XCD_BAR_WORDS 3456
#define XB_SPIN_CAP (1u << 18)
__device__ __forceinline__ unsigned xb_ld(unsigned* p)              { return __hip_atomic_load(p, __ATOMIC_RELAXED, __HIP_MEMORY_SCOPE_AGENT); }
__device__ __forceinline__ unsigned xb_add(unsigned* p, unsigned v) { return __hip_atomic_fetch_add(p, v, __ATOMIC_RELAXED, __HIP_MEMORY_SCOPE_AGENT); }
__device__ __forceinline__ unsigned xb_xcc_id() { return (unsigned)__builtin_amdgcn_s_getreg((3 << 11) | 20) & 0xFu; }
#define XB_SPIN(cond, bar) do { unsigned _sp = 0; while (cond) { __builtin_amdgcn_s_sleep(1); \
    if ((++_sp & 255u) == 0u) { if (xb_ld(&(bar)[XB_TMO])) break; if (_sp > XB_SPIN_CAP) { atomicAdd(&(bar)[XB_TMO], 1u); break; } } } } while (0)
struct XcdBarrier { unsigned* bar; unsigned x; volatile LAS unsigned* st; unsigned wv; };
__device__ __forceinline__ bool xb_thread0(unsigned wv) { return wv == 0u && hw_lane() == 0; }
__device__ __forceinline__ XcdBarrier xcd_barrier_post(unsigned* bar, volatile LAS unsigned* st, unsigned wv) {
    XcdBarrier b; b.bar = bar; b.x = xb_xcc_id(); b.st = st; b.wv = wv;
    if (xb_thread0(wv)) (void)xb_add(&bar[XB_XCNT(b.x)], 1u);
    return b;
}
__device__ __forceinline__ void xcd_barrier_complete(unsigned* bar, unsigned x, unsigned& nloc, unsigned& nx) {
    const unsigned G = gridDim.x * gridDim.y * gridDim.z;
    unsigned sum, cnt, mine, sp = 0u;
    for (;;) {
        sum = 0u; cnt = 0u; mine = 0u;
#pragma unroll
        for (unsigned j = 0; j < 16; ++j) { const unsigned c = xb_ld(&bar[XB_XCNT(j)]); sum += c; cnt += (c > 0u) ? 1u : 0u; mine = (j == x) ? c : mine; }
        if (sum == G) break;
        __builtin_amdgcn_s_sleep(1);
        if ((++sp & 255u) == 0u) { if (xb_ld(&bar[XB_TMO])) break; if (sp > XB_SPIN_CAP) { atomicAdd(&bar[XB_TMO], 1u); break; } }
    }
    nloc = mine > 0u ? mine : 1u; nx = cnt > 0u ? cnt : 1u;
}
__device__ __forceinline__ void xcd_barrier(const XcdBarrier& b) {
    asm volatile("s_waitcnt vmcnt(0)" ::: "memory");
    __syncthreads();
    if (xb_thread0(b.wv)) {
        unsigned* bar = b.bar;
        __builtin_amdgcn_s_waitcnt(0);
        unsigned nloc = b.st[0], nx = b.st[1];
        if (nloc == 0u) { xcd_barrier_complete(bar, b.x, nloc, nx); b.st[0] = nloc; b.st[1] = nx; }
        const unsigned old = xb_add(&bar[XB_XSUB(b.x)], 1u);
        const unsigned gen = old / nloc;
        if (old + 1u == (gen + 1u) * nloc) {
            __builtin_amdgcn_fence(__ATOMIC_RELEASE, "agent");
            asm volatile("s_waitcnt vmcnt(0)" ::: "memory");
            const unsigned og = xb_add(&bar[XB_TOP], 1u);
            const unsigned tg = og / nx;
            if (og + 1u == (tg + 1u) * nx) xb_add(&bar[XB_TOPGEN], 1u);
            else XB_SPIN(xb_ld(&bar[XB_TOPGEN]) == tg, bar);
            __builtin_amdgcn_fence(__ATOMIC_ACQUIRE, "agent");
            xb_add(&bar[XB_XGEN(b.x)], 1u);
            asm volatile("s_waitcnt vmcnt(0)" ::: "memory");
        } else {
            XB_SPIN(xb_ld(&bar[XB_XGEN(b.x)]) == gen, bar);
            __builtin_amdgcn_fence(__ATOMIC_ACQUIRE, "agent");
            asm volatile("s_waitcnt vmcnt(0)" ::: "memory");
        }
    }
    __syncthreads();
}

struct Args {
    const float* in[28]; float* out; unsigned char* ws;
    int it_lo, it_hi, ph_lo, ph_hi;
    int single, pad;
};
typedef const __attribute__((address_space(4))) Args* KArgs;
enum { I_XP = 0, I_XS, I_MP, I_MS, I_LNG, I_LNB, I_FWI, I_FWO, I_WIN, I_POOLW, I_POOLS, I_SINK, I_MU, I_W0, I_W2, I_A0, I_A2, I_G2, I_KK, I_KA, I_RK, I_GNG, I_GNB, I_WBR, I_WOUT, I_XWQ, I_XWKV, I_XWO };

__device__ __forceinline__ int map_row(int kind, int n) {
    if (kind == 1) { const int up = n >= DFF ? 1 : 0; const int j = up ? n - DFF : n; return (j >> 7) * 256 + (up << 7) + (j & 127); }
    if (kind == 2) {
        if (n >= 512 && n < 1792) { const int d = n & 127; return (n & ~127) + 8 * ((d & 63) >> 2) + (d & 3) + 4 * (d >> 6); }
        return n >= 3968 ? n + 128 : n;
    }
    return n;
}
__device__ __forceinline__ void transpose_item(const float* W, int K, int N, bf16* WT, int kind, LAS float* scr, int item, int lane) {
    const int nblk = N / 32, kb = item / nblk, nb = item % nblk, k0 = 64 * kb, n0 = 32 * nb;
#pragma unroll 8
    for (int i = 0; i < 32; ++i) { const int kk = 2 * i + (lane >> 5); scr[kk * 33 + (lane & 31)] = W[(size_t)(k0 + kk) * N + n0 + (lane & 31)]; }
    LDS_WAIT(); asm volatile("" ::: "memory");
    const int c = lane & 7;
#pragma unroll
    for (int j = 0; j < 4; ++j) { const int n = (lane >> 3) + 8 * j; const LAS float* s = scr + (8 * c) * 33 + n;
        u32x4 o; o.x = pk2(s[0 * 33], s[1 * 33]); o.y = pk2(s[2 * 33], s[3 * 33]); o.z = pk2(s[4 * 33], s[5 * 33]); o.w = pk2(s[6 * 33], s[7 * 33]);
        *(u32x4*)(WT + (size_t)map_row(kind, n0 + n) * K + k0 + 8 * c) = o; }
    LDS_WAIT(); asm volatile("" ::: "memory");
}

__device__ __forceinline__ void conv_phase(KArgs a, int L, LAS unsigned char* lds, int gw, int NGW, int wave, int lane, int gtid, int NT) {
    unsigned char* ws = a->ws;
    LAS float* scr = (LAS float*)(lds + RING_OFF + wave * 16384);
    constexpr int N_W1 = 32 * 352, N_W2 = 88 * 64, N_WI = 32 * 316, N_B1 = 16 * 64, N_B2 = 8 * 64, N_OU = 32 * 64, N_Q = 32 * 16, N_KV = 32 * 32, N_O = 8 * 64;
    constexpr int NITEMS = 2 * N_W1 + 2 * N_W2 + N_WI + N_B1 + N_B2 + N_OU + N_Q + N_KV + N_O;
    const float* fwi = a->in[I_FWI] + (size_t)L * 2 * D * 2 * DFF;
    const float* fwo = a->in[I_FWO] + (size_t)L * 2 * DFF * D;
    const float* wbr = a->in[I_WBR] + (size_t)L * D * D;
    for (int it = gw; it < NITEMS; it += NGW) {
        int r = it;
        if (r < N_W1) { transpose_item(fwi, D, 2 * DFF, (bf16*)(ws + WS_W1T), 1, scr, r, lane); continue; } r -= N_W1;
        if (r < N_W1) { transpose_item(fwi + (size_t)D * 2 * DFF, D, 2 * DFF, (bf16*)(ws + WS_W1T) + (size_t)2 * DFF * D, 1, scr, r, lane); continue; } r -= N_W1;
        if (r < N_W2) { transpose_item(fwo, DFF, D, (bf16*)(ws + WS_W2T), 0, scr, r, lane); continue; } r -= N_W2;
        if (r < N_W2) { transpose_item(fwo + (size_t)DFF * D, DFF, D, (bf16*)(ws + WS_W2T) + (size_t)D * DFF, 0, scr, r, lane); continue; } r -= N_W2;
        if (r < N_WI) { transpose_item(a->in[I_WIN] + (size_t)L * D * INC, D, INC, (bf16*)(ws + WS_WINT), 2, scr, r, lane); continue; } r -= N_WI;
        if (r < N_B1) { transpose_item(wbr + (size_t)512 * D, 1024, D, (bf16*)(ws + WS_WBR1), 0, scr, r, lane); continue; } r -= N_B1;
        if (r < N_B2) { transpose_item(wbr + (size_t)1536 * D, 512, D, (bf16*)(ws + WS_WBR2), 0, scr, r, lane); continue; } r -= N_B2;
        if (r < N_OU) { transpose_item(a->in[I_WOUT] + (size_t)L * D * D, D, D, (bf16*)(ws + WS_WOUT), 0, scr, r, lane); continue; } r -= N_OU;
        if (r < N_Q) { transpose_item(a->in[I_XWQ] + (size_t)L * D * 512, D, 512, (bf16*)(ws + WS_WQ), 0, scr, r, lane); continue; } r -= N_Q;
        if (r < N_KV) { transpose_item(a->in[I_XWKV] + (size_t)L * D * 1024, D, 1024, (bf16*)(ws + WS_WKV), 0, scr, r, lane); continue; } r -= N_KV;
        transpose_item(a->in[I_XWO] + (size_t)L * 512 * D, 512, D, (bf16*)(ws + WS_WO), 0, scr, r, lane);
    }
    {
        const float* pw = a->in[I_POOLW] + (size_t)L * 4 * 128 * 128; const float* ps = a->in[I_POOLS] + (size_t)L * 512;
        bf16* dst = (bf16*)(ws + WS_WBR0);
        for (int id = gtid; id < 2048 * 64; id += NT) {
            const int n = id & 2047, kg = id >> 11, g = kg >> 4, c0 = (8 * kg) & 127;
            float acc[8];
#pragma unroll
            for (int i = 0; i < 8; ++i) acc[i] = 0.f;
            const float* pwr = pw + ((size_t)g * 128 + c0) * 128;
            for (int e = 0; e < 128; ++e) {
                const float wb = wbr[(size_t)(g * 128 + e) * D + n] * ps[g * 128 + e];
#pragma unroll
                for (int i = 0; i < 8; ++i) acc[i] += pwr[i * 128 + e] * wb;
            }
            u32x4 o; o.x = pk2(acc[0], acc[1]); o.y = pk2(acc[2], acc[3]); o.z = pk2(acc[4], acc[5]); o.w = pk2(acc[6], acc[7]);
            *(u32x4*)(dst + (size_t)n * 512 + 8 * kg) = o;
        }
    }
    {
        const float* w2 = a->in[I_W2] + (size_t)L * 2 * 64 * 512; const float* a2 = a->in[I_A2] + (size_t)L * 2 * 64 * 512; const float* g2 = a->in[I_G2] + (size_t)L * 128 * 512;
        bf16* dst = (bf16*)(ws + WS_BL);
        for (int id = gtid; id < 2560 * 48; id += NT) {
            const int n = id / 48, k0 = 8 * (id % 48);
            float v[8];
#pragma unroll
            for (int i = 0; i < 8; ++i) {
                const int k = k0 + i; float x = 0.f;
                if (n < 512) { if (k < 64) x = w2[(size_t)k * 512 + n]; }
                else if (n < 1024) { if (k >= 64 && k < 128) x = w2[(size_t)(64 + k - 64) * 512 + (n - 512)]; }
                else if (n < 1536) { if (k >= 128 && k < 192) x = a2[(size_t)(k - 128) * 512 + (n - 1024)]; }
                else if (n < 2048) { if (k >= 192 && k < 256) x = a2[(size_t)(64 + k - 192) * 512 + (n - 1536)]; }
                else { if (k >= 256) x = g2[(size_t)(k - 256) * 512 + (n - 2048)]; }
                v[i] = x;
            }
            u32x4 o; o.x = pk2(v[0], v[1]); o.y = pk2(v[2], v[3]); o.z = pk2(v[4], v[5]); o.w = pk2(v[6], v[7]);
            *(u32x4*)(dst + (size_t)n * 384 + k0) = o;
        }
    }
    { u32x4* p = (u32x4*)((bf16*)(ws + WS_WINT) + (size_t)3968 * D); for (int id = gtid; id < 128 * D / 8; id += NT) p[id] = (u32x4){0u, 0u, 0u, 0u}; }
}

__device__ __forceinline__ void prologue_phase(KArgs a, int gtid, int NT) {
    unsigned char* ws = a->ws;
    { f32x2* cs = (f32x2*)(ws + WS_CS);
      for (int id = gtid; id < SEQP * 64; id += NT) { const int t = id >> 6, j = id & 63; const float ang = (float)t * INV_FREQ[j]; float s, c; sincosf(ang, &s, &c); cs[id] = (f32x2){c, s}; } }
    { bf16* mb = (bf16*)(ws + WS_MEMB);
      for (int id = gtid; id < MMEM * D / 4; id += NT) { const int row = id / (D / 4), c4 = id % (D / 4);
          const float* src = row < MEML ? a->in[I_MP] + (size_t)row * D : a->in[I_MS] + (size_t)(row - MEML) * D;
          const f32x4 v = *(const f32x4*)(src + 4 * c4); u32x2 o; o.x = pk2(v[0], v[1]); o.y = pk2(v[2], v[3]); *(u32x2*)(mb + (size_t)row * D + 4 * c4) = o; } }
    { bf16* xb = (bf16*)(ws + WS_XB);
      for (int id = gtid; id < MTOK * (D / 4); id += NT) { const int row = id / (D / 4), c4 = id % (D / 4);
          const float* src = row < SEQP ? a->in[I_XP] + (size_t)row * D : a->in[I_XS] + (size_t)(row - SEQP) * D;
          const f32x4 v = *(const f32x4*)(src + 4 * c4); *(f32x4*)(a->out + (size_t)row * D + 4 * c4) = v;
          u32x2 o; o.x = pk2(v[0], v[1]); o.y = pk2(v[2], v[3]); *(u32x2*)(xb + (size_t)row * D + 4 * c4) = o; } }
}

__device__ __forceinline__ void ln_phase(float* x, bf16* xb, const float* g, const float* b, int gw, int NGW, int lane) {
    for (int m = gw; m < MTOK; m += NGW) {
        f32x4* xr = (f32x4*)(x + (size_t)m * D) + lane;
        f32x4 v[8]; float s = 0.f;
#pragma unroll
        for (int j = 0; j < 8; ++j) { v[j] = xr[64 * j]; s += (v[j][0] + v[j][1]) + (v[j][2] + v[j][3]); }
        const float mean = wave_sum(s) * (1.f / D); float s2 = 0.f;
#pragma unroll
        for (int j = 0; j < 8; ++j) { v[j] = v[j] - mean; s2 += (v[j][0] * v[j][0] + v[j][1] * v[j][1]) + (v[j][2] * v[j][2] + v[j][3] * v[j][3]); }
        const float rstd = 1.f / sqrtf(wave_sum(s2) * (1.f / D) + LN_EPS);
        u32x2* o8 = (u32x2*)(xb + (size_t)m * D) + lane;
#pragma unroll
        for (int j = 0; j < 8; ++j) { const f32x4 gg = *((const f32x4*)g + lane + 64 * j), bb = *((const f32x4*)b + lane + 64 * j);
            const f32x4 o = v[j] * rstd * gg + bb; xr[64 * j] = o; u32x2 w; w.x = pk2(o[0], o[1]); w.y = pk2(o[2], o[3]); o8[64 * j] = w; }
    }
}

__device__ __forceinline__ void pool_phase(const bf16* UP, bf16* OP, int gw, int NGW, int lane) {
    const int g = lane >> 4, half = 1 << g;
    for (int row = gw; row < MTOK; row += NGW) {
        const int pos = row_pos(row), S = row_slen(row), lo = max(pos - half, 0), hi = min(pos + half, S);
        const bf16* base = UP + (size_t)(row - pos) * 512 + 8 * lane;
        float sum[8];
#pragma unroll
        for (int i = 0; i < 8; ++i) sum[i] = 0.f;
        for (int s = lo; s < hi; ++s) { const u32x4 w = *(const u32x4*)(base + (size_t)s * 512);
            sum[0] += bflo(w.x); sum[1] += bfhi(w.x); sum[2] += bflo(w.y); sum[3] += bfhi(w.y); sum[4] += bflo(w.z); sum[5] += bfhi(w.z); sum[6] += bflo(w.w); sum[7] += bfhi(w.w); }
        const u32x4 w = *(const u32x4*)(base + (size_t)pos * 512); const float inv = 1.f / (float)(hi - lo);
        u32x4 o; o.x = pk2(sum[0] * inv - bflo(w.x), sum[1] * inv - bfhi(w.x)); o.y = pk2(sum[2] * inv - bflo(w.y), sum[3] * inv - bfhi(w.y));
        o.z = pk2(sum[4] * inv - bflo(w.z), sum[5] * inv - bfhi(w.z)); o.w = pk2(sum[6] * inv - bflo(w.w), sum[7] * inv - bfhi(w.w));
        *(u32x4*)(OP + (size_t)row * 512 + 8 * lane) = o;
    }
}

template <bool WINDOW>
__device__ __forceinline__ void attn_task(const bf16* Qp, int ldq, const bf16* Kp, int ldk, const bf16* VTp, int ldvt, bf16* Op, int ldo, int nkb, int qrel0, float m0, float l0, int lane_in) {
    int lane = lane_in; asm volatile("" : "+v"(lane));
    int lr = lane & 15, quad = lane >> 4;
    bf16x8 qf[2][4];
#pragma unroll
    for (int G = 0; G < 2; ++G)
#pragma unroll
        for (int ds = 0; ds < 4; ++ds) qf[G][ds] = *(const bf16x8*)(Qp + (unsigned)((16 * G + lr) * ldq + 32 * ds + 8 * quad));
    f32x4 oacc[2][8];
#pragma unroll
    for (int G = 0; G < 2; ++G)
#pragma unroll
        for (int dt = 0; dt < 8; ++dt) oacc[G][dt] = (f32x4){0.f, 0.f, 0.f, 0.f};
    float mrun[2] = {m0, m0}, lrun[2] = {l0, l0};
    for (int kb = 0; kb < nkb; ++kb) {
        asm volatile("" : "+v"(lr), "+v"(quad));
        const bf16* Kb = Kp + (size_t)(128 * kb) * ldk;
        f32x4 sacc[2][8];
#pragma unroll
        for (int T = 0; T < 8; ++T) {
            bf16x8 kf[4];
#pragma unroll
            for (int ds = 0; ds < 4; ++ds) kf[ds] = *(const bf16x8*)(Kb + (unsigned)((16 * T + lr) * ldk + 32 * ds + 8 * quad));
#pragma unroll
            for (int G = 0; G < 2; ++G) { f32x4 c = (f32x4){0.f, 0.f, 0.f, 0.f};
#pragma unroll
                for (int ds = 0; ds < 4; ++ds) c = __builtin_amdgcn_mfma_f32_16x16x32_bf16(kf[ds], qf[G][ds], c, 0, 0, 0);
                sacc[G][T] = c; }
            asm volatile("" ::: "memory");
        }
#pragma unroll
        for (int G = 0; G < 2; ++G) {
            float mx = -3.0e38f;
#pragma unroll
            for (int T = 0; T < 8; ++T)
#pragma unroll
                for (int r = 0; r < 4; ++r) { float t = sacc[G][T][r] * ATT_C1;
                    if (WINDOW) { const int dd = (qrel0 + 16 * G + lr) - (128 * kb + 16 * T + 4 * quad + r); if (dd > 128 || dd < -128) t = -1.0e30f; }
                    sacc[G][T][r] = t; mx = fmaxf(mx, t); }
            mx = fmaxf(mx, __shfl_xor(mx, 16)); mx = fmaxf(mx, __shfl_xor(mx, 32));
            const float mnew = fmaxf(mrun[G], mx), alpha = __builtin_amdgcn_exp2f(mrun[G] - mnew); mrun[G] = mnew;
            float sum = 0.f;
#pragma unroll
            for (int T = 0; T < 8; ++T)
#pragma unroll
                for (int r = 0; r < 4; ++r) { const float p = __builtin_amdgcn_exp2f(sacc[G][T][r] - mnew); sacc[G][T][r] = p; sum += p; }
            sum += __shfl_xor(sum, 16); sum += __shfl_xor(sum, 32);
            lrun[G] = lrun[G] * alpha + sum;
#pragma unroll
            for (int dt = 0; dt < 8; ++dt) oacc[G][dt] = oacc[G][dt] * alpha;
        }
#pragma unroll
        for (int s = 0; s < 4; ++s) {
            bf16x8 pf[2];
#pragma unroll
            for (int G = 0; G < 2; ++G) { u32x4 w; w.x = pk2(sacc[G][2 * s][0], sacc[G][2 * s][1]); w.y = pk2(sacc[G][2 * s][2], sacc[G][2 * s][3]);
                w.z = pk2(sacc[G][2 * s + 1][0], sacc[G][2 * s + 1][1]); w.w = pk2(sacc[G][2 * s + 1][2], sacc[G][2 * s + 1][3]); pf[G] = __builtin_bit_cast(bf16x8, w); }
#pragma unroll
            for (int dt = 0; dt < 8; ++dt) {
                const unsigned vo = (unsigned)((16 * dt + lr) * ldvt + 128 * kb + 32 * s + 4 * quad);
                const u32x2 lo = *(const u32x2*)(VTp + vo), hi = *(const u32x2*)(VTp + vo + 16);
                const bf16x8 vf = __builtin_bit_cast(bf16x8, (u32x4){lo.x, lo.y, hi.x, hi.y});
#pragma unroll
                for (int G = 0; G < 2; ++G) oacc[G][dt] = __builtin_amdgcn_mfma_f32_16x16x32_bf16(vf, pf[G], oacc[G][dt], 0, 0, 0);
                if (dt & 1) asm volatile("" ::: "memory");
            }
        }
    }
#pragma unroll
    for (int G = 0; G < 2; ++G) { const float inv = 1.f / lrun[G];
#pragma unroll
        for (int dt = 0; dt < 8; ++dt) { const f32x4 o = oacc[G][dt] * inv; u32x2 w; w.x = pk2(o[0], o[1]); w.y = pk2(o[2], o[3]);
            *(u32x2*)(Op + (unsigned)((16 * G + lr) * ldo + 16 * dt + 4 * quad)) = w; } }
}

__device__ __forceinline__ void winattn_phase(KArgs a, int L, int gw, int NGW, int lane) {
    unsigned char* ws = a->ws;
    const bf16* Q = (const bf16*)(ws + WS_Q); const bf16* K = (const bf16*)(ws + WS_K); const bf16* VT = (const bf16*)(ws + WS_VT); bf16* O = (bf16*)(ws + WS_OATT);
    const float* sink = a->in[I_SINK] + L * 8;
    for (int task = gw; task < (MTOK / 32) * 8; task += NGW) {
        const int hq = task & 7, row0 = (task >> 3) * 32, pos0 = row_pos(row0), S = row_slen(row0), qb = pos0 >> 7;
        const int kb_lo = max(qb - 1, 0), kb_hi = min(qb + 1, (S >> 7) - 1), keyrow0 = (row0 - pos0) + 128 * kb_lo, hkv = hq >> 2;
        attn_task<true>(Q + (size_t)row0 * 1024 + hq * 128, 1024, K + (size_t)keyrow0 * 256 + hkv * 128, 256, VT + (size_t)(hkv * 128) * MTOK + keyrow0, MTOK,
                        O + (size_t)row0 * 1024 + hq * 128, 1024, kb_hi - kb_lo + 1, pos0 - 128 * kb_lo, sink[hq] * LOG2E, 1.f, lane);
    }
}
__device__ __forceinline__ void xattn_phase(KArgs a, int gw, int NGW, int lane) {
    unsigned char* ws = a->ws;
    const bf16* Q = (const bf16*)(ws + WS_QX); const bf16* K = (const bf16*)(ws + WS_KX); const bf16* VT = (const bf16*)(ws + WS_VXT); bf16* O = (bf16*)(ws + WS_OX);
    for (int task = gw; task < (MTOK / 32) * 4; task += NGW) {
        const int h = task & 3, row0 = (task >> 2) * 32, seq = row0 < SEQP ? 0 : 1 + ((row0 - SEQP) >> 12);
        attn_task<false>(Q + (size_t)row0 * 512 + h * 128, 512, K + (size_t)(MEML * seq) * 512 + h * 128, 512, VT + (size_t)(h * 128) * MMEM + MEML * seq, MMEM,
                         O + (size_t)row0 * 512 + h * 128, 512, 2, 0, -1.0e30f, 0.f, lane);
    }
}

__device__ __forceinline__ void prepa_phase(KArgs a, int L, int gw, int NGW, int lane) {
    unsigned char* ws = a->ws;
    const float* U = (const float*)(ws + WS_URWKV); float* SH = (float*)(ws + WS_SH); float* KB = (float*)(ws + WS_KBUF); bf16* AL = (bf16*)(ws + WS_AL);
    const float* mu0 = a->in[I_MU] + (size_t)L * 2 * RWC; const float* mu1 = mu0 + RWC; const float* k_k = a->in[I_KK] + L * 512;
    for (int row = gw; row < MTOK; row += NGW) {
        const int pos = row_pos(row), S = row_slen(row); const bool hp = pos > 0, hn = pos < S - 1;
        const float* u0 = U + (size_t)row * 2048;
#pragma unroll 1
        for (int seg = 0; seg < 3; ++seg)
#pragma unroll 2
            for (int h = 0; h < 8; ++h) {
                const int c = seg * 512 + h * 64 + lane;
                const float f = u0[c], p = hp ? u0[c - 2048] : 0.f, n = hn ? u0[c + 2048] : 0.f;
                const float xs = f + mu0[c] * (p - f) + mu1[c] * (n - f);
                float* sh = SH + ((size_t)row * 8 + h) * 192;
                if (seg == 0) sh[64 + lane] = xs;
                else if (seg == 2) sh[128 + lane] = xs;
                else { KB[(size_t)row * 512 + h * 64 + lane] = xs; const float ku = xs * k_k[h * 64 + lane]; const float nrm = sqrtf(wave_sum(ku * ku)); sh[lane] = -ku / fmaxf(nrm, 1e-12f); }
            }
#pragma unroll
        for (int i = 0; i < 6; ++i) {
            const int c = 1536 + 64 * i + lane;
            const float f = u0[c], p = hp ? u0[c - 2048] : 0.f, n = hn ? u0[c + 2048] : 0.f;
            const float xs = f + mu0[c] * (p - f) + mu1[c] * (n - f);
            const float o = i < 2 ? tanhf(xs) : (i < 4 ? xs : 1.f / (1.f + expf(-xs)));
            const unsigned w = pk2(o, 0.f);
            AL[(size_t)row * 384 + 64 * i + lane] = (bf16)(w & 0xffffu);
        }
    }
}

__device__ __forceinline__ void scan_phase(KArgs a, LAS unsigned char* lds, int gw, int NGW, int wave, int lane) {
    unsigned char* ws = a->ws;
    const float* SH = (const float*)(ws + WS_SH); const float* DIR = (const float*)(ws + WS_DIR);
    float* Y = (float*)(ws + WS_Y); float* Z = (float*)(ws + WS_Z); float* QM = (float*)(ws + WS_QM); float* PM = (float*)(ws + WS_PM);
    LAS float* wl = (LAS float*)(lds + RING_OFF + wave * 12288);
    for (int task = gw; task < NCP * 16; task += NGW) {
        const int cp = task >> 4, e = (task >> 3) & 1, h = task & 7;
        f32x2 S2[32], X2[32];
#pragma unroll
        for (int q = 0; q < 32; ++q) { S2[q] = (f32x2){0.f, 0.f}; X2[q] = (f32x2){(2 * q == lane) ? 1.f : 0.f, (2 * q + 1 == lane) ? 1.f : 0.f}; }
#pragma unroll 1
        for (int b = 0; b < CH / 8; ++b) {
            LDS_WAIT(); asm volatile("" ::: "memory");
            if (lane < 48) {
#pragma unroll
                for (int st = 0; st < 8; ++st) {
                    const int tau = 8 * b + st, row = cp * CH + (e ? CH - 1 - tau : tau);
                    const f32x4 s4 = *(const f32x4*)(SH + ((size_t)row * 8 + h) * 192 + 4 * lane);
                    const f32x4 d4 = *(const f32x4*)(DIR + (((size_t)row * 2 + e) * 8 + h) * 192 + 4 * lane);
                    *(LAS f32x4*)(wl + st * 384 + 4 * lane) = s4; *(LAS f32x4*)(wl + st * 384 + 192 + 4 * lane) = d4;
                }
            }
            LDS_WAIT(); asm volatile("" ::: "memory");
#pragma unroll 1
            for (int st = 0; st < 8; ++st) {
                const LAS float* p = wl + st * 384;
                const int tau = 8 * b + st, row = cp * CH + (e ? CH - 1 - tau : tau);
                const float vi = p[128 + lane];
                f32x2 sa0 = {0.f, 0.f}, sa1 = {0.f, 0.f}, sx0 = {0.f, 0.f}, sx1 = {0.f, 0.f};
#pragma unroll
                for (int q = 0; q < 16; ++q) { const f32x4 nk = *(const LAS f32x4*)(p + 4 * q);
                    sa0 += S2[2 * q] * nk.xy; sa1 += S2[2 * q + 1] * nk.zw; sx0 += X2[2 * q] * nk.xy; sx1 += X2[2 * q + 1] * nk.zw; }
                const float sa = (sa0.x + sa0.y) + (sa1.x + sa1.y), sx = (sx0.x + sx0.y) + (sx1.x + sx1.y);
                const f32x2 sav = {sa, sa}, sxv = {sx, sx}, vv = {vi, vi};
                f32x2 y0 = {0.f, 0.f}, y1 = {0.f, 0.f}, z0 = {0.f, 0.f}, z1 = {0.f, 0.f};
#pragma unroll
                for (int q = 0; q < 16; ++q) {
                    const f32x4 r4 = *(const LAS f32x4*)(p + 64 + 4 * q), w4 = *(const LAS f32x4*)(p + 192 + 4 * q), ka4 = *(const LAS f32x4*)(p + 256 + 4 * q), kd4 = *(const LAS f32x4*)(p + 320 + 4 * q);
                    S2[2 * q] = S2[2 * q] * w4.xy + sav * ka4.xy + vv * kd4.xy; y0 += S2[2 * q] * r4.xy;
                    S2[2 * q + 1] = S2[2 * q + 1] * w4.zw + sav * ka4.zw + vv * kd4.zw; y1 += S2[2 * q + 1] * r4.zw;
                    X2[2 * q] = X2[2 * q] * w4.xy + sxv * ka4.xy; z0 += X2[2 * q] * r4.xy;
                    X2[2 * q + 1] = X2[2 * q + 1] * w4.zw + sxv * ka4.zw; z1 += X2[2 * q + 1] * r4.zw;
                }
                const size_t oi = (((size_t)row * 2 + e) * 8 + h) * 64 + lane;
                Y[oi] = (y0.x + y0.y) + (y1.x + y1.y); Z[oi] = (z0.x + z0.y) + (z1.x + z1.y);
            }
        }
        float* qo = QM + (size_t)task * 4096 + lane * 64; float* po = PM + (size_t)task * 4096 + lane * 64;
#pragma unroll
        for (int q = 0; q < 16; ++q) { *(f32x4*)(qo + 4 * q) = (f32x4){S2[2 * q].x, S2[2 * q].y, S2[2 * q + 1].x, S2[2 * q + 1].y};
            *(f32x4*)(po + 4 * q) = (f32x4){X2[2 * q].x, X2[2 * q].y, X2[2 * q + 1].x, X2[2 * q + 1].y}; }
    }
}

__device__ __forceinline__ void carry_phase(KArgs a, LAS unsigned char* lds, int tid) {
    const int chain = blockIdx.x;
    if (chain >= NSEQ * 16) return;
    unsigned char* ws = a->ws;
    const float* QM = (const float*)(ws + WS_QM); const float* PM = (const float*)(ws + WS_PM); float* SST = (float*)(ws + WS_SST);
    const int seq = chain >> 4, e = (chain >> 3) & 1, h = chain & 7;
    const int cp0 = seq == 0 ? 0 : (SEQP / CH) + (SEQS / CH) * (seq - 1), nc = seq == 0 ? SEQP / CH : SEQS / CH;
    LAS float* ST = (LAS float*)(lds + RING_OFF); LAS float* PB = (LAS float*)(lds + RING_OFF + 16384);
    const int i0 = 2 * (tid >> 4), j0 = 4 * (tid & 15);
    float sreg[2][4];
#pragma unroll
    for (int x = 0; x < 2; ++x)
#pragma unroll
        for (int y = 0; y < 4; ++y) sreg[x][y] = 0.f;
    for (int k = tid; k < 4096; k += 512) ST[k] = 0.f;
    f32x4 pn0, pn1, qn0, qn1;
    { const int cp = e ? cp0 + nc - 1 : cp0; const size_t sidx = ((size_t)cp * 2 + e) * 8 + h;
      pn0 = *(const f32x4*)(PM + sidx * 4096 + 4 * tid); pn1 = *(const f32x4*)(PM + sidx * 4096 + 2048 + 4 * tid);
      qn0 = *(const f32x4*)(QM + sidx * 4096 + (size_t)i0 * 64 + j0); qn1 = *(const f32x4*)(QM + sidx * 4096 + (size_t)(i0 + 1) * 64 + j0); }
#pragma unroll 1
    for (int c = 0; c < nc; ++c) {
        const int cp = e ? cp0 + nc - 1 - c : cp0 + c; const size_t sidx = ((size_t)cp * 2 + e) * 8 + h;
        *(f32x4*)(SST + sidx * 4096 + (size_t)i0 * 64 + j0) = (f32x4){sreg[0][0], sreg[0][1], sreg[0][2], sreg[0][3]};
        *(f32x4*)(SST + sidx * 4096 + (size_t)(i0 + 1) * 64 + j0) = (f32x4){sreg[1][0], sreg[1][1], sreg[1][2], sreg[1][3]};
        if (c == nc - 1) break;
        *(LAS f32x4*)(PB + 4 * tid) = pn0; *(LAS f32x4*)(PB + 2048 + 4 * tid) = pn1;
        float acc[2][4] = {{qn0[0], qn0[1], qn0[2], qn0[3]}, {qn1[0], qn1[1], qn1[2], qn1[3]}};
        if (c + 1 < nc - 1) { const int cpn = e ? cp0 + nc - 2 - c : cp0 + c + 1; const size_t sn = ((size_t)cpn * 2 + e) * 8 + h;
            pn0 = *(const f32x4*)(PM + sn * 4096 + 4 * tid); pn1 = *(const f32x4*)(PM + sn * 4096 + 2048 + 4 * tid);
            qn0 = *(const f32x4*)(QM + sn * 4096 + (size_t)i0 * 64 + j0); qn1 = *(const f32x4*)(QM + sn * 4096 + (size_t)(i0 + 1) * 64 + j0); }
        __syncthreads();
#pragma unroll 8
        for (int m = 0; m < 64; ++m) { const f32x2 s2 = *(const LAS f32x2*)(ST + m * 64 + i0); const f32x4 p4 = *(const LAS f32x4*)(PB + m * 64 + j0);
#pragma unroll
            for (int y = 0; y < 4; ++y) { acc[0][y] += s2.x * p4[y]; acc[1][y] += s2.y * p4[y]; } }
        __syncthreads();
#pragma unroll
        for (int y = 0; y < 4; ++y) { *(LAS f32x2*)(ST + (j0 + y) * 64 + i0) = (f32x2){acc[0][y], acc[1][y]}; sreg[0][y] = acc[0][y]; sreg[1][y] = acc[1][y]; }
    }
}

__device__ __forceinline__ void post_phase(KArgs a, int L, LAS unsigned char* lds, int gw, int NGW, int wave, int lane) {
    unsigned char* ws = a->ws;
    const float* SH = (const float*)(ws + WS_SH); const float* DIR = (const float*)(ws + WS_DIR); const float* Y = (const float*)(ws + WS_Y); const float* Z = (const float*)(ws + WS_Z);
    const float* SST = (const float*)(ws + WS_SST); const bf16* G = (const bf16*)(ws + WS_G); bf16* O = (bf16*)(ws + WS_ORWKV);
    const float* gng = a->in[I_GNG] + L * 512; const float* gnb = a->in[I_GNB] + L * 512; const float* rk = a->in[I_RK] + L * 512;
    LAS float* zl = (LAS float*)(lds + RING_OFF + wave * 2048);
    for (int task = gw; task < NCP * 16; task += NGW) {
        const int cp = task >> 4, hf = (task >> 3) & 1, h = task & 7;
        f32x2 Sf[32], Sb[32];
        { const float* sf = SST + (((size_t)cp * 2 + 0) * 8 + h) * 4096 + lane * 64; const float* sb = SST + (((size_t)cp * 2 + 1) * 8 + h) * 4096 + lane * 64;
#pragma unroll
          for (int q = 0; q < 16; ++q) { const f32x4 x = *(const f32x4*)(sf + 4 * q), y = *(const f32x4*)(sb + 4 * q); Sf[2 * q] = x.xy; Sf[2 * q + 1] = x.zw; Sb[2 * q] = y.xy; Sb[2 * q + 1] = y.zw; } }
        const float gg = gng[h * 64 + lane], gb = gnb[h * 64 + lane], rkk = rk[h * 64 + lane];
#pragma unroll 1
        for (int tb = 0; tb < 16; ++tb) {
            LDS_WAIT(); asm volatile("" ::: "memory");
#pragma unroll
            for (int u = 0; u < 4; ++u) { const int row = cp * CH + hf * 64 + tb * 4 + u;
                zl[(u * 2 + 0) * 64 + lane] = Z[(((size_t)row * 2 + 0) * 8 + h) * 64 + lane]; zl[(u * 2 + 1) * 64 + lane] = Z[(((size_t)row * 2 + 1) * 8 + h) * 64 + lane]; }
            LDS_WAIT(); asm volatile("" ::: "memory");
#pragma unroll 1
            for (int u = 0; u < 4; ++u) {
                const int row = cp * CH + hf * 64 + tb * 4 + u;
                f32x2 c0 = {0.f, 0.f}, c1 = {0.f, 0.f};
#pragma unroll
                for (int q = 0; q < 16; ++q) { const f32x4 zf = *(const LAS f32x4*)(zl + (u * 2 + 0) * 64 + 4 * q), zb = *(const LAS f32x4*)(zl + (u * 2 + 1) * 64 + 4 * q);
                    c0 += Sf[2 * q] * zf.xy + Sb[2 * q] * zb.xy; c1 += Sf[2 * q + 1] * zf.zw + Sb[2 * q + 1] * zb.zw; }
                const size_t yi = (((size_t)row * 2) * 8 + h) * 64 + lane;
                const float y = Y[yi] + Y[yi + 512] + (c0.x + c0.y) + (c1.x + c1.y);
                const float mean = wave_sum(y) * (1.f / 64.f), yc = y - mean, var = wave_sum(yc * yc) * (1.f / 64.f);
                const float yn = yc * (1.f / sqrtf(var + GN_EPS)) * gg + gb;
                const float* sh = SH + ((size_t)row * 8 + h) * 192; const float r = sh[64 + lane], v = sh[128 + lane];
                const float kd0 = DIR[(((size_t)row * 2 + 0) * 8 + h) * 192 + 128 + lane], kd1 = DIR[(((size_t)row * 2 + 1) * 8 + h) * 192 + 128 + lane];
                const float sbn = wave_sum(r * (kd0 + kd1) * rkk);
                const unsigned gw16 = G[(size_t)row * 512 + h * 64 + lane];
                const float o = (yn + sbn * v) * __uint_as_float(gw16 << 16);
                O[(size_t)row * 512 + h * 64 + lane] = (bf16)(pk2(o, 0.f) & 0xffffu);
            }
        }
    }
}

#define SEAM() do { if (a.single) { XcdBarrier b_ = bar; asm volatile("" : "+s"(b_.bar), "+s"(b_.x)); xcd_barrier(b_); } } while (0)
#ifndef PHMASK
#define PHMASK 0x1ffff
#endif
#define RUN(k) ((((PHMASK) >> (k)) & 1) && a.ph_lo <= (k) && (k) < a.ph_hi)
#define KA() KArgs ka = (KArgs)__builtin_amdgcn_kernarg_segment_ptr(); asm volatile("" : "+s"(ka)); unsigned char* ws = ka->ws; float* X = ka->out; bf16* XB = (bf16*)(ws + WS_XB); (void)X; (void)XB
#define IDS() KA(); const int lane = hw_lane(), wave = wave_s, tid = wave * 64 + lane, gw = blockIdx.x * NWAVES + wave, gtid = blockIdx.x * (NWAVES * 64) + tid; (void)lane; (void)gw; (void)gtid; (void)tid


template <int IT> __device__ __forceinline__ void half_layer(const Args& a, LAS unsigned char* lds, const XcdBarrier& bar, int G, int NGW, int NT, int wave_s) {
    constexpr int it = IT;
        const int L = it >> 1, s = it & 1;
        if (s == 0 && RUN(0)) { IDS(); conv_phase(ka, L, lds, gw, NGW, wave, lane, gtid, NT); if (it == 0) prologue_phase(ka, gtid, NT); __syncthreads(); SEAM(); }
        if (RUN(1)) {
            KA();
            pg8::Gemm g{XB, (const bf16*)(ws + WS_W1T) + (size_t)s * 2 * DFF * D, MTOK, 2 * DFF, D}; pg8::StaticOrder S; S.init(MTOK, 2 * DFF, G, (int)blockIdx.x);
            pg8::EpiSwiglu E{(bf16*)(ws + WS_H)};
            pg8::gemm_phase<pg8::EpiSwiglu, pg8::StaticOrder, true, true>(lds + RING_OFF, g, S, E, wave_s);
            SEAM();
        }
        if (RUN(2)) {
            KA();
            pg8::Gemm g{(const bf16*)(ws + WS_H), (const bf16*)(ws + WS_W2T) + (size_t)s * D * DFF, MTOK, D, DFF}; pg8::StaticOrder S; S.init(MTOK, D, G, (int)blockIdx.x);
            pg8::EpiResid E{X, ALPHA, 0.5f};
            pg8::gemm_phase<pg8::EpiResid, pg8::StaticOrder, true, true>(lds + RING_OFF, g, S, E, wave_s);
            SEAM();
        }
        if (RUN(3)) { IDS(); const int li = (L * 4 + (s ? 3 : 0)) * D; ln_phase(X, XB, ka->in[I_LNG] + li, ka->in[I_LNB] + li, gw, NGW, lane); SEAM(); }
        if (s == 0) {
            if (RUN(4)) {
                KA();
                { pg8::Gemm g{XB, (const bf16*)(ws + WS_WINT), MTOK, NWIN, D}; pg8::StaticOrder S; S.init(MTOK, NWIN, G, (int)blockIdx.x);
                  pg8::EpiWin E{(bf16*)(ws + WS_UPOOL), (bf16*)(ws + WS_Q), (bf16*)(ws + WS_K), (bf16*)(ws + WS_GATES), (float*)(ws + WS_URWKV), (const float*)(ws + WS_CS)};
                  pg8::gemm_phase<pg8::EpiWin, pg8::StaticOrder, true, true>(lds + RING_OFF, g, S, E, wave_s); }
                { pg8::Gemm g{(const bf16*)(ws + WS_WINT) + (size_t)1792 * D, XB, 256, MTOK, D}; pg8::StaticOrder S; S.init(256, MTOK, G, (int)blockIdx.x);
                  pg8::EpiPlain E{(bf16*)(ws + WS_VT), MTOK};
                  pg8::gemm_phase<pg8::EpiPlain, pg8::StaticOrder, true, true>(lds + RING_OFF, g, S, E, wave_s); }
                SEAM();
            }
            if (RUN(5)) {
                IDS();
                pool_phase((const bf16*)(ws + WS_UPOOL), (bf16*)(ws + WS_OPOOL), gw, NGW, lane);
                winattn_phase(ka, L, gw, NGW, lane);
                prepa_phase(ka, L, gw, NGW, lane);
                SEAM();
            }
            if (RUN(6)) {
                KA();
                pg8::Gemm g{(const bf16*)(ws + WS_AL), (const bf16*)(ws + WS_BL), MTOK, 2560, 384}; pg8::StaticOrder S; S.init(MTOK, 2560, G, (int)blockIdx.x);
                pg8::EpiLora E{ka->in[I_W0] + L * 1024, ka->in[I_A0] + L * 1024, ka->in[I_KA] + L * 512, (const float*)(ws + WS_SH), (const float*)(ws + WS_KBUF), (float*)(ws + WS_DIR), (bf16*)(ws + WS_G)};
                pg8::gemm_phase<pg8::EpiLora, pg8::StaticOrder, true, true>(lds + RING_OFF, g, S, E, wave_s);
                SEAM();
            }
            if (RUN(7)) { IDS(); scan_phase(ka, lds, gw, NGW, wave, lane); SEAM(); }
            if (RUN(8)) { IDS(); carry_phase(ka, lds, tid); __syncthreads(); SEAM(); }
            if (RUN(9)) { IDS(); post_phase(ka, L, lds, gw, NGW, wave, lane); SEAM(); }
            if (RUN(10)) {
                KA();
#pragma unroll 1
                for (int b = 0; b < 3; ++b) {
                    const bf16* Ab = (const bf16*)(ws + (b == 0 ? WS_OPOOL : (b == 1 ? WS_OATT : WS_ORWKV)));
                    const bf16* Bb = (const bf16*)(ws + (b == 0 ? WS_WBR0 : (b == 1 ? WS_WBR1 : WS_WBR2)));
                    pg8::Gemm g{Ab, Bb, MTOK, D, b == 1 ? 1024 : 512}; pg8::StaticOrder S; S.init(MTOK, D, G, (int)blockIdx.x);
                    pg8::EpiBranch E{(bf16*)(ws + WS_MERGED), (const bf16*)(ws + WS_GATES) + b * D, b == 0 ? 1 : 0};
                    pg8::gemm_phase<pg8::EpiBranch, pg8::StaticOrder, true, true>(lds + RING_OFF, g, S, E, wave_s);
                }
                SEAM();
            }
            if (RUN(11)) {
                KA();
                pg8::Gemm g{(const bf16*)(ws + WS_MERGED), (const bf16*)(ws + WS_WOUT), MTOK, D, D}; pg8::StaticOrder S; S.init(MTOK, D, G, (int)blockIdx.x);
                pg8::EpiResid E{X, ALPHA, 1.f};
                pg8::gemm_phase<pg8::EpiResid, pg8::StaticOrder, true, true>(lds + RING_OFF, g, S, E, wave_s);
                SEAM();
            }
            if (RUN(12)) { IDS(); const int li = (L * 4 + 1) * D; ln_phase(X, XB, ka->in[I_LNG] + li, ka->in[I_LNB] + li, gw, NGW, lane); SEAM(); }
            if (RUN(13)) {
                KA();
#pragma unroll 1
                for (int b = 0; b < 3; ++b) {
                    const bf16* Ab = b == 0 ? XB : (b == 1 ? (const bf16*)(ws + WS_MEMB) : (const bf16*)(ws + WS_WKV) + (size_t)512 * D);
                    const bf16* Bb = b == 0 ? (const bf16*)(ws + WS_WQ) : (b == 1 ? (const bf16*)(ws + WS_WKV) : (const bf16*)(ws + WS_MEMB));
                    const int Mb = b == 0 ? MTOK : (b == 1 ? MMEM : 512), Nb = b == 0 ? 512 : (b == 1 ? 512 : MMEM);
                    pg8::Gemm g{Ab, Bb, Mb, Nb, D}; pg8::StaticOrder S; S.init(Mb, Nb, G, (int)blockIdx.x);
                    pg8::EpiPlain E{(bf16*)(ws + (b == 0 ? WS_QX : (b == 1 ? WS_KX : WS_VXT))), Nb};
                    pg8::gemm_phase<pg8::EpiPlain, pg8::StaticOrder, true, true>(lds + RING_OFF, g, S, E, wave_s);
                }
                SEAM();
            }
            if (RUN(14)) { IDS(); xattn_phase(ka, gw, NGW, lane); SEAM(); }
            if (RUN(15)) {
                KA();
                pg8::Gemm g{(const bf16*)(ws + WS_OX), (const bf16*)(ws + WS_WO), MTOK, D, 512}; pg8::StaticOrder S; S.init(MTOK, D, G, (int)blockIdx.x);
                pg8::EpiResid E{X, ALPHA, 1.f};
                pg8::gemm_phase<pg8::EpiResid, pg8::StaticOrder, true, true>(lds + RING_OFF, g, S, E, wave_s);
                SEAM();
            }
            if (RUN(16)) { IDS(); const int li = (L * 4 + 2) * D; ln_phase(X, XB, ka->in[I_LNG] + li, ka->in[I_LNB] + li, gw, NGW, lane); SEAM(); }
        }
}

__global__ void __launch_bounds__(NWAVES * 64, 2) fwd_kernel(Args a) {
    extern __shared__ __attribute__((aligned(16))) unsigned char lds_raw[];
    LAS unsigned char* lds = (LAS unsigned char*)lds_raw;
    volatile LAS unsigned* MISC = (volatile LAS unsigned*)(lds + MISC_OFF);
    const int G = gridDim.x, NGW = G * NWAVES, NT = G * NWAVES * 64, wave_s = __builtin_amdgcn_readfirstlane((int)threadIdx.x >> 6);
    { const int t0 = wave_s * 64 + hw_lane(); for (int u = t0; u < (LDS_BYTES - LDSCTL_OFF) / 4; u += NWAVES * 64) ((LAS unsigned*)(lds + LDSCTL_OFF))[u] = 0u; }
    __syncthreads();
    XcdBarrier bar; bar.bar = (unsigned*)(a.ws + WS_CTL) + 4096; bar.x = 0; bar.st = nullptr; bar.wv = (unsigned)wave_s;
    if (a.single) bar = xcd_barrier_post((unsigned*)(a.ws + WS_CTL) + 4096, MISC + 8, (unsigned)wave_s);
    if (0 >= a.it_lo && 0 < a.it_hi) half_layer<0>(a, lds, bar, G, NGW, NT, wave_s);
    if (1 >= a.it_lo && 1 < a.it_hi) half_layer<1>(a, lds, bar, G, NGW, NT, wave_s);
    if (2 >= a.it_lo && 2 < a.it_hi) half_layer<2>(a, lds, bar, G, NGW, NT, wave_s);
    if (3 >= a.it_lo && 3 < a.it_hi) half_layer<3>(a, lds, bar, G, NGW, NT, wave_s);
    if (4 >= a.it_lo && 4 < a.it_hi) half_layer<4>(a, lds, bar, G, NGW, NT, wave_s);
    if (5 >= a.it_lo && 5 < a.it_hi) half_layer<5>(a, lds, bar, G, NGW, NT, wave_s);
    if (6 >= a.it_lo && 6 < a.it_hi) half_layer<6>(a, lds, bar, G, NGW, NT, wave_s);
    if (7 >= a.it_lo && 7 < a.it_hi) half_layer<7>(a, lds, bar, G, NGW, NT, wave_s);
}
#undef SEAM
#undef RUN

#ifndef MK_SINGLE
#define MK_SINGLE 1
#endif
extern "C" void kernel_launch(void* const* d_in, const int* in_sizes, int n_in, void* d_out, int out_size, void* d_ws, size_t ws_size, hipStream_t stream) {
    static int grid = 0;
    if (grid == 0) {
        if (n_in != 28 || out_size != MTOK * D || ws_size < WS_END) { fprintf(stderr, "kernel_launch: unexpected problem (n_in %d, out %d, ws %zu < %zu); nothing launched\n", n_in, out_size, ws_size, (size_t)WS_END); grid = -1; return; }
        int dev = 0, cus = 0, per_cu = 0;
        if (hipGetDevice(&dev) != hipSuccess || hipDeviceGetAttribute(&cus, hipDeviceAttributeMultiprocessorCount, dev) != hipSuccess) { grid = -1; return; }
        if (hipFuncSetAttribute((const void*)fwd_kernel, hipFuncAttributeMaxDynamicSharedMemorySize, LDS_BYTES) != hipSuccess) { fprintf(stderr, "kernel_launch: hipFuncSetAttribute failed\n"); grid = -1; return; }
        if (hipOccupancyMaxActiveBlocksPerMultiprocessor(&per_cu, (const void*)fwd_kernel, NWAVES * 64, LDS_BYTES) != hipSuccess || per_cu < 1) { fprintf(stderr, "kernel_launch: occupancy query says %d blocks per CU; nothing launched\n", per_cu); (void)hipGetLastError(); grid = -1; return; }
        grid = cus;
    }
    if (grid < 0) return;
    (void)hipMemsetAsync((char*)d_ws + WS_CTL, 0, CTL_ZERO_BYTES, stream);
    Args a{};
    for (int i = 0; i < 28; ++i) a.in[i] = (const float*)d_in[i];
    a.out = (float*)d_out; a.ws = (unsigned char*)d_ws; a.pad = 0;
#if MK_SINGLE
    a.it_lo = 0; a.it_hi = 2 * DEPTH; a.ph_lo = 0; a.ph_hi = 17; a.single = 1;
    hipLaunchKernelGGL(fwd_kernel, dim3(grid), dim3(NWAVES * 64), LDS_BYTES, stream, a);
#else
    a.single = 0;
    for (int it = 0; it < 2 * DEPTH; ++it)
        for (int ph = 0; ph < 17; ++ph) {
            if ((it & 1) && (ph == 0 || ph > 3)) continue;
            a.it_lo = it; a.it_hi = it + 1; a.ph_lo = ph; a.ph_hi = ph + 1;
            hipLaunchKernelGGL(fwd_kernel, dim3(grid), dim3(NWAVES * 64), LDS_BYTES, stream, a);
        }
#endif
}
```

```cpp
#include <hip/hip_runtime.h>
#include <cstdio>
#include <cstdint>
#include <cmath>
constexpr int D = 2048, DFF = 5632, DEPTH = 4;
constexpr int SEQP = 16384, SEQS = 4096, NSAMP = 8, NSEQ = 9;
constexpr int MTOK = SEQP + NSAMP * SEQS;
constexpr int MEML = 256, MMEM = NSEQ * MEML;
constexpr int INC = 10112, NWIN = 10240;
constexpr int RWC = 1920;
constexpr float ALPHA = 1.681792830507429f;
constexpr float LN_EPS = 1e-5f, GN_EPS = 64e-5f;
constexpr int CH = 128;
constexpr int NCP = MTOK / CH;
constexpr float LOG2E = 1.4426950408889634f;
constexpr float ATT_C1 = 0.08838834764831845f * 1.4426950408889634f;

constexpr size_t MiB = 1u << 20;
constexpr size_t WS_CTL = 0, CTL_ZERO_BYTES = 1 * MiB;
constexpr size_t WS_CS = 1 * MiB;
constexpr size_t WS_MEMB = 9 * MiB;
constexpr size_t WS_W1T = 18 * MiB;
constexpr size_t WS_W2T = 106 * MiB;
constexpr size_t WS_WINT = 150 * MiB;
constexpr size_t WS_WBR0 = 190 * MiB;
constexpr size_t WS_WBR1 = 192 * MiB;
constexpr size_t WS_WBR2 = 196 * MiB;
constexpr size_t WS_WOUT = 198 * MiB;
constexpr size_t WS_WQ = 206 * MiB;
constexpr size_t WS_WKV = 208 * MiB;
constexpr size_t WS_WO = 212 * MiB;
constexpr size_t WS_BL = 214 * MiB;
constexpr size_t WS_XB = 216 * MiB;
constexpr size_t WS_RA = 408 * MiB;
constexpr size_t WS_Q = WS_RA;
constexpr size_t WS_K = WS_RA + 96 * MiB;
constexpr size_t WS_VT = WS_RA + 120 * MiB;
constexpr size_t WS_UPOOL = WS_RA + 144 * MiB;
constexpr size_t WS_URWKV = WS_RA + 192 * MiB;
constexpr size_t WS_GATES = WS_RA + 576 * MiB;
constexpr size_t WS_PM = WS_XB;
constexpr size_t WS_QM = WS_XB + 96 * MiB;
constexpr size_t WS_Y = WS_RA + 192 * MiB;
constexpr size_t WS_Z = WS_RA + 384 * MiB;
constexpr size_t WS_H = WS_RA;
constexpr size_t WS_QX = WS_RA;
constexpr size_t WS_KX = WS_RA + 48 * MiB;
constexpr size_t WS_VXT = WS_RA + 51 * MiB;
constexpr size_t WS_OX = WS_RA + 54 * MiB;
constexpr size_t WS_OPOOL = 1560 * MiB;
constexpr size_t WS_OATT = 1608 * MiB;
constexpr size_t WS_ORWKV = 1704 * MiB;
constexpr size_t WS_SH = 1752 * MiB;
constexpr size_t WS_MERGED = WS_SH;
constexpr size_t WS_DIR = 2040 * MiB;
constexpr size_t WS_KBUF = 2616 * MiB;
constexpr size_t WS_SST = WS_KBUF;
constexpr size_t WS_G = 2712 * MiB;
constexpr size_t WS_AL = 2760 * MiB;
constexpr size_t WS_STATS = 2796 * MiB;
constexpr size_t WS_END = 2797 * MiB;
static_assert(WS_GATES + 576 * MiB == WS_OPOOL, "region A");

typedef unsigned short bf16;
namespace pg8 {
#define PG8_LAS __attribute__((address_space(3)))
typedef unsigned short bf16_t;
typedef short bf16x8 __attribute__((ext_vector_type(8)));
typedef float f32x4 __attribute__((ext_vector_type(4)));
typedef unsigned u32x4 __attribute__((ext_vector_type(4)));
constexpr int BM = 256, BK = 64, HALF = 128, HTB = HALF * BK * 2  , STAGE_BYTES = 8 * HTB, NXCD = 8, WGM = 8;

__host__ __device__ __forceinline__ int lds_byte(int r, int c) { const int st = (r >> 4) * 2 + (c >> 5), rr = r & 15, cc = c & 31, ob = rr * 64 + cc * 2; return st * 1024 + (ob ^ (((ob >> 9) & 1) << 5)); }
__host__ __device__ __forceinline__ void stage_rc(int b, int& R, int& C) { const int st = b / 1024, sb = b % 1024, swz = sb ^ (((sb >> 9) & 1) << 5); R = (st >> 1) * 16 + swz / 64; C = (st & 1) * 32 + (swz % 64) / 2; }
__host__ __device__ __forceinline__ int perm32(int rho) { const int n = rho >> 4, i = rho & 15; return 8 * (i >> 2) + 4 * n + (i & 3); }

struct Unit { int pm, pn; };
struct Gemm { const bf16_t* A; const bf16_t* Bt; int M, N, K; };

struct StaticOrder {
    int nM, nN, nwg, G, c, wgm;
    __host__ __device__ void init(int M, int N, int G_, int c_, int wgm_ = WGM) { nM = M / BM; nN = N / BM; nwg = nM * nN; G = G_; c = c_; wgm = wgm_; }
    __host__ __device__ bool next(int i, Unit& u) const {
        const long L = (long)i * G + c; if (L >= nwg) return false;
        int wgid = (int)L; { const int q = nwg / NXCD, r = nwg % NXCD, xcd = wgid % NXCD, off = wgid / NXCD; wgid = (xcd < r ? xcd * (q + 1) : r * (q + 1) + (xcd - r) * q) + off; }
        const int nig = wgm * nN, gid = wgid / nig, fm = gid * wgm, gsz = (nM - fm) < wgm ? (nM - fm) : wgm;
        u.pm = fm + ((wgid % nig) % gsz); u.pn = (wgid % nig) / gsz; return true;
    }
    __device__ __forceinline__ void a_ready(const Unit&) const {}
    __device__ __forceinline__ void done(const Unit&) const {}
};

__device__ __forceinline__ unsigned cvt_pk_bf16(float lo, float hi) { unsigned r; asm volatile("v_cvt_pk_bf16_f32 %0, %1, %2" : "=v"(r) : "v"(lo), "v"(hi)); return r; }
typedef float f32x2 __attribute__((ext_vector_type(2)));
typedef unsigned u32x2 __attribute__((ext_vector_type(2)));
__device__ __forceinline__ int lane_now() { int l; asm volatile("v_mbcnt_lo_u32_b32 %0, -1, 0\n\tv_mbcnt_hi_u32_b32 %0, -1, %0" : "=v"(l)); return l; }
__device__ __forceinline__ float sigm(float x) { return __builtin_amdgcn_rcpf(1.f + __builtin_amdgcn_exp2f(-x * LOG2E)); }
__device__ __forceinline__ float bf_lo(unsigned w) { return __uint_as_float(w << 16); }
__device__ __forceinline__ float bf_hi(unsigned w) { return __uint_as_float(w & 0xffff0000u); }

struct EpiSwiglu {
    static constexpr bool PERM = true, AFTER_DRAIN = false;
    bf16_t* H;
    __device__ __forceinline__ void operator()(const f32x4 (&acc)[2][2][4][2], const Unit& u, int wr, int wc, int, int) const {
        const int ln_ = lane_now(), fr = ln_ & 15, fq = ln_ >> 4;
        const int row0 = u.pm * BM + wr * 64 + fr, col0 = u.pn * 128 + wc * 32 + 8 * fq;
#pragma unroll
        for (int ai = 0; ai < 2; ++ai)
#pragma unroll
            for (int m = 0; m < 4; ++m) {
                bf16_t* rowp = H + (size_t)(row0 + ai * HALF + m * 16) * DFF + col0;
                float o[8];
#pragma unroll
                for (int n = 0; n < 2; ++n)
#pragma unroll
                    for (int e = 0; e < 4; ++e) { const float g = acc[ai][0][m][n][e], up = acc[ai][1][m][n][e]; o[4 * n + e] = g * sigm(g) * up; }
                u32x4 w; w.x = cvt_pk_bf16(o[0], o[1]); w.y = cvt_pk_bf16(o[2], o[3]); w.z = cvt_pk_bf16(o[4], o[5]); w.w = cvt_pk_bf16(o[6], o[7]);
                __builtin_nontemporal_store(w, (u32x4*)rowp);
            }
    }
};
template <bool NORM, bool HALFSC> struct EpiResid {
    static constexpr bool PERM = false, AFTER_DRAIN = false;
    float* X; const float* stats; const float* g; const float* b;
    __device__ __forceinline__ void operator()(const f32x4 (&acc)[2][2][4][2], const Unit& u, int wr, int wc, int, int) const {
        const int ln_ = lane_now(), fr = ln_ & 15, fq = ln_ >> 4;
        const int row0 = u.pm * BM + wr * 64 + fr, col0 = u.pn * BM + wc * 32 + 4 * fq;
        float* const Xp = X; const float al = ALPHA, sc = HALFSC ? 0.5f : 1.f; const float* const stp = stats; const float* const gp = g + col0; const float* const bp = b + col0;
        f32x4 gg[2][2], bb[2][2]; f32x2 st_[2][4];
        if (NORM) {
#pragma unroll
            for (int bj = 0; bj < 2; ++bj)
#pragma unroll
                for (int n = 0; n < 2; ++n) { gg[bj][n] = *(const f32x4*)(gp + bj * HALF + n * 16); bb[bj][n] = *(const f32x4*)(bp + bj * HALF + n * 16); }
#pragma unroll
            for (int ai = 0; ai < 2; ++ai)
#pragma unroll
                for (int m = 0; m < 4; ++m) st_[ai][m] = *(const f32x2*)(stp + 2 * (size_t)(row0 + ai * HALF + m * 16));
        }
#pragma unroll
        for (int ai = 0; ai < 2; ++ai)
#pragma unroll
            for (int m = 0; m < 4; ++m) {
                const int row = row0 + ai * HALF + m * 16;
                float* rowp = Xp + (size_t)row * D + col0;
#pragma unroll
                for (int bj = 0; bj < 2; ++bj)
#pragma unroll
                    for (int n = 0; n < 2; ++n) { f32x4* p = (f32x4*)(rowp + bj * HALF + n * 16); f32x4 x;
                        if (NORM) { x = *p; x = (x - st_[ai][m].x) * st_[ai][m].y * gg[bj][n] + bb[bj][n]; }
                        else x = *(const f32x4*)((row < SEQP ? gp + (size_t)row * D : bp + (size_t)(row - SEQP) * D) + bj * HALF + n * 16);
                        *p = x * al + acc[ai][bj][m][n] * sc; }
                if (m & 1) asm volatile("" ::: "memory");
            }
    }
};
typedef _Float16 f16x2_t __attribute__((ext_vector_type(2)));
__device__ __forceinline__ f32x2 h2f(unsigned w) { const f16x2_t h = __builtin_bit_cast(f16x2_t, w); return (f32x2){(float)h[0], (float)h[1]}; }
__device__ __forceinline__ unsigned f2h(float a, float b) { f16x2_t h; h[0] = (_Float16)__builtin_amdgcn_fmed3f(a, -65504.f, 65504.f); h[1] = (_Float16)__builtin_amdgcn_fmed3f(b, -65504.f, 65504.f);
    return __builtin_bit_cast(unsigned, h); }
template <bool NORM, bool HALFSC, bool LAST> struct EpiResidH {
    static constexpr bool PERM = true, AFTER_DRAIN = false;
    unsigned short* XH; unsigned short* XF; const float* stats; const float* g; const float* b;
    __device__ __forceinline__ void operator()(const f32x4 (&acc)[2][2][4][2], const Unit& u, int wr, int wc, int, int) const {
        const int ln_ = lane_now(), fr = ln_ & 15, fq = ln_ >> 4;
        const int row0 = u.pm * BM + wr * 64 + fr, col0 = u.pn * BM + wc * 32 + 8 * fq;
        unsigned short* const Xp = XH; unsigned short* const Fp = XF; const float al = ALPHA, sc = HALFSC ? 0.5f : 1.f; const float* const stp = stats; const float* const gp = g + col0; const float* const bp = b + col0;
        f32x4 gg[2][2], bb[2][2]; f32x2 st_[2][4];
        if (NORM) {
#pragma unroll
            for (int bj = 0; bj < 2; ++bj)
#pragma unroll
                for (int n = 0; n < 2; ++n) { gg[bj][n] = *(const f32x4*)(gp + bj * HALF + n * 4); bb[bj][n] = *(const f32x4*)(bp + bj * HALF + n * 4); }
#pragma unroll
            for (int ai = 0; ai < 2; ++ai)
#pragma unroll
                for (int m = 0; m < 4; ++m) st_[ai][m] = *(const f32x2*)(stp + 2 * (size_t)(row0 + ai * HALF + m * 16));
        }
#pragma unroll
        for (int ai = 0; ai < 2; ++ai) {
            u32x4 hv[4][2];
            if (NORM) {
#pragma unroll
                for (int m = 0; m < 4; ++m)
#pragma unroll
                    for (int bj = 0; bj < 2; ++bj) hv[m][bj] = *(const u32x4*)(Xp + (size_t)(row0 + ai * HALF + m * 16) * D + col0 + bj * HALF);
                asm volatile("" ::: "memory");
            }
#pragma unroll
            for (int m = 0; m < 4; ++m) {
                const int row = row0 + ai * HALF + m * 16;
                unsigned short* rowp = Xp + (size_t)row * D + col0;
                f32x4 xi[2][2];
                if (!NORM) {
#pragma unroll
                    for (int bj = 0; bj < 2; ++bj) { const float* src = (row < SEQP ? gp + (size_t)row * D : bp + (size_t)(row - SEQP) * D) + bj * HALF; xi[bj][0] = *(const f32x4*)src; xi[bj][1] = *(const f32x4*)(src + 4); }
                    if (m & 1) asm volatile("" ::: "memory"); }
#pragma unroll
                for (int bj = 0; bj < 2; ++bj) { f32x4 x0, x1;
                    if (NORM) { const u32x4 h4 = hv[m][bj]; const f32x2 a0 = h2f(h4.x), a1 = h2f(h4.y), a2 = h2f(h4.z), a3 = h2f(h4.w);
                        x0 = ((f32x4){a0.x, a0.y, a1.x, a1.y} - st_[ai][m].x) * st_[ai][m].y * gg[bj][0] + bb[bj][0];
                        x1 = ((f32x4){a2.x, a2.y, a3.x, a3.y} - st_[ai][m].x) * st_[ai][m].y * gg[bj][1] + bb[bj][1]; }
                    else { x0 = xi[bj][0]; x1 = xi[bj][1]; }
                    const f32x4 o0 = x0 * al + acc[ai][bj][m][0] * sc, o1 = x1 * al + acc[ai][bj][m][1] * sc;
                    u32x4 w; w.x = f2h(o0[0], o0[1]); w.y = f2h(o0[2], o0[3]); w.z = f2h(o1[0], o1[1]); w.w = f2h(o1[2], o1[3]);
                    *(u32x4*)((LAST ? Fp + (size_t)row * D + col0 : rowp) + bj * HALF) = w; }
            }
            asm volatile("" ::: "memory");
        }
    }
};
struct EpiPlain {
    static constexpr bool PERM = true, AFTER_DRAIN = false;
    bf16_t* O; int ldc;
    __device__ __forceinline__ void operator()(const f32x4 (&acc)[2][2][4][2], const Unit& u, int wr, int wc, int, int) const {
        const int ln_ = lane_now(), fr = ln_ & 15, fq = ln_ >> 4;
        const int row0 = u.pm * BM + wr * 64 + fr, col0 = u.pn * BM + wc * 32 + 8 * fq;
#pragma unroll
        for (int ai = 0; ai < 2; ++ai)
#pragma unroll
            for (int m = 0; m < 4; ++m) {
                bf16_t* rowp = O + (size_t)(row0 + ai * HALF + m * 16) * ldc + col0;
#pragma unroll
                for (int bj = 0; bj < 2; ++bj) { const f32x4 v0 = acc[ai][bj][m][0], v1 = acc[ai][bj][m][1];
                    u32x4 w; w.x = cvt_pk_bf16(v0[0], v0[1]); w.y = cvt_pk_bf16(v0[2], v0[3]); w.z = cvt_pk_bf16(v1[0], v1[1]); w.w = cvt_pk_bf16(v1[2], v1[3]);
                    *(u32x4*)(rowp + bj * HALF) = w; }
            }
    }
};
struct EpiWin {
    static constexpr bool PERM = true, AFTER_DRAIN = false;
    bf16_t *UP, *Q, *K, *GT; float* UR; const float* CS; bf16_t* VT;
    __device__ __forceinline__ void operator()(const f32x4 (&acc)[2][2][4][2], const Unit& u, int wr, int wc, int, int) const {
        const int ln_ = lane_now(), fr = ln_ & 15, fq = ln_ >> 4;
        const int pn = u.pn, row0 = u.pm * BM + wr * 64 + fr, c8 = wc * 32 + 8 * fq;
        if (pn == 7) {
#pragma unroll
            for (int ai = 0; ai < 2; ++ai)
#pragma unroll
                for (int m = 0; m < 4; ++m) { const int row = row0 + ai * HALF + m * 16;
#pragma unroll
                    for (int bj = 0; bj < 2; ++bj)
#pragma unroll
                        for (int n = 0; n < 2; ++n) { const f32x4 v = acc[ai][bj][m][n]; const unsigned w01 = cvt_pk_bf16(v[0], v[1]), w23 = cvt_pk_bf16(v[2], v[3]);
                            bf16_t* dst = VT + (size_t)(bj * 128 + c8 + 4 * n) * MTOK + row;
                            dst[0] = (bf16_t)(w01 & 0xffffu); dst[MTOK] = (bf16_t)(w01 >> 16); dst[2 * (size_t)MTOK] = (bf16_t)(w23 & 0xffffu); dst[3 * (size_t)MTOK] = (bf16_t)(w23 >> 16); } }
            return;
        }
#pragma unroll
        for (int ai = 0; ai < 2; ++ai)
#pragma unroll
            for (int m = 0; m < 4; ++m) {
                const int row = row0 + ai * HALF + m * 16;
                if (pn >= 2 && pn < 7) {
                    const int pos = row < SEQP ? row : (row & (SEQS - 1));
                    const f32x4* csp = (const f32x4*)(CS + ((size_t)pos * 64 + 4 * (4 * wc + fq)) * 2);
                    const f32x4 c01 = csp[0], c23 = csp[1];
                    const float cs_[4] = {c01[0], c01[2], c23[0], c23[2]}, sn_[4] = {c01[1], c01[3], c23[1], c23[3]};
#pragma unroll
                    for (int bj = 0; bj < 2; ++bj) {
                        const f32x4 t1 = acc[ai][bj][m][0], t2 = acc[ai][bj][m][1]; float o1[4], o2[4];
#pragma unroll
                        for (int e = 0; e < 4; ++e) { o1[e] = t1[e] * cs_[e] - t2[e] * sn_[e]; o2[e] = t2[e] * cs_[e] + t1[e] * sn_[e]; }
                        u32x4 w; w.x = cvt_pk_bf16(o1[0], o1[1]); w.y = cvt_pk_bf16(o1[2], o1[3]); w.z = cvt_pk_bf16(o2[0], o2[1]); w.w = cvt_pk_bf16(o2[2], o2[3]);
                        bf16_t* dst = (pn == 6) ? K + (size_t)row * 256 + bj * 128 + c8 : Q + (size_t)row * 1024 + ((pn - 2) * 2 + bj) * 128 + c8;
                        __builtin_nontemporal_store(w, (u32x4*)dst);
                    }
                } else if (pn >= 8 && pn < 16) {
#pragma unroll
                    for (int bj = 0; bj < 2; ++bj) { float* p = UR + (size_t)row * 2048 + (pn - 8) * 256 + bj * 128 + c8; __builtin_nontemporal_store(acc[ai][bj][m][0], (f32x4*)p); __builtin_nontemporal_store(acc[ai][bj][m][1], (f32x4*)(p + 4)); }
                } else {
#pragma unroll
                    for (int bj = 0; bj < 2; ++bj) {
                        f32x4 v0 = acc[ai][bj][m][0], v1 = acc[ai][bj][m][1]; bf16_t* dst;
                        if (pn < 2) dst = UP + (size_t)row * 512 + pn * 256 + bj * 128 + c8;
                        else { dst = GT + (size_t)row * 6144 + (pn - 16) * 256 + bj * 128 + c8;
#pragma unroll
                            for (int e = 0; e < 4; ++e) { v0[e] = sigm(v0[e]); v1[e] = sigm(v1[e]); } }
                        u32x4 w; w.x = cvt_pk_bf16(v0[0], v0[1]); w.y = cvt_pk_bf16(v0[2], v0[3]); w.z = cvt_pk_bf16(v1[0], v1[1]); w.w = cvt_pk_bf16(v1[2], v1[3]);
                        __builtin_nontemporal_store(w, (u32x4*)dst);
                    }
                }
                asm volatile("" ::: "memory");
            }
    }
};
struct EpiBranch {
    static constexpr bool PERM = true, AFTER_DRAIN = false;
    bf16_t* MG; const bf16_t* GT; int first;
    __device__ __forceinline__ void operator()(const f32x4 (&acc)[2][2][4][2], const Unit& u, int wr, int wc, int, int) const {
        const int ln_ = lane_now(), fr = ln_ & 15, fq = ln_ >> 4;
        const int row0 = u.pm * BM + wr * 64 + fr, col0 = u.pn * BM + wc * 32 + 8 * fq;
#pragma unroll
        for (int ai = 0; ai < 2; ++ai) {
            u32x4 gwv[4][2], mwv[4][2];
#pragma unroll
            for (int m = 0; m < 4; ++m)
#pragma unroll
                for (int bj = 0; bj < 2; ++bj) { const int row = row0 + ai * HALF + m * 16, col = col0 + bj * HALF;
                    gwv[m][bj] = __builtin_nontemporal_load((const u32x4*)(GT + (size_t)row * 6144 + col));
                    mwv[m][bj] = first ? (u32x4){0u, 0u, 0u, 0u} : *(const u32x4*)(MG + (size_t)row * D + col); }
            asm volatile("" ::: "memory");
#pragma unroll
            for (int m = 0; m < 4; ++m)
#pragma unroll
                for (int bj = 0; bj < 2; ++bj) { const int row = row0 + ai * HALF + m * 16, col = col0 + bj * HALF;
                    const u32x4 gw = gwv[m][bj], mw = mwv[m][bj]; const f32x4 v0 = acc[ai][bj][m][0], v1 = acc[ai][bj][m][1];
                    u32x4 w;
                    w.x = cvt_pk_bf16(bf_lo(mw.x) + bf_lo(gw.x) * v0[0], bf_hi(mw.x) + bf_hi(gw.x) * v0[1]);
                    w.y = cvt_pk_bf16(bf_lo(mw.y) + bf_lo(gw.y) * v0[2], bf_hi(mw.y) + bf_hi(gw.y) * v0[3]);
                    w.z = cvt_pk_bf16(bf_lo(mw.z) + bf_lo(gw.z) * v1[0], bf_hi(mw.z) + bf_hi(gw.z) * v1[1]);
                    w.w = cvt_pk_bf16(bf_lo(mw.w) + bf_lo(gw.w) * v1[2], bf_hi(mw.w) + bf_hi(gw.w) * v1[3]);
                    *(u32x4*)(MG + (size_t)row * D + col) = w; }
            asm volatile("" ::: "memory");
        }
    }
};
struct EpiLora {
    static constexpr bool PERM = false, AFTER_DRAIN = false;
    const float *w0, *a0, *k_a; const float* SH; const float* KB; float* DIR; bf16_t* G;
    __device__ __forceinline__ void operator()(const f32x4 (&acc)[2][2][4][2], const Unit& u, int wr, int wc, int, int) const {
        const int ln_ = lane_now(), fr = ln_ & 15, fq = ln_ >> 4;
        const int pn = u.pn, row0 = u.pm * BM + wr * 64 + fr, cq = wc * 32 + 4 * fq;
        const int ed = (pn >> 1) & 1;
#pragma unroll
        for (int ai = 0; ai < 2; ++ai)
#pragma unroll
            for (int m = 0; m < 4; ++m) {
                const int row = row0 + ai * HALF + m * 16;
#pragma unroll
                for (int bj = 0; bj < 2; ++bj)
#pragma unroll
                    for (int n = 0; n < 2; ++n) {
                        const int c = pn * BM + bj * HALF + cq + 16 * n; const f32x4 v = acc[ai][bj][m][n];
                        const int ch = c & 511, hh = ch >> 6, j = ch & 63;
                        float* dp = DIR + (((size_t)row * 2 + ed) * 8 + hh) * 192 + j;
                        if (pn < 4) {
                            const f32x4 b = *(const f32x4*)(w0 + ed * 512 + ch); f32x4 o;
#pragma unroll
                            for (int e = 0; e < 4; ++e) { const float x = -(b[e] + v[e]);
                                const float sp = fmaxf(x, 0.f) + 0.6931471805599453f * __builtin_amdgcn_logf(1.f + __builtin_amdgcn_exp2f(-fabsf(x) * LOG2E));
                                o[e] = __builtin_amdgcn_exp2f(-LOG2E * __builtin_amdgcn_exp2f((-sp - 0.5f) * LOG2E)); }
                            *(f32x4*)dp = o;
                        } else if (pn < 8) {
                            const f32x4 b = *(const f32x4*)(a0 + ed * 512 + ch), ka = *(const f32x4*)(k_a + ch);
                            const f32x4 nk = *(const f32x4*)(SH + ((size_t)row * 8 + hh) * 192 + j), kk_ = *(const f32x4*)(KB + (size_t)row * 512 + ch);
                            f32x4 o1, o2;
#pragma unroll
                            for (int e = 0; e < 4; ++e) { const float a = sigm(b[e] + v[e]); o1[e] = -nk[e] * a; o2[e] = kk_[e] * (1.f + (a - 1.f) * ka[e]); }
                            *(f32x4*)(dp + 64) = o1; *(f32x4*)(dp + 128) = o2;
                        } else {
                            u32x2 w; w.x = cvt_pk_bf16(v[0], v[1]); w.y = cvt_pk_bf16(v[2], v[3]);
                            *(u32x2*)(G + (size_t)row * 512 + (c - 2048)) = w;
                        }
                    }
                asm volatile("" ::: "memory");
            }
    }
};

constexpr int XQ_UNITS = 420;
struct XqOrder {
    int G, c;
    __device__ __forceinline__ bool next(int i, Unit& u) const {
        const int L = i * G + c; if (L >= XQ_UNITS) return false;
        if (L < 384) { u.pm = (int)(WS_XB >> 20) + (L >> 1); u.pn = (int)(WS_WQ >> 20) + (L & 1); }
        else if (L < 402) { const int t = L - 384; u.pm = (int)(WS_MEMB >> 20) + (t >> 1); u.pn = (int)(WS_WKV >> 20) + (t & 1); }
        else { const int t = L - 402; u.pm = (int)(WS_WKV >> 20) + 2 + t / 9; u.pn = (int)(WS_MEMB >> 20) + t % 9; }
        return true;
    }
    __device__ __forceinline__ void a_ready(const Unit&) const {}
    __device__ __forceinline__ void done(const Unit&) const {}
};
struct EpiXq {
    static constexpr bool PERM = true, AFTER_DRAIN = false;
    bf16_t *QX, *KX, *VXT;
    __device__ __forceinline__ void operator()(const f32x4 (&acc)[2][2][4][2], const Unit& u, int wr, int wc, int, int) const {
        const int ln_ = lane_now(), fr = ln_ & 15, fq = ln_ >> 4;
        bf16_t* O; int ldc, tm, tn;
        if (u.pm >= (int)(WS_XB >> 20)) { O = QX; ldc = 512; tm = u.pm - (int)(WS_XB >> 20); tn = u.pn - (int)(WS_WQ >> 20); }
        else if (u.pm < (int)(WS_WKV >> 20)) { O = KX; ldc = 512; tm = u.pm - (int)(WS_MEMB >> 20); tn = u.pn - (int)(WS_WKV >> 20); }
        else { O = VXT; ldc = MMEM; tm = u.pm - (int)(WS_WKV >> 20) - 2; tn = u.pn - (int)(WS_MEMB >> 20); }
        const int row0 = tm * BM + wr * 64 + fr, col0 = tn * BM + wc * 32 + 8 * fq;
#pragma unroll
        for (int ai = 0; ai < 2; ++ai)
#pragma unroll
            for (int m = 0; m < 4; ++m) {
                bf16_t* rowp = O + (size_t)(row0 + ai * HALF + m * 16) * ldc + col0;
#pragma unroll
                for (int bj = 0; bj < 2; ++bj) { const f32x4 v0 = acc[ai][bj][m][0], v1 = acc[ai][bj][m][1];
                    u32x4 w; w.x = cvt_pk_bf16(v0[0], v0[1]); w.y = cvt_pk_bf16(v0[2], v0[3]); w.z = cvt_pk_bf16(v1[0], v1[1]); w.w = cvt_pk_bf16(v1[2], v1[3]);
                    *(u32x4*)(rowp + bj * HALF) = w; }
            }
    }
};
template <class Epi, class Sched, bool ALIGN_EPI = false, bool SP2 = false>
__device__ __forceinline__ void gemm_phase(PG8_LAS unsigned char* lds, const Gemm g, const Sched& S, const Epi E, int wid_in) {
    int lane_o; asm volatile("v_mbcnt_lo_u32_b32 %0, -1, 0\n\tv_mbcnt_hi_u32_b32 %0, -1, %0" : "=v"(lane_o));
    const int wid = wid_in, lane = lane_o, tid = wid * 64 + lane, wr = wid >> 2, wc = wid & 3, fr = lane & 15, fq = lane >> 4;
    const int K = g.K, nt = K / BK;
    unsigned voffA[2], voffB[2];
#pragma unroll
    for (int i = 0; i < 2; ++i) { int R, C; stage_rc(tid * 16 + i * 8192, R, C); const int Rb = Epi::PERM ? ((R & ~31) + perm32(R & 31)) : R;
        voffA[i] = (unsigned)(R * K + C) * 2u; voffB[i] = (unsigned)(Rb * K + C) * 2u; }
    const size_t kstep = (size_t)(BK * 2);
    const size_t hstep = (size_t)HALF * K * 2;
    const size_t tstep = 2 * hstep;
    const unsigned ldsw = (unsigned)wid * 1024u;
    const int aoff = lds_byte(wr * 64 + fr, fq * 8), boff = lds_byte(wc * 32 + fr, fq * 8);
#define PG8_SA(b, h) (((b) * 2 + (h)) * HTB)
#define PG8_SB(b, h) ((4 + (b) * 2 + (h)) * HTB)
#define PG8_STAGE(bufoff, gbase, voff) do { _Pragma("unroll") for (int _i = 0; _i < 2; ++_i) \
        __builtin_amdgcn_global_load_lds((const unsigned*)((const char*)(gbase) + (voff)[_i]), (PG8_LAS unsigned*)(lds + (bufoff) + ldsw + _i * 8192), 16, 0, 0); } while (0)
#define PG8_LDA(dst, b, h) do { _Pragma("unroll") for (int m = 0; m < 4; ++m) _Pragma("unroll") for (int k = 0; k < 2; ++k) dst[m][k] = *(const PG8_LAS bf16x8*)(lds + PG8_SA(b, h) + aoff + m * 2048 + k * 1024); } while (0)
#define PG8_LDB(dst, b, h) do { _Pragma("unroll") for (int n = 0; n < 2; ++n) _Pragma("unroll") for (int k = 0; k < 2; ++k) dst[n][k] = *(const PG8_LAS bf16x8*)(lds + PG8_SB(b, h) + boff + n * 2048 + k * 1024); } while (0)
#define PG8_MMA(ai, bj, At, Bt) do { __builtin_amdgcn_s_setprio(1); _Pragma("unroll") for (int m = 0; m < 4; ++m) _Pragma("unroll") for (int n = 0; n < 2; ++n) _Pragma("unroll") for (int k = 0; k < 2; ++k) \
        acc[ai][bj][m][n] = __builtin_amdgcn_mfma_f32_16x16x32_bf16(Bt[n][k], At[m][k], acc[ai][bj][m][n], 0, 0, 0); __builtin_amdgcn_s_setprio(0); } while (0)
#define PG8_WAIT_V(n) asm volatile("s_waitcnt vmcnt(" #n ")" ::: "memory")
#define PG8_WAIT_L(n) asm volatile("s_waitcnt lgkmcnt(" #n ")" ::: "memory")
#define PG8_BAR __builtin_amdgcn_s_barrier()
#define PG8_SCHED __builtin_amdgcn_sched_barrier(0)
    Unit cur, nxt; int ui = 0;
    if (!S.next(0, cur)) return;
    f32x4 acc[2][2][4][2];
#pragma unroll
    for (int a = 0; a < 2; ++a)
#pragma unroll
        for (int b = 0; b < 2; ++b)
#pragma unroll
            for (int m = 0; m < 4; ++m)
#pragma unroll
                for (int n = 0; n < 2; ++n) acc[a][b][m][n] = (f32x4){0.f, 0.f, 0.f, 0.f};
    bf16x8 At[4][2], B0[2][2], B1[2][2];
    const char* cA = (const char*)g.A + (size_t)cur.pm * tstep; const char* cB = (const char*)g.Bt + (size_t)cur.pn * tstep;
    S.a_ready(cur);
    if constexpr (SP2) {
        PG8_STAGE(PG8_SB(0, 0), cB, voffB); PG8_STAGE(PG8_SB(0, 1), cB + hstep, voffB); PG8_STAGE(PG8_SA(0, 0), cA, voffA); PG8_STAGE(PG8_SA(0, 1), cA + hstep, voffA);
        if (wr == 1) PG8_BAR;
        PG8_WAIT_V(2); PG8_BAR;
        PG8_STAGE(PG8_SB(1, 0), cB + kstep, voffB); PG8_STAGE(PG8_SA(1, 0), cA + kstep, voffA); PG8_STAGE(PG8_SB(1, 1), cB + hstep + kstep, voffB);
        PG8_WAIT_V(6); PG8_BAR;
    } else {
        PG8_STAGE(PG8_SB(0, 0), cB, voffB); PG8_STAGE(PG8_SA(0, 0), cA, voffA); PG8_STAGE(PG8_SB(0, 1), cB + hstep, voffB); PG8_STAGE(PG8_SA(0, 1), cA + hstep, voffA);
        if (wr == 1) PG8_BAR;
        PG8_WAIT_V(4); PG8_BAR;
        PG8_STAGE(PG8_SB(1, 0), cB + kstep, voffB); PG8_STAGE(PG8_SA(1, 0), cA + kstep, voffA); PG8_STAGE(PG8_SB(1, 1), cB + hstep + kstep, voffB);
        PG8_WAIT_V(6); PG8_BAR;
    }
    for (;;) {
        const bool has_next = S.next(ui + 1, nxt);
        const char* nA = has_next ? (const char*)g.A + (size_t)nxt.pm * tstep : cA; const char* nB = has_next ? (const char*)g.Bt + (size_t)nxt.pn * tstep : cB;
        for (int t = 0; t < nt; t += 2) {
            const bool last = (t == nt - 2);
            const char* a1 = cA + (size_t)(t + 1) * kstep;
            const char* a2 = last ? nA : cA + (size_t)(t + 2) * kstep; const char* b2 = last ? nB : cB + (size_t)(t + 2) * kstep;
            const char* a3 = a2 + kstep; const char* b3 = b2 + kstep;
            if (last && has_next) S.a_ready(nxt);
            if constexpr (SP2) {
            PG8_LDB(B0, 0, 0); PG8_LDB(B1, 0, 1); PG8_SCHED; PG8_LDA(At, 0, 0); PG8_STAGE(PG8_SA(1, 1), a1 + hstep, voffA);
            PG8_WAIT_V(8); PG8_WAIT_L(0); PG8_BAR; PG8_MMA(0, 0, At, B0); PG8_MMA(0, 1, At, B1); PG8_BAR; PG8_SCHED;
            PG8_LDA(At, 0, 1); PG8_STAGE(PG8_SB(0, 0), b2, voffB); PG8_STAGE(PG8_SB(0, 1), b2 + hstep, voffB); PG8_STAGE(PG8_SA(0, 0), a2, voffA);
            PG8_WAIT_V(8); PG8_WAIT_L(0); PG8_BAR; PG8_MMA(1, 0, At, B0); PG8_MMA(1, 1, At, B1); PG8_BAR; PG8_SCHED;
            PG8_LDB(B0, 1, 0); PG8_LDB(B1, 1, 1); PG8_SCHED; PG8_LDA(At, 1, 0); PG8_STAGE(PG8_SA(0, 1), a2 + hstep, voffA);
            PG8_WAIT_V(8); PG8_WAIT_L(0); PG8_BAR; PG8_MMA(0, 0, At, B0); PG8_MMA(0, 1, At, B1); PG8_BAR; PG8_SCHED;
            PG8_LDA(At, 1, 1); PG8_STAGE(PG8_SB(1, 0), b3, voffB); PG8_STAGE(PG8_SB(1, 1), b3 + hstep, voffB); PG8_STAGE(PG8_SA(1, 0), a3, voffA);
            PG8_WAIT_V(8); PG8_WAIT_L(0); PG8_BAR; PG8_MMA(1, 0, At, B0); PG8_MMA(1, 1, At, B1); PG8_BAR; PG8_SCHED;
            } else {
            PG8_LDB(B0, 0, 0); PG8_SCHED; PG8_LDA(At, 0, 0); PG8_STAGE(PG8_SA(1, 1), a1 + hstep, voffA);
            PG8_WAIT_L(8); PG8_BAR; PG8_WAIT_L(0); PG8_MMA(0, 0, At, B0); PG8_BAR; PG8_SCHED;
            PG8_LDB(B1, 0, 1); PG8_STAGE(PG8_SB(0, 0), b2, voffB);
            PG8_BAR; PG8_WAIT_L(0); PG8_MMA(0, 1, At, B1); PG8_BAR;
            PG8_LDA(At, 0, 1); PG8_STAGE(PG8_SA(0, 0), a2, voffA);
            PG8_BAR; PG8_WAIT_L(0); PG8_MMA(1, 0, At, B0); PG8_BAR; PG8_SCHED;
            PG8_STAGE(PG8_SB(0, 1), b2 + hstep, voffB);
            PG8_WAIT_V(6); PG8_BAR; PG8_MMA(1, 1, At, B1); PG8_BAR;
            PG8_LDB(B0, 1, 0); PG8_SCHED; PG8_LDA(At, 1, 0); PG8_STAGE(PG8_SA(0, 1), a2 + hstep, voffA);
            PG8_WAIT_L(8); PG8_BAR; PG8_WAIT_L(0); PG8_MMA(0, 0, At, B0); PG8_BAR; PG8_SCHED;
            PG8_LDB(B1, 1, 1); PG8_STAGE(PG8_SB(1, 0), b3, voffB);
            PG8_BAR; PG8_WAIT_L(0); PG8_MMA(0, 1, At, B1); PG8_BAR;
            PG8_LDA(At, 1, 1); PG8_STAGE(PG8_SA(1, 0), a3, voffA);
            PG8_BAR; PG8_WAIT_L(0); PG8_MMA(1, 0, At, B0); PG8_BAR; PG8_SCHED;
            PG8_STAGE(PG8_SB(1, 1), b3 + hstep, voffB);
            PG8_WAIT_V(6); PG8_BAR; PG8_MMA(1, 1, At, B1); PG8_BAR;
            }
        }
        if constexpr (ALIGN_EPI) { if (wr == 0) PG8_BAR; }
        if constexpr (!Epi::AFTER_DRAIN) { E(acc, cur, wr, wc, fr, fq); S.done(cur); }
        if (!has_next) break;
#pragma unroll
        for (int a = 0; a < 2; ++a)
#pragma unroll
            for (int b = 0; b < 2; ++b)
#pragma unroll
                for (int m = 0; m < 4; ++m)
#pragma unroll
                    for (int n = 0; n < 2; ++n) acc[a][b][m][n] = (f32x4){0.f, 0.f, 0.f, 0.f};
        cur = nxt; cA = nA; cB = nB; ++ui;
        if constexpr (ALIGN_EPI) { if (wr == 1) PG8_BAR; }
    }
    PG8_WAIT_V(0);
    if constexpr (!ALIGN_EPI) { if (wr == 0) PG8_BAR; }
    PG8_BAR;
    if constexpr (Epi::AFTER_DRAIN) { E.fused(acc, cur, wr, wc, fr, fq, lds, wid, lane); S.done(cur); }
#undef PG8_SA
#undef PG8_SB
#undef PG8_STAGE
#undef PG8_LDA
#undef PG8_LDB
#undef PG8_MMA
#undef PG8_WAIT_V
#undef PG8_WAIT_L
#undef PG8_BAR
#undef PG8_SCHED
}
}

constexpr int NWAVES = 8;
constexpr int RING_OFF = 0, RING_BYTES = 131072;
constexpr int LDSCTL_OFF = RING_BYTES, MISC_OFF = LDSCTL_OFF + 320;
constexpr int LDS_BYTES = 147456;

#define LAS __attribute__((address_space(3)))
typedef unsigned u32x2 __attribute__((ext_vector_type(2)));
typedef unsigned u32x4 __attribute__((ext_vector_type(4)));
typedef float f32x2 __attribute__((ext_vector_type(2)));
typedef float f32x4 __attribute__((ext_vector_type(4)));
typedef short bf16x8 __attribute__((ext_vector_type(8)));
#define LDS_WAIT() asm volatile("s_waitcnt lgkmcnt(0)" ::: "memory")
#define VM_WAIT() asm volatile("s_waitcnt vmcnt(0)" ::: "memory")
__device__ __forceinline__ unsigned pk2(float lo, float hi) { return pg8::cvt_pk_bf16(lo, hi); }
__device__ __forceinline__ float bflo(unsigned w) { return __uint_as_float(w << 16); }
__device__ __forceinline__ float bfhi(unsigned w) { return __uint_as_float(w & 0xffff0000u); }
__device__ __forceinline__ float wave_sum(float v) {
#pragma unroll
    for (int o = 1; o < 64; o <<= 1) v += __shfl_xor(v, o);
    return v;
}
__device__ __forceinline__ int hw_lane() { int l; asm volatile("v_mbcnt_lo_u32_b32 %0, -1, 0\n\tv_mbcnt_hi_u32_b32 %0, -1, %0" : "=v"(l)); return l; }
__device__ __forceinline__ int row_pos(int row) { return row < SEQP ? row : (row & (SEQS - 1)); }
__device__ __forceinline__ int row_slen(int row) { return row < SEQP ? SEQP : SEQS; }

__device__ const float INV_FREQ[64] = {
    1.000000000e+00f, 8.659643531e-01f, 7.498942018e-01f, 6.493816376e-01f,
    5.623413324e-01f, 4.869675338e-01f, 4.216965139e-01f, 3.651741147e-01f,
    3.162277639e-01f, 2.738419771e-01f, 2.371373773e-01f, 2.053525001e-01f,
    1.778279394e-01f, 1.539926529e-01f, 1.333521456e-01f, 1.154781953e-01f,
    1.000000015e-01f, 8.659642935e-02f, 7.498942316e-02f, 6.493816525e-02f,
    5.623413250e-02f, 4.869675264e-02f, 4.216964915e-02f, 3.651741147e-02f,
    3.162277490e-02f, 2.738419548e-02f, 2.371373773e-02f, 2.053525113e-02f,
    1.778279431e-02f, 1.539926510e-02f, 1.333521400e-02f, 1.154781971e-02f,
    9.999999776e-03f, 8.659643121e-03f, 7.498942316e-03f, 6.493816152e-03f,
    5.623413250e-03f, 4.869675264e-03f, 4.216964822e-03f, 3.651741194e-03f,
    3.162277630e-03f, 2.738419687e-03f, 2.371373819e-03f, 2.053525066e-03f,
    1.778279431e-03f, 1.539926510e-03f, 1.333521446e-03f, 1.154782018e-03f,
    1.000000047e-03f, 8.659643354e-04f, 7.498941850e-04f, 6.493816036e-04f,
    5.623413017e-04f, 4.869675322e-04f, 4.216965172e-04f, 3.651741135e-04f,
    3.162277571e-04f, 2.738419571e-04f, 2.371373703e-04f, 2.053525095e-04f,
    1.778279402e-04f, 1.539926598e-04f, 1.333521504e-04f, 1.154782003e-04f
};

#define XB_TMO      128
#define XB_XCNT(j)  (256  + 64 * (j))
#define XB_XSUB(j)  (1280 + 64 * (j))
#define XB_XGEN(j)  (2304 + 64 * (j))
#define XB_TOP      3328
#define XB_TOPGEN   3392
#define XCD_BAR_WORDS 3456
#define XB_SPIN_CAP (1u << 18)
__device__ __forceinline__ unsigned xb_ld(unsigned* p)              { return __hip_atomic_load(p, __ATOMIC_RELAXED, __HIP_MEMORY_SCOPE_AGENT); }
__device__ __forceinline__ unsigned xb_add(unsigned* p, unsigned v) { return __hip_atomic_fetch_add(p, v, __ATOMIC_RELAXED, __HIP_MEMORY_SCOPE_AGENT); }
__device__ __forceinline__ unsigned xb_xcc_id() { return (unsigned)__builtin_amdgcn_s_getreg((3 << 11) | 20) & 0xFu; }
#define XB_SPIN(cond, bar) do { unsigned _sp = 0; while (cond) { __builtin_amdgcn_s_sleep(1); \
    if ((++_sp & 255u) == 0u) { if (xb_ld(&(bar)[XB_TMO])) break; if (_sp > XB_SPIN_CAP) { atomicAdd(&(bar)[XB_TMO], 1u); break; } } } } while (0)
struct XcdBarrier { unsigned* bar; unsigned x; volatile LAS unsigned* st; unsigned wv; };
__device__ __forceinline__ bool xb_thread0(unsigned wv) { return wv == 0u && hw_lane() == 0; }
__device__ __forceinline__ XcdBarrier xcd_barrier_post(unsigned* bar, volatile LAS unsigned* st, unsigned wv) {
    XcdBarrier b; b.bar = bar; b.x = xb_xcc_id(); b.st = st; b.wv = wv;
    if (xb_thread0(wv)) (void)xb_add(&bar[XB_XCNT(b.x)], 1u);
    return b;
}
__device__ __forceinline__ void xcd_barrier_complete(unsigned* bar, unsigned x, unsigned& nloc, unsigned& nx) {
    const unsigned G = gridDim.x * gridDim.y * gridDim.z;
    unsigned sum, cnt, mine, sp = 0u;
    for (;;) {
        sum = 0u; cnt = 0u; mine = 0u;
#pragma unroll
        for (unsigned j = 0; j < 16; ++j) { const unsigned c = xb_ld(&bar[XB_XCNT(j)]); sum += c; cnt += (c > 0u) ? 1u : 0u; mine = (j == x) ? c : mine; }
        if (sum == G) break;
        __builtin_amdgcn_s_sleep(1);
        if ((++sp & 255u) == 0u) { if (xb_ld(&bar[XB_TMO])) break; if (sp > XB_SPIN_CAP) { atomicAdd(&bar[XB_TMO], 1u); break; } }
    }
    nloc = mine > 0u ? mine : 1u; nx = cnt > 0u ? cnt : 1u;
}
__device__ __forceinline__ void xcd_barrier(const XcdBarrier& b) {
    asm volatile("s_waitcnt vmcnt(0)" ::: "memory");
    __syncthreads();
    if (xb_thread0(b.wv)) {
        unsigned* bar = b.bar;
        __builtin_amdgcn_s_waitcnt(0);
        unsigned nloc = b.st[0], nx = b.st[1];
        if (nloc == 0u) { xcd_barrier_complete(bar, b.x, nloc, nx); b.st[0] = nloc; b.st[1] = nx; }
        const unsigned old = xb_add(&bar[XB_XSUB(b.x)], 1u);
        const unsigned gen = old / nloc;
        if (old + 1u == (gen + 1u) * nloc) {
            __builtin_amdgcn_fence(__ATOMIC_RELEASE, "agent");
            asm volatile("s_waitcnt vmcnt(0)" ::: "memory");
            const unsigned og = xb_add(&bar[XB_TOP], 1u);
            const unsigned tg = og / nx;
            if (og + 1u == (tg + 1u) * nx) xb_add(&bar[XB_TOPGEN], 1u);
            else XB_SPIN(xb_ld(&bar[XB_TOPGEN]) == tg, bar);
            __builtin_amdgcn_fence(__ATOMIC_ACQUIRE, "agent");
            xb_add(&bar[XB_XGEN(b.x)], 1u);
            asm volatile("s_waitcnt vmcnt(0)" ::: "memory");
        } else {
            XB_SPIN(xb_ld(&bar[XB_XGEN(b.x)]) == gen, bar);
            __builtin_amdgcn_fence(__ATOMIC_ACQUIRE, "agent");
            asm volatile("s_waitcnt vmcnt(0)" ::: "memory");
        }
    }
    __syncthreads();
}

#define GAS __attribute__((address_space(1)))
struct Args {
    const GAS float* in[28]; GAS float* out; GAS unsigned char* ws;
    int it_lo, it_hi, ph_lo, ph_hi;
    int single, pad;
};
typedef const __attribute__((address_space(4))) Args* KArgs;
enum { I_XP = 0, I_XS, I_MP, I_MS, I_LNG, I_LNB, I_FWI, I_FWO, I_WIN, I_POOLW, I_POOLS, I_SINK, I_MU, I_W0, I_W2, I_A0, I_A2, I_G2, I_KK, I_KA, I_RK, I_GNG, I_GNB, I_WBR, I_WOUT, I_XWQ, I_XWKV, I_XWO };

__device__ __forceinline__ int map_row(int kind, int n) {
    if (kind == 1) { const int up = n >= DFF ? 1 : 0; const int j = up ? n - DFF : n; return (j >> 7) * 256 + (up << 7) + (j & 127); }
    if (kind == 2) {
        if (n >= 512 && n < 1792) { const int d = n & 127; return (n & ~127) + 8 * ((d & 63) >> 2) + (d & 3) + 4 * (d >> 6); }
        return n >= 3968 ? n + 128 : n;
    }
    return n;
}
__device__ __forceinline__ void transpose_item(const float* W, int K, int N, bf16* WT, int kind, LAS float* scr, int item, int lane) {
    const int nblk = N / 32, kb = item / nblk, nb = item % nblk, k0 = 64 * kb, n0 = 32 * nb;
#pragma unroll
    for (int i = 0; i < 32; ++i) { const int kk = 2 * i + (lane >> 5); scr[kk * 33 + (lane & 31)] = __builtin_nontemporal_load(W + (size_t)(k0 + kk) * N + n0 + (lane & 31)); }
    LDS_WAIT(); asm volatile("" ::: "memory");
    const int c = lane & 7;
#pragma unroll
    for (int j = 0; j < 4; ++j) { const int n = (lane >> 3) + 8 * j; const LAS float* s = scr + (8 * c) * 33 + n;
        u32x4 o; o.x = pk2(s[0 * 33], s[1 * 33]); o.y = pk2(s[2 * 33], s[3 * 33]); o.z = pk2(s[4 * 33], s[5 * 33]); o.w = pk2(s[6 * 33], s[7 * 33]);
        *(u32x4*)(WT + (size_t)map_row(kind, n0 + n) * K + k0 + 8 * c) = o; }
    LDS_WAIT(); asm volatile("" ::: "memory");
}

__device__ __forceinline__ void conv_phase(KArgs a, int L, LAS unsigned char* lds, int gw, int NGW, int wave, int lane, int gtid, int NT) {
    unsigned char* ws = (unsigned char*)a->ws;
    LAS float* scr = (LAS float*)(lds + RING_OFF + wave * 16384);
    constexpr int N_W1 = 32 * 352, N_W2 = 88 * 64, N_WI = 32 * 316, N_B1 = 16 * 64, N_B2 = 8 * 64, N_OU = 32 * 64, N_Q = 32 * 16, N_KV = 32 * 32, N_O = 8 * 64;
    constexpr int NITEMS = 2 * N_W1 + 2 * N_W2 + N_WI + N_B1 + N_B2 + N_OU + N_Q + N_KV + N_O;
    const float* fwi = ((const float*)a->in[I_FWI]) + (size_t)L * 2 * D * 2 * DFF;
    const float* fwo = ((const float*)a->in[I_FWO]) + (size_t)L * 2 * DFF * D;
    const float* wbr = ((const float*)a->in[I_WBR]) + (size_t)L * D * D;
    for (int it = gw; it < NITEMS; it += NGW) {
        int r = it;
        if (r < N_W1) { transpose_item(fwi, D, 2 * DFF, (bf16*)(ws + WS_W1T), 1, scr, r, lane); continue; } r -= N_W1;
        if (r < N_W1) { transpose_item(fwi + (size_t)D * 2 * DFF, D, 2 * DFF, (bf16*)(ws + WS_W1T) + (size_t)2 * DFF * D, 1, scr, r, lane); continue; } r -= N_W1;
        if (r < N_W2) { transpose_item(fwo, DFF, D, (bf16*)(ws + WS_W2T), 0, scr, r, lane); continue; } r -= N_W2;
        if (r < N_W2) { transpose_item(fwo + (size_t)DFF * D, DFF, D, (bf16*)(ws + WS_W2T) + (size_t)D * DFF, 0, scr, r, lane); continue; } r -= N_W2;
        if (r < N_WI) { transpose_item(((const float*)a->in[I_WIN]) + (size_t)L * D * INC, D, INC, (bf16*)(ws + WS_WINT), 2, scr, r, lane); continue; } r -= N_WI;
        if (r < N_B1) { transpose_item(wbr + (size_t)512 * D, 1024, D, (bf16*)(ws + WS_WBR1), 0, scr, r, lane); continue; } r -= N_B1;
        if (r < N_B2) { transpose_item(wbr + (size_t)1536 * D, 512, D, (bf16*)(ws + WS_WBR2), 0, scr, r, lane); continue; } r -= N_B2;
        if (r < N_OU) { transpose_item(((const float*)a->in[I_WOUT]) + (size_t)L * D * D, D, D, (bf16*)(ws + WS_WOUT), 0, scr, r, lane); continue; } r -= N_OU;
        if (r < N_Q) { transpose_item(((const float*)a->in[I_XWQ]) + (size_t)L * D * 512, D, 512, (bf16*)(ws + WS_WQ), 0, scr, r, lane); continue; } r -= N_Q;
        if (r < N_KV) { transpose_item(((const float*)a->in[I_XWKV]) + (size_t)L * D * 1024, D, 1024, (bf16*)(ws + WS_WKV), 0, scr, r, lane); continue; } r -= N_KV;
        transpose_item(((const float*)a->in[I_XWO]) + (size_t)L * 512 * D, 512, D, (bf16*)(ws + WS_WO), 0, scr, r, lane);
    }
    {
        const float* pw = ((const float*)a->in[I_POOLW]) + (size_t)L * 4 * 128 * 128; const float* ps = ((const float*)a->in[I_POOLS]) + (size_t)L * 512;
        bf16* dst = (bf16*)(ws + WS_WBR0);
        for (int id = gtid; id < 2048 * 64; id += NT) {
            const int n = id & 2047, kg = id >> 11, g = kg >> 4, c0 = (8 * kg) & 127;
            float acc[8];
#pragma unroll
            for (int i = 0; i < 8; ++i) acc[i] = 0.f;
            const float* pwr = pw + ((size_t)g * 128 + c0) * 128;
            for (int e = 0; e < 128; ++e) {
                const float wb = wbr[(size_t)(g * 128 + e) * D + n] * ps[g * 128 + e];
#pragma unroll
                for (int i = 0; i < 8; ++i) acc[i] += pwr[i * 128 + e] * wb;
            }
            u32x4 o; o.x = pk2(acc[0], acc[1]); o.y = pk2(acc[2], acc[3]); o.z = pk2(acc[4], acc[5]); o.w = pk2(acc[6], acc[7]);
            *(u32x4*)(dst + (size_t)n * 512 + 8 * kg) = o;
        }
    }
    {
        const float* w2 = ((const float*)a->in[I_W2]) + (size_t)L * 2 * 64 * 512; const float* a2 = ((const float*)a->in[I_A2]) + (size_t)L * 2 * 64 * 512; const float* g2 = ((const float*)a->in[I_G2]) + (size_t)L * 128 * 512;
        bf16* dst = (bf16*)(ws + WS_BL);
        for (int id = gtid; id < 2560 * 48; id += NT) {
            const int n = id / 48, k0 = 8 * (id % 48);
            float v[8];
#pragma unroll
            for (int i = 0; i < 8; ++i) {
                const int k = k0 + i; float x = 0.f;
                if (n < 512) { if (k < 64) x = w2[(size_t)k * 512 + n]; }
                else if (n < 1024) { if (k >= 64 && k < 128) x = w2[(size_t)(64 + k - 64) * 512 + (n - 512)]; }
                else if (n < 1536) { if (k >= 128 && k < 192) x = a2[(size_t)(k - 128) * 512 + (n - 1024)]; }
                else if (n < 2048) { if (k >= 192 && k < 256) x = a2[(size_t)(64 + k - 192) * 512 + (n - 1536)]; }
                else { if (k >= 256) x = g2[(size_t)(k - 256) * 512 + (n - 2048)]; }
                v[i] = x;
            }
            u32x4 o; o.x = pk2(v[0], v[1]); o.y = pk2(v[2], v[3]); o.z = pk2(v[4], v[5]); o.w = pk2(v[6], v[7]);
            *(u32x4*)(dst + (size_t)n * 384 + k0) = o;
        }
    }
    { u32x4* p = (u32x4*)((bf16*)(ws + WS_WINT) + (size_t)3968 * D); for (int id = gtid; id < 128 * D / 8; id += NT) p[id] = (u32x4){0u, 0u, 0u, 0u}; }
}

__device__ __forceinline__ void prologue_phase(KArgs a, int gtid, int NT) {
    unsigned char* ws = (unsigned char*)a->ws;
    { f32x2* cs = (f32x2*)(ws + WS_CS);
      for (int id = gtid; id < SEQP * 64; id += NT) { const int t = id >> 6, j = id & 63; const float ang = (float)t * INV_FREQ[j]; float s, c; sincosf(ang, &s, &c); cs[id] = (f32x2){c, s}; } }
    { bf16* mb = (bf16*)(ws + WS_MEMB);
      for (int id = gtid; id < MMEM * D / 4; id += NT) { const int row = id / (D / 4), c4 = id % (D / 4);
          const float* src = row < MEML ? ((const float*)a->in[I_MP]) + (size_t)row * D : ((const float*)a->in[I_MS]) + (size_t)(row - MEML) * D;
          const f32x4 v = *(const f32x4*)(src + 4 * c4); u32x2 o; o.x = pk2(v[0], v[1]); o.y = pk2(v[2], v[3]); *(u32x2*)(mb + (size_t)row * D + 4 * c4) = o; } }
    { bf16* xb = (bf16*)(ws + WS_XB);
      for (int id = gtid; id < MTOK * (D / 4); id += NT) { const int row = id / (D / 4), c4 = id % (D / 4);
          const float* src = row < SEQP ? ((const float*)a->in[I_XP]) + (size_t)row * D : ((const float*)a->in[I_XS]) + (size_t)(row - SEQP) * D;
          const f32x4 v = *(const f32x4*)(src + 4 * c4);
          u32x2 o; o.x = pk2(v[0], v[1]); o.y = pk2(v[2], v[3]); *(u32x2*)(xb + (size_t)row * D + 4 * c4) = o; } }
}

__device__ __forceinline__ void ln_phase(const float* x, float* xo, bf16* xb, const float* g, const float* b, float* stats, bool write_x, int gw, int NGW, int lane) {
    f32x4 v[8], nx[8];
    if (gw < MTOK) { const f32x4* xr = (const f32x4*)(x + (size_t)gw * D) + lane;
#pragma unroll
        for (int j = 0; j < 8; ++j) v[j] = __builtin_nontemporal_load(xr + 64 * j); }
#pragma unroll 1
    for (int m = gw; m < MTOK; m += NGW) {
        f32x4* xr = (f32x4*)(xo + (size_t)m * D) + lane;
        if (m + NGW < MTOK) { const f32x4* xn = (const f32x4*)(x + (size_t)(m + NGW) * D) + lane;
#pragma unroll
            for (int j = 0; j < 8; ++j) nx[j] = __builtin_nontemporal_load(xn + 64 * j); }
        float s = 0.f;
#pragma unroll
        for (int j = 0; j < 8; ++j) s += (v[j][0] + v[j][1]) + (v[j][2] + v[j][3]);
        const float mean = wave_sum(s) * (1.f / D); float s2 = 0.f;
#pragma unroll
        for (int j = 0; j < 8; ++j) { v[j] = v[j] - mean; s2 += (v[j][0] * v[j][0] + v[j][1] * v[j][1]) + (v[j][2] * v[j][2] + v[j][3] * v[j][3]); }
        const float rstd = 1.f / sqrtf(wave_sum(s2) * (1.f / D) + LN_EPS);
        if (!write_x && lane == 0) *(f32x2*)(stats + 2 * (size_t)m) = (f32x2){mean, rstd};
        u32x2* o8 = (u32x2*)(xb + (size_t)m * D) + lane;
#pragma unroll
        for (int j = 0; j < 8; ++j) { const f32x4 gg = *((const f32x4*)g + lane + 64 * j), bb = *((const f32x4*)b + lane + 64 * j);
            const f32x4 o = v[j] * rstd * gg + bb; if (write_x) xr[64 * j] = o; u32x2 w; w.x = pk2(o[0], o[1]); w.y = pk2(o[2], o[3]); o8[64 * j] = w; }
#pragma unroll
        for (int j = 0; j < 8; ++j) v[j] = nx[j];
    }
}

template <bool FINAL> __device__ __forceinline__ void ln_phase_h(const unsigned short* xh, bf16* xb, float* xout, const float* g, const float* b, float* stats, int gw, int NGW, int lane) {
    u32x4 hv[4], nx[4];
    if (gw < MTOK) { const u32x4* xr = (const u32x4*)(xh + (size_t)gw * D) + lane;
#pragma unroll
        for (int j = 0; j < 4; ++j) hv[j] = __builtin_nontemporal_load(xr + 64 * j); }
#pragma unroll 1
    for (int m = gw; m < MTOK; m += NGW) {
        if (m + NGW < MTOK) { const u32x4* xn = (const u32x4*)(xh + (size_t)(m + NGW) * D) + lane;
#pragma unroll
            for (int j = 0; j < 4; ++j) nx[j] = __builtin_nontemporal_load(xn + 64 * j); }
        f32x4 v[8];
#pragma unroll
        for (int j = 0; j < 4; ++j) { const f32x2 a0 = pg8::h2f(hv[j].x), a1 = pg8::h2f(hv[j].y), a2 = pg8::h2f(hv[j].z), a3 = pg8::h2f(hv[j].w);
            v[2 * j] = (f32x4){a0.x, a0.y, a1.x, a1.y}; v[2 * j + 1] = (f32x4){a2.x, a2.y, a3.x, a3.y}; }
        float s = 0.f;
#pragma unroll
        for (int j = 0; j < 8; ++j) s += (v[j][0] + v[j][1]) + (v[j][2] + v[j][3]);
        const float mean = wave_sum(s) * (1.f / D); float s2 = 0.f;
#pragma unroll
        for (int j = 0; j < 8; ++j) { v[j] = v[j] - mean; s2 += (v[j][0] * v[j][0] + v[j][1] * v[j][1]) + (v[j][2] * v[j][2] + v[j][3] * v[j][3]); }
        const float rstd = 1.f / sqrtf(wave_sum(s2) * (1.f / D) + LN_EPS);
        if (!FINAL && lane == 0) *(f32x2*)(stats + 2 * (size_t)m) = (f32x2){mean, rstd};
        u32x4* o8 = (u32x4*)(xb + (size_t)m * D) + lane; f32x4* of = (f32x4*)(xout + (size_t)m * D) + 2 * lane;
#pragma unroll
        for (int j = 0; j < 4; ++j) { const f32x4* gq = (const f32x4*)g + 2 * (lane + 64 * j); const f32x4* bq = (const f32x4*)b + 2 * (lane + 64 * j);
            const f32x4 o0 = v[2 * j] * rstd * gq[0] + bq[0], o1 = v[2 * j + 1] * rstd * gq[1] + bq[1];
            if (FINAL) { of[128 * j] = o0; of[128 * j + 1] = o1; }
            else { u32x4 w; w.x = pk2(o0[0], o0[1]); w.y = pk2(o0[2], o0[3]); w.z = pk2(o1[0], o1[1]); w.w = pk2(o1[2], o1[3]); o8[64 * j] = w; } }
#pragma unroll
        for (int j = 0; j < 4; ++j) hv[j] = nx[j];
    }
}

__device__ __forceinline__ void pool_rows(const bf16* UP, bf16* OP, int row_lo, int row_hi, int step, int lane) {
    const int g = lane >> 4, half = 1 << g;
    for (int row = row_lo; row < row_hi; row += step) {
        const int pos = row_pos(row), S = row_slen(row), lo = max(pos - half, 0), hi = min(pos + half, S);
        const bf16* base = UP + (size_t)(row - pos) * 512 + 8 * lane;
        u32x4 w[16];
#pragma unroll
        for (int k = 0; k < 16; ++k) { const int s = pos - 8 + k; w[k] = (s >= lo && s < hi) ? *(const u32x4*)(base + (size_t)s * 512) : (u32x4){0u, 0u, 0u, 0u}; }
        float sum[8];
#pragma unroll
        for (int i = 0; i < 8; ++i) sum[i] = 0.f;
#pragma unroll
        for (int k = 0; k < 16; ++k) { sum[0] += bflo(w[k].x); sum[1] += bfhi(w[k].x); sum[2] += bflo(w[k].y); sum[3] += bfhi(w[k].y); sum[4] += bflo(w[k].z); sum[5] += bfhi(w[k].z); sum[6] += bflo(w[k].w); sum[7] += bfhi(w[k].w); }
        const u32x4 ws = w[8]; const float inv = 1.f / (float)(hi - lo);
        u32x4 o; o.x = pk2(sum[0] * inv - bflo(ws.x), sum[1] * inv - bfhi(ws.x)); o.y = pk2(sum[2] * inv - bflo(ws.y), sum[3] * inv - bfhi(ws.y));
        o.z = pk2(sum[4] * inv - bflo(ws.z), sum[5] * inv - bfhi(ws.z)); o.w = pk2(sum[6] * inv - bflo(ws.w), sum[7] * inv - bfhi(ws.w));
        *(u32x4*)(OP + (size_t)row * 512 + 8 * lane) = o;
    }
}

template <bool WINDOW>
__device__ __forceinline__ void attn_unit(LAS unsigned char* lds, int wave, int lane_in, const bf16* Qw, int ldq, const bf16* Kg, int ldk, const bf16* VTg, int ldvt, bf16* Ow, int ldo,
                                          int nkb, int qrel0, float m0, float l0) {
    int lane = lane_in; asm volatile("" : "+v"(lane));
    int lr = lane & 15, quad = lane >> 4;
    const int tid = wave * 64 + lane;
#define ATT_DMA(kb, b) do { _Pragma("unroll") for (int j_ = 0; j_ < 4; ++j_) { const int r_ = 32 * j_ + (tid >> 4), sc_ = 8 * ((tid & 15) ^ (r_ & 15)); \
        __builtin_amdgcn_global_load_lds((const GAS unsigned*)(Kg + (size_t)(128 * (kb) + r_) * ldk + sc_), (LAS unsigned*)(lds + (b) * 65536 + (j_ * 8 + wave) * 1024), 16, 0, 0); \
        __builtin_amdgcn_global_load_lds((const GAS unsigned*)(VTg + (size_t)r_ * ldvt + 128 * (kb) + sc_), (LAS unsigned*)(lds + (b) * 65536 + 32768 + (j_ * 8 + wave) * 1024), 16, 0, 0); } } while (0)
    bf16x8 qf[2][4];
#pragma unroll
    for (int G = 0; G < 2; ++G)
#pragma unroll
        for (int ds = 0; ds < 4; ++ds) qf[G][ds] = *(const bf16x8*)(Qw + (unsigned)((16 * G + lr) * ldq + 32 * ds + 8 * quad));
    ATT_DMA(0, 0);
    f32x4 oacc[2][8];
#pragma unroll
    for (int G = 0; G < 2; ++G)
#pragma unroll
        for (int dt = 0; dt < 8; ++dt) oacc[G][dt] = (f32x4){0.f, 0.f, 0.f, 0.f};
    float mrun[2] = {m0, m0}, lrun[2] = {l0, l0};
#pragma unroll 1
    for (int kb = 0; kb < nkb; ++kb) {
        asm volatile("" : "+v"(lr), "+v"(quad));
        if (kb + 1 < nkb) { ATT_DMA(kb + 1, (kb + 1) & 1); asm volatile("s_waitcnt vmcnt(8)" ::: "memory"); }
        else asm volatile("s_waitcnt vmcnt(0)" ::: "memory");
        asm volatile("" ::: "memory"); __builtin_amdgcn_s_barrier(); asm volatile("" ::: "memory");
        const LAS unsigned char* Kb = lds + (kb & 1) * 65536; const LAS unsigned char* Vb = Kb + 32768;
        f32x4 sacc[2][8];
#pragma unroll
        for (int T = 0; T < 8; ++T) {
            bf16x8 kf[4];
#pragma unroll
            for (int ds = 0; ds < 4; ++ds) kf[ds] = *(const LAS bf16x8*)(Kb + (16 * T + lr) * 256 + 16 * ((4 * ds + quad) ^ lr));
#pragma unroll
            for (int G = 0; G < 2; ++G) { f32x4 cc = (f32x4){0.f, 0.f, 0.f, 0.f};
#pragma unroll
                for (int ds = 0; ds < 4; ++ds) cc = __builtin_amdgcn_mfma_f32_16x16x32_bf16(kf[ds], qf[G][ds], cc, 0, 0, 0);
                sacc[G][T] = cc; }
        }
#pragma unroll
        for (int G = 0; G < 2; ++G) {
            float mx = -3.0e38f;
#pragma unroll
            for (int T = 0; T < 8; ++T)
#pragma unroll
                for (int r = 0; r < 4; ++r) { float t = sacc[G][T][r] * ATT_C1;
                    if (WINDOW) { const int dd = (qrel0 + 16 * G + lr) - (128 * kb + 16 * T + 4 * quad + r); if (dd > 128 || dd < -128) t = -1.0e30f; }
                    sacc[G][T][r] = t; mx = fmaxf(mx, t); }
            mx = fmaxf(mx, __shfl_xor(mx, 16)); mx = fmaxf(mx, __shfl_xor(mx, 32));
            const float mnew = fmaxf(mrun[G], mx), alpha = __builtin_amdgcn_exp2f(mrun[G] - mnew); mrun[G] = mnew;
            float sum = 0.f;
#pragma unroll
            for (int T = 0; T < 8; ++T)
#pragma unroll
                for (int r = 0; r < 4; ++r) { const float p = __builtin_amdgcn_exp2f(sacc[G][T][r] - mnew); sacc[G][T][r] = p; sum += p; }
            sum += __shfl_xor(sum, 16); sum += __shfl_xor(sum, 32);
            lrun[G] = lrun[G] * alpha + sum;
#pragma unroll
            for (int dt = 0; dt < 8; ++dt) oacc[G][dt] = oacc[G][dt] * alpha;
        }
#pragma unroll
        for (int s = 0; s < 4; ++s) {
            bf16x8 pf[2];
#pragma unroll
            for (int G = 0; G < 2; ++G) { u32x4 w; w.x = pk2(sacc[G][2 * s][0], sacc[G][2 * s][1]); w.y = pk2(sacc[G][2 * s][2], sacc[G][2 * s][3]);
                w.z = pk2(sacc[G][2 * s + 1][0], sacc[G][2 * s + 1][1]); w.w = pk2(sacc[G][2 * s + 1][2], sacc[G][2 * s + 1][3]); pf[G] = __builtin_bit_cast(bf16x8, w); }
#pragma unroll
            for (int dt = 0; dt < 8; ++dt) {
                const int p8 = 8 * s + quad;
                const LAS unsigned char* vrow = Vb + (16 * dt + lr) * 256 + 8 * (p8 & 1);
                const u32x2 lo = *(const LAS u32x2*)(vrow + 16 * ((p8 >> 1) ^ lr)), hi = *(const LAS u32x2*)(vrow + 16 * (((p8 >> 1) + 2) ^ lr));
                const bf16x8 vf = __builtin_bit_cast(bf16x8, (u32x4){lo.x, lo.y, hi.x, hi.y});
#pragma unroll
                for (int G = 0; G < 2; ++G) oacc[G][dt] = __builtin_amdgcn_mfma_f32_16x16x32_bf16(vf, pf[G], oacc[G][dt], 0, 0, 0);
            }
        }
        asm volatile("" ::: "memory"); __builtin_amdgcn_s_barrier(); asm volatile("" ::: "memory");
    }
#undef ATT_DMA
#pragma unroll
    for (int G = 0; G < 2; ++G) { const float inv = 1.f / lrun[G];
#pragma unroll
        for (int dt = 0; dt < 8; ++dt) { const f32x4 o = oacc[G][dt] * inv; u32x2 w; w.x = pk2(o[0], o[1]); w.y = pk2(o[2], o[3]);
            *(u32x2*)(Ow + (unsigned)((16 * G + lr) * ldo + 16 * dt + 4 * quad)) = w; } }
}

__device__ __forceinline__ void winattn_unit(KArgs a, int L, LAS unsigned char* lds, int wave, int lane, int unit) {
    unsigned char* ws = (unsigned char*)a->ws;
    const bf16* Q = (const bf16*)(ws + WS_Q); const bf16* K = (const bf16*)(ws + WS_K); const bf16* VT = (const bf16*)(ws + WS_VT); bf16* O = (bf16*)(ws + WS_OATT);
    const float* sink = ((const float*)a->in[I_SINK]) + L * 8;
    const int hkv = unit & 1, row0 = (unit >> 1) * 64, pos0 = row_pos(row0), S = row_slen(row0), qb = pos0 >> 7;
    const int kb_lo = max(qb - 1, 0), kb_hi = min(qb + 1, (S >> 7) - 1), keyrow0 = (row0 - pos0) + 128 * kb_lo;
    const int hq = hkv * 4 + (wave & 3), rw = row0 + 32 * (wave >> 2);
    attn_unit<true>(lds, wave, lane, Q + (size_t)rw * 1024 + hq * 128, 1024, K + (size_t)keyrow0 * 256 + hkv * 128, 256, VT + (size_t)(hkv * 128) * MTOK + keyrow0, MTOK,
                    O + (size_t)rw * 1024 + hq * 128, 1024, kb_hi - kb_lo + 1, (pos0 + 32 * (wave >> 2)) - 128 * kb_lo, sink[hq] * LOG2E, 1.f);
}
constexpr int NQ_ATT = (MTOK / 64) * 2, NQ_POOL = MTOK / 64;
__device__ __forceinline__ void mixq_phase(KArgs a, int L, LAS unsigned char* lds, volatile LAS unsigned* MISC, unsigned* ctr, int wave, int lane) {
    unsigned char* ws = (unsigned char*)a->ws;
    for (;;) {
        if (wave == 0 && lane == 0) MISC[0] = __hip_atomic_fetch_add(ctr, 1u, __ATOMIC_RELAXED, __HIP_MEMORY_SCOPE_AGENT);
        __syncthreads();
        const int u = (int)MISC[0];
        __syncthreads();
        if (u >= NQ_ATT + NQ_POOL) break;
        if (u < NQ_ATT) winattn_unit(a, L, lds, wave, lane, u);
        else { const int r0 = (u - NQ_ATT) * 64 + wave * 8; pool_rows((const bf16*)(ws + WS_UPOOL), (bf16*)(ws + WS_OPOOL), r0, r0 + 8, 1, lane); }
    }
}
__device__ __forceinline__ void xattn_phase(KArgs a, LAS unsigned char* lds, int wave, int lane) {
    unsigned char* ws = (unsigned char*)a->ws;
    const bf16* Q = (const bf16*)(ws + WS_QX); const bf16* K = (const bf16*)(ws + WS_KX); const bf16* VT = (const bf16*)(ws + WS_VXT); bf16* O = (bf16*)(ws + WS_OX);
    for (int unit = blockIdx.x; unit < (MTOK / 256) * 4; unit += gridDim.x) {
        const int h = unit & 3, row0 = (unit >> 2) * 256, seq = row0 < SEQP ? 0 : 1 + ((row0 - SEQP) >> 12), rw = row0 + 32 * wave;
        attn_unit<false>(lds, wave, lane, Q + (size_t)rw * 512 + h * 128, 512, K + (size_t)(MEML * seq) * 512 + h * 128, 512, VT + (size_t)(h * 128) * MMEM + MEML * seq, MMEM,
                         O + (size_t)rw * 512 + h * 128, 512, 2, 0, -1.0e30f, 0.f);
    }
}

__device__ __forceinline__ void prepa_phase(KArgs a, int L, int gw, int NGW, int lane_in) {
    unsigned char* ws = (unsigned char*)a->ws;
    const float* U = (const float*)(ws + WS_URWKV); float* SH = (float*)(ws + WS_SH); float* KB = (float*)(ws + WS_KBUF); bf16* AL = (bf16*)(ws + WS_AL);
    const float* mu0p = ((const float*)a->in[I_MU]) + (size_t)L * 2 * RWC; const float* mu1p = mu0p + RWC; const float* k_k = ((const float*)a->in[I_KK]) + L * 512;
    int lane = lane_in; asm volatile("" : "+v"(lane));
    f32x4 m0[8], m1[8];
#pragma unroll
    for (int j = 0; j < 8; ++j) { const int c = 256 * j + 4 * lane; const bool ok = c < RWC; m0[j] = ok ? *(const f32x4*)(mu0p + c) : (f32x4){0.f, 0.f, 0.f, 0.f}; m1[j] = ok ? *(const f32x4*)(mu1p + c) : (f32x4){0.f, 0.f, 0.f, 0.f}; }
    const f32x4 kk0 = *(const f32x4*)(k_k + 4 * lane), kk1 = *(const f32x4*)(k_k + 256 + 4 * lane);
    const f32x4 zero4 = {0.f, 0.f, 0.f, 0.f};
    for (int run = gw; run < MTOK / 8; run += NGW) {
        const int r0 = run * 8, pos0 = row_pos(r0), S = row_slen(r0);
        f32x4 P[8], C[8], N[8];
        { const float* up = U + (size_t)(r0 - 1) * 2048 + 4 * lane; const float* uc = U + (size_t)r0 * 2048 + 4 * lane; const bool hp = pos0 > 0;
#pragma unroll
          for (int j = 0; j < 8; ++j) { P[j] = hp ? *(const f32x4*)(up + 256 * j) : zero4; C[j] = *(const f32x4*)(uc + 256 * j); } }
#pragma unroll 1
        for (int t = 0; t < 8; ++t) {
            const int row = r0 + t; const bool hn = (pos0 + t) < S - 1;
            { const float* un = U + (size_t)(row + 1) * 2048 + 4 * lane;
#pragma unroll
              for (int j = 0; j < 8; ++j) N[j] = hn ? *(const f32x4*)(un + 256 * j) : zero4; }
            f32x4 xs[8];
#pragma unroll
            for (int j = 0; j < 8; ++j) xs[j] = C[j] + m0[j] * (P[j] - C[j]) + m1[j] * (N[j] - C[j]);
            const int hl = lane >> 4, jj = 4 * (lane & 15);
#pragma unroll
            for (int j2 = 0; j2 < 2; ++j2) { float* sh = SH + ((size_t)row * 8 + 4 * j2 + hl) * 192 + jj;
                *(f32x4*)(sh + 64) = xs[j2]; *(f32x4*)(sh + 128) = xs[4 + j2];
                const f32x4 kv = xs[2 + j2]; *(f32x4*)(KB + (size_t)row * 512 + 256 * j2 + 4 * lane) = kv;
                const f32x4 ku = kv * (j2 ? kk1 : kk0); float ss = (ku[0] * ku[0] + ku[1] * ku[1]) + (ku[2] * ku[2] + ku[3] * ku[3]);
                ss += __shfl_xor(ss, 1); ss += __shfl_xor(ss, 2); ss += __shfl_xor(ss, 4); ss += __shfl_xor(ss, 8);
                const float inv = -1.f / fmaxf(sqrtf(ss), 1e-12f); *(f32x4*)sh = ku * inv; }
            { const f32x4 x6 = xs[6]; f32x4 o6;
#pragma unroll
              for (int e = 0; e < 4; ++e) o6[e] = lane < 32 ? tanhf(x6[e]) : x6[e];
              u32x2 w; w.x = pk2(o6[0], o6[1]); w.y = pk2(o6[2], o6[3]); *(u32x2*)(AL + (size_t)row * 384 + 4 * lane) = w;
              if (lane < 32) { const f32x4 x7 = xs[7]; u32x2 w7; w7.x = pk2(1.f / (1.f + expf(-x7[0])), 1.f / (1.f + expf(-x7[1]))); w7.y = pk2(1.f / (1.f + expf(-x7[2])), 1.f / (1.f + expf(-x7[3])));
                  *(u32x2*)(AL + (size_t)row * 384 + 256 + 4 * lane) = w7; } }
#pragma unroll
            for (int j = 0; j < 8; ++j) { P[j] = C[j]; C[j] = N[j]; }
        }
    }
}

__device__ __forceinline__ void scan_phase(KArgs a, LAS unsigned char* lds, int gw, int NGW, int wave, int lane) {
    unsigned char* ws = (unsigned char*)a->ws;
    const float* SH = (const float*)(ws + WS_SH); const float* DIR = (const float*)(ws + WS_DIR);
    float* Y = (float*)(ws + WS_Y); float* Z = (float*)(ws + WS_Z); float* QM = (float*)(ws + WS_QM); float* PM = (float*)(ws + WS_PM);
    LAS unsigned char* wlb = lds + RING_OFF + wave * 12288;
    for (int task = gw; task < NCP * 16; task += NGW) {
        const int cp = task >> 4, e = (task >> 3) & 1, h = task & 7;
#define SCAN_DMA(bb) do { int ln_ = lane; asm volatile("" : "+v"(ln_)); _Pragma("unroll") for (int pr_ = 0; pr_ < 2; ++pr_) _Pragma("unroll") for (int k_ = 0; k_ < 3; ++k_) { \
            const int o_ = 1024 * k_ + 16 * ln_, stp_ = o_ >= 1536 ? 1 : 0, wi_ = o_ - 1536 * stp_, blk_ = wi_ >= 768 ? 1 : 0, off_ = (wi_ - 768 * blk_) >> 2; \
            const int tau_ = 4 * (bb) + 2 * pr_ + stp_, row_ = cp * CH + (e ? CH - 1 - tau_ : tau_); \
            const float* src_ = blk_ ? DIR + (((size_t)row_ * 2 + e) * 8 + h) * 192 + off_ : SH + ((size_t)row_ * 8 + h) * 192 + off_; \
            __builtin_amdgcn_global_load_lds((const GAS unsigned*)src_, (LAS unsigned*)(wlb + (((bb) & 1) * 4 + 2 * pr_) * 1536 + 1024 * k_), 16, 0, 0); } } while (0)
        LDS_WAIT(); asm volatile("" ::: "memory");
        SCAN_DMA(0);
        asm volatile("" ::: "memory");
        f32x2 S2[32], X2[32];
        { int ln = lane; asm volatile("" : "+v"(ln));
#pragma unroll
          for (int q = 0; q < 32; ++q) { S2[q] = (f32x2){0.f, 0.f}; X2[q] = (f32x2){(2 * q == ln) ? 1.f : 0.f, (2 * q + 1 == ln) ? 1.f : 0.f}; } }
        f32x4 buf[2][8];
#pragma unroll 1
        for (int bb = 0; bb < CH / 4; ++bb) {
            if (bb == 0) asm volatile("s_waitcnt vmcnt(0)" ::: "memory");
            else asm volatile("s_waitcnt vmcnt(8)" ::: "memory");
            if (bb + 1 < CH / 4) SCAN_DMA(bb + 1);
            const LAS float* p0 = (const LAS float*)(wlb + ((bb & 1) * 4) * 1536);
#pragma unroll
            for (int i = 0; i < 8; ++i) buf[0][i] = *(const LAS f32x4*)(p0 + 4 * i);
#pragma unroll 1
            for (int st = 0; st < 4; ++st) {
                const LAS float* p = p0 + st * 384;
                const int tau = 4 * bb + st, row = cp * CH + (e ? CH - 1 - tau : tau);
                const float vi = p[128 + lane];
                f32x2 sa0 = {0.f, 0.f}, sa1 = {0.f, 0.f}, sx0 = {0.f, 0.f}, sx1 = {0.f, 0.f};
#pragma unroll
                for (int i = 0; i < 8; ++i) buf[1][i] = *(const LAS f32x4*)(p + 32 + 4 * i);
                asm volatile("" : "+v"(sa0), "+v"(sx0) :: "memory");
#pragma unroll
                for (int i = 0; i < 8; ++i) { const f32x4 nk = buf[0][i]; sa0 += S2[2 * i] * nk.xy; sa1 += S2[2 * i + 1] * nk.zw; sx0 += X2[2 * i] * nk.xy; sx1 += X2[2 * i + 1] * nk.zw; }
                asm volatile("" : "+v"(sa0), "+v"(sa1), "+v"(sx0), "+v"(sx1) :: "memory");
#pragma unroll
                for (int j = 0; j < 2; ++j) { buf[0][j] = *(const LAS f32x4*)(p + 64 + 4 * j); buf[0][2 + j] = *(const LAS f32x4*)(p + 192 + 4 * j); buf[0][4 + j] = *(const LAS f32x4*)(p + 256 + 4 * j); buf[0][6 + j] = *(const LAS f32x4*)(p + 320 + 4 * j); }
                asm volatile("" : "+v"(sa0), "+v"(sx0) :: "memory");
#pragma unroll
                for (int i = 0; i < 8; ++i) { const f32x4 nk = buf[1][i]; sa0 += S2[16 + 2 * i] * nk.xy; sa1 += S2[16 + 2 * i + 1] * nk.zw; sx0 += X2[16 + 2 * i] * nk.xy; sx1 += X2[16 + 2 * i + 1] * nk.zw; }
                asm volatile("" : "+v"(sa0), "+v"(sa1), "+v"(sx0), "+v"(sx1) :: "memory");
                const float sa = (sa0.x + sa0.y) + (sa1.x + sa1.y), sx = (sx0.x + sx0.y) + (sx1.x + sx1.y);
                const f32x2 sav = {sa, sa}, sxv = {sx, sx}, vv = {vi, vi};
                f32x2 y0 = {0.f, 0.f}, y1 = {0.f, 0.f}, z0 = {0.f, 0.f}, z1 = {0.f, 0.f};
#pragma unroll
                for (int g = 0; g < 8; ++g) {
                    if (g < 7) {
#pragma unroll
                        for (int j = 0; j < 2; ++j) { const int q = 2 * (g + 1) + j; buf[(g + 1) & 1][j] = *(const LAS f32x4*)(p + 64 + 4 * q); buf[(g + 1) & 1][2 + j] = *(const LAS f32x4*)(p + 192 + 4 * q);
                            buf[(g + 1) & 1][4 + j] = *(const LAS f32x4*)(p + 256 + 4 * q); buf[(g + 1) & 1][6 + j] = *(const LAS f32x4*)(p + 320 + 4 * q); }
                    } else if (st < 3) {
#pragma unroll
                        for (int i = 0; i < 8; ++i) buf[0][i] = *(const LAS f32x4*)(p + 384 + 4 * i);
                    }
                    asm volatile("" : "+v"(y0), "+v"(z0) :: "memory");
#pragma unroll
                    for (int j = 0; j < 2; ++j) { const int q = 2 * g + j; const f32x4 r4 = buf[g & 1][j], w4 = buf[g & 1][2 + j], ka4 = buf[g & 1][4 + j], kd4 = buf[g & 1][6 + j];
                        S2[2 * q] = S2[2 * q] * w4.xy + sav * ka4.xy + vv * kd4.xy; y0 += S2[2 * q] * r4.xy;
                        S2[2 * q + 1] = S2[2 * q + 1] * w4.zw + sav * ka4.zw + vv * kd4.zw; y1 += S2[2 * q + 1] * r4.zw;
                        X2[2 * q] = X2[2 * q] * w4.xy + sxv * ka4.xy; z0 += X2[2 * q] * r4.xy;
                        X2[2 * q + 1] = X2[2 * q + 1] * w4.zw + sxv * ka4.zw; z1 += X2[2 * q + 1] * r4.zw; }
                    asm volatile("" : "+v"(y0), "+v"(y1), "+v"(z0), "+v"(z1) :: "memory");
                }
                const size_t oi = (((size_t)row * 2 + e) * 8 + h) * 64 + lane;
                Y[oi] = (y0.x + y0.y) + (y1.x + y1.y); Z[oi] = (z0.x + z0.y) + (z1.x + z1.y);
            }
        }
#undef SCAN_DMA
        float* qo = QM + (size_t)task * 4096 + lane * 64; float* po = PM + (size_t)task * 4096 + lane * 64;
#pragma unroll
        for (int q = 0; q < 16; ++q) { *(f32x4*)(qo + 4 * q) = (f32x4){S2[2 * q].x, S2[2 * q].y, S2[2 * q + 1].x, S2[2 * q + 1].y};
            *(f32x4*)(po + 4 * q) = (f32x4){X2[2 * q].x, X2[2 * q].y, X2[2 * q + 1].x, X2[2 * q + 1].y}; }
    }
}

__device__ __forceinline__ void carry_phase(KArgs a, LAS unsigned char* lds, int wave, int lane_in) {
    const int chain = blockIdx.x;
    if (chain >= NSEQ * 16) return;
    unsigned char* ws = (unsigned char*)a->ws;
    const float* QM = (const float*)(ws + WS_QM); const float* PM = (const float*)(ws + WS_PM); float* SST = (float*)(ws + WS_SST);
    const int seq = chain >> 4, e = (chain >> 3) & 1, h = chain & 7;
    const int cp0 = seq == 0 ? 0 : (SEQP / CH) + (SEQS / CH) * (seq - 1), nc = seq == 0 ? SEQP / CH : SEQS / CH;
    LAS float* ST = (LAS float*)(lds + RING_OFF); LAS float* PB = (LAS float*)(lds + RING_OFF + 16896);
    int lane = lane_in; asm volatile("" : "+v"(lane));
    const int tid = wave * 64 + lane, lr = lane & 15, quad = lane >> 4, ti = wave >> 1, tj0 = 2 * (wave & 1);
    f32x4 sreg[2] = {{0.f, 0.f, 0.f, 0.f}, {0.f, 0.f, 0.f, 0.f}};
    for (int k = tid; k < 64 * 65; k += 512) ST[k] = 0.f;
    f32x4 pn0, pn1; float qn[2][4];
    { const int cp = e ? cp0 + nc - 1 : cp0; const size_t sidx = ((size_t)cp * 2 + e) * 8 + h;
      pn0 = *(const f32x4*)(PM + sidx * 4096 + 4 * tid); pn1 = *(const f32x4*)(PM + sidx * 4096 + 2048 + 4 * tid);
#pragma unroll
      for (int t = 0; t < 2; ++t)
#pragma unroll
          for (int r = 0; r < 4; ++r) qn[t][r] = QM[sidx * 4096 + (size_t)(16 * ti + 4 * quad + r) * 64 + 16 * (tj0 + t) + lr]; }
#pragma unroll 1
    for (int c = 0; c < nc; ++c) {
        const int cp = e ? cp0 + nc - 1 - c : cp0 + c; const size_t sidx = ((size_t)cp * 2 + e) * 8 + h;
#pragma unroll
        for (int t = 0; t < 2; ++t) { const int j = 16 * (tj0 + t) + lr;
#pragma unroll
            for (int r = 0; r < 4; ++r) SST[sidx * 4096 + (size_t)((j >> 2) * 64 + 16 * ti + 4 * quad + r) * 4 + (j & 3)] = sreg[t][r]; }
        if (c == nc - 1) break;
        { const int i0 = 4 * tid, i1 = 2048 + 4 * tid; *(LAS f32x4*)(PB + (i0 >> 6) * 80 + (i0 & 63)) = pn0; *(LAS f32x4*)(PB + (i1 >> 6) * 80 + (i1 & 63)) = pn1; }
        f32x4 acc[2];
#pragma unroll
        for (int t = 0; t < 2; ++t) acc[t] = (f32x4){qn[t][0], qn[t][1], qn[t][2], qn[t][3]};
        if (c + 1 < nc - 1) { const int cpn = e ? cp0 + nc - 2 - c : cp0 + c + 1; const size_t sn = ((size_t)cpn * 2 + e) * 8 + h;
            pn0 = *(const f32x4*)(PM + sn * 4096 + 4 * tid); pn1 = *(const f32x4*)(PM + sn * 4096 + 2048 + 4 * tid);
#pragma unroll
            for (int t = 0; t < 2; ++t)
#pragma unroll
                for (int r = 0; r < 4; ++r) qn[t][r] = QM[sn * 4096 + (size_t)(16 * ti + 4 * quad + r) * 64 + 16 * (tj0 + t) + lr]; }
        __syncthreads();
#pragma unroll
        for (int kk = 0; kk < 16; ++kk) { const float a_ = ST[(16 * ti + lr) * 65 + 4 * kk + quad];
#pragma unroll
            for (int t = 0; t < 2; ++t) { const float b_ = PB[(4 * kk + quad) * 80 + 16 * (tj0 + t) + lr]; acc[t] = __builtin_amdgcn_mfma_f32_16x16x4f32(a_, b_, acc[t], 0, 0, 0); } }
        __syncthreads();
#pragma unroll
        for (int t = 0; t < 2; ++t) {
#pragma unroll
            for (int r = 0; r < 4; ++r) ST[(16 * ti + 4 * quad + r) * 65 + 16 * (tj0 + t) + lr] = acc[t][r];
            sreg[t] = acc[t]; }
    }
}

struct PostIn { float zf[4], zb[4], yv[4], rr[4], vv[4], kd[4], gt[4]; };
__device__ __forceinline__ void post_load(PostIn& q, const float* SH, const float* DIR, const float* Y, const float* Z, const bf16* G, int rowb, int h, int lane) {
#pragma unroll
    for (int u = 0; u < 4; ++u) { const int row = rowb + u; const size_t yi = (((size_t)row * 2) * 8 + h) * 64 + lane;
        q.zf[u] = Z[yi]; q.zb[u] = Z[yi + 512]; q.yv[u] = Y[yi] + Y[yi + 512];
        const float* sh = SH + ((size_t)row * 8 + h) * 192; q.rr[u] = sh[64 + lane]; q.vv[u] = sh[128 + lane];
        q.kd[u] = DIR[(((size_t)row * 2 + 0) * 8 + h) * 192 + 128 + lane] + DIR[(((size_t)row * 2 + 1) * 8 + h) * 192 + 128 + lane];
        q.gt[u] = __uint_as_float(((unsigned)G[(size_t)row * 512 + h * 64 + lane]) << 16); }
}
__device__ __forceinline__ void post_phase(KArgs a, int L, LAS unsigned char* lds, int gw, int NGW, int wave, int lane_in) {
    unsigned char* ws = (unsigned char*)a->ws;
    const float* SH = (const float*)(ws + WS_SH); const float* DIR = (const float*)(ws + WS_DIR); const float* Y = (const float*)(ws + WS_Y); const float* Z = (const float*)(ws + WS_Z);
    const float* SST = (const float*)(ws + WS_SST); const bf16* G = (const bf16*)(ws + WS_G); bf16* O = (bf16*)(ws + WS_ORWKV);
    const float* gng = ((const float*)a->in[I_GNG]) + L * 512; const float* gnb = ((const float*)a->in[I_GNB]) + L * 512; const float* rk = ((const float*)a->in[I_RK]) + L * 512;
    LAS float* zl = (LAS float*)(lds + RING_OFF + wave * 2048);
    for (int task = gw; task < NCP * 16; task += NGW) {
        int lane = lane_in; asm volatile("" : "+v"(lane));
        const int cp = task >> 4, hf = (task >> 3) & 1, h = task & 7;
        PostIn cur, nxt;
        post_load(cur, SH, DIR, Y, Z, G, cp * CH + hf * 64, h, lane);
        f32x2 Sf[32], Sb[32];
        { const float* sf = SST + (((size_t)cp * 2 + 0) * 8 + h) * 4096 + lane * 4; const float* sb = SST + (((size_t)cp * 2 + 1) * 8 + h) * 4096 + lane * 4;
#pragma unroll
          for (int q = 0; q < 16; ++q) { const f32x4 x = *(const f32x4*)(sf + q * 256), y = *(const f32x4*)(sb + q * 256); Sf[2 * q] = x.xy; Sf[2 * q + 1] = x.zw; Sb[2 * q] = y.xy; Sb[2 * q + 1] = y.zw; } }
        const float gg = gng[h * 64 + lane], gb = gnb[h * 64 + lane], rkk = rk[h * 64 + lane];
#pragma unroll 1
        for (int tb = 0; tb < 16; ++tb) {
            const int rowb = cp * CH + hf * 64 + tb * 4;
            if (tb < 15) post_load(nxt, SH, DIR, Y, Z, G, rowb + 4, h, lane);
            LDS_WAIT(); asm volatile("" ::: "memory");
#pragma unroll
            for (int u = 0; u < 4; ++u) { zl[(u * 2 + 0) * 64 + lane] = cur.zf[u]; zl[(u * 2 + 1) * 64 + lane] = cur.zb[u]; }
            LDS_WAIT(); asm volatile("" ::: "memory");
            float y[4], sbn[4];
#pragma unroll
            for (int u = 0; u < 4; ++u) {
                f32x2 c0 = {0.f, 0.f}, c1 = {0.f, 0.f};
#pragma unroll
                for (int q = 0; q < 16; ++q) { const f32x4 f4 = *(const LAS f32x4*)(zl + (u * 2 + 0) * 64 + 4 * q), b4 = *(const LAS f32x4*)(zl + (u * 2 + 1) * 64 + 4 * q);
                    c0 += Sf[2 * q] * f4.xy + Sb[2 * q] * b4.xy; c1 += Sf[2 * q + 1] * f4.zw + Sb[2 * q + 1] * b4.zw; }
                y[u] = cur.yv[u] + (c0.x + c0.y) + (c1.x + c1.y); sbn[u] = cur.rr[u] * cur.kd[u] * rkk;
            }
            float mean[4];
#pragma unroll
            for (int u = 0; u < 4; ++u) mean[u] = y[u];
#pragma unroll
            for (int o = 1; o < 64; o <<= 1)
#pragma unroll
                for (int u = 0; u < 4; ++u) { mean[u] += __shfl_xor(mean[u], o); sbn[u] += __shfl_xor(sbn[u], o); }
            float var[4];
#pragma unroll
            for (int u = 0; u < 4; ++u) { y[u] -= mean[u] * (1.f / 64.f); var[u] = y[u] * y[u]; }
#pragma unroll
            for (int o = 1; o < 64; o <<= 1)
#pragma unroll
                for (int u = 0; u < 4; ++u) var[u] += __shfl_xor(var[u], o);
#pragma unroll
            for (int u = 0; u < 4; ++u) { const float yn = y[u] * (1.f / sqrtf(var[u] * (1.f / 64.f) + GN_EPS)) * gg + gb;
                const float o = (yn + sbn[u] * cur.vv[u]) * cur.gt[u];
                O[(size_t)(rowb + u) * 512 + h * 64 + lane] = (bf16)(pk2(o, 0.f) & 0xffffu); }
            cur = nxt;
        }
    }
}

#define SEAM() do { if (a.single) { XcdBarrier b_ = bar; asm volatile("" : "+s"(b_.bar), "+s"(b_.x)); xcd_barrier(b_); } } while (0)
#ifndef PHMASK
#define PHMASK 0x1ffff
#endif
#ifndef DUPMASK
#define DUPMASK 0
#endif
#define RUN(k) ((((PHMASK) >> (k)) & 1) && a.ph_lo <= (k) && (k) < a.ph_hi)
#define REP(k) for (int rep_ = 0; rep_ < (((DUPMASK) >> (k)) & 1) + 1; ++rep_)
#define KA() KArgs ka = (KArgs)__builtin_amdgcn_kernarg_segment_ptr(); asm volatile("" : "+s"(ka)); unsigned char* ws = (unsigned char*)ka->ws; float* X = (float*)ka->out; unsigned short* XH = (unsigned short*)ka->out; unsigned short* XF = (unsigned short*)(ws + WS_GATES); (void)XH; (void)XF; bf16* XB = (bf16*)(ws + WS_XB); (void)X; (void)XB
#define IDS() KA(); const int lane = hw_lane(), wave = wave_s, tid = wave * 64 + lane, gw = blockIdx.x * NWAVES + wave, gtid = blockIdx.x * (NWAVES * 64) + tid; (void)lane; (void)gw; (void)gtid; (void)tid


template <int IT> __device__ __forceinline__ void half_layer(const Args& a, LAS unsigned char* lds, const XcdBarrier& bar, int G, int NGW, int NT, int wave_s) {
    constexpr int it = IT;
        const int L = it >> 1, s = it & 1;
        REP(0) if (s == 0 && RUN(0)) { IDS(); conv_phase(ka, L, lds, gw, NGW, wave, lane, gtid, NT); if (it == 0) prologue_phase(ka, gtid, NT); __syncthreads(); SEAM(); }
        REP(1) if (RUN(1)) {
            KA();
            pg8::Gemm g{XB, (const bf16*)(ws + WS_W1T) + (size_t)s * 2 * DFF * D, MTOK, 2 * DFF, D}; pg8::StaticOrder S; S.init(MTOK, 2 * DFF, G, (int)blockIdx.x);
            pg8::EpiSwiglu E{(bf16*)(ws + WS_H)};
            pg8::gemm_phase<pg8::EpiSwiglu, pg8::StaticOrder, true, true>(lds + RING_OFF, g, S, E, wave_s);
            SEAM();
        }
        REP(2) if (RUN(2)) {
            KA();
            pg8::Gemm g{(const bf16*)(ws + WS_H), (const bf16*)(ws + WS_W2T) + (size_t)s * D * DFF, MTOK, D, DFF}; pg8::StaticOrder S; S.init(MTOK, D, G, (int)blockIdx.x, 4);
            constexpr int pli = it == 0 ? 0 : (s == 0 ? ((L - 1) * 4 + 3) : (L * 4 + 2));
            if constexpr (it == 0) { pg8::EpiResidH<false, true, false> E{XH, XF, nullptr, (const float*)ka->in[I_XP], (const float*)ka->in[I_XS]};
                pg8::gemm_phase<pg8::EpiResidH<false, true, false>, pg8::StaticOrder, true, true>(lds + RING_OFF, g, S, E, wave_s); }
            else { constexpr bool last = (it == 2 * DEPTH - 1); pg8::EpiResidH<true, true, last> E{XH, XF, (const float*)(ws + WS_STATS), ((const float*)ka->in[I_LNG]) + pli * D, ((const float*)ka->in[I_LNB]) + pli * D};
                pg8::gemm_phase<pg8::EpiResidH<true, true, last>, pg8::StaticOrder, true, true>(lds + RING_OFF, g, S, E, wave_s); }
            SEAM();
        }
        REP(3) if (RUN(3)) { IDS(); const int li = (L * 4 + (s ? 3 : 0)) * D; if constexpr (it == 2 * DEPTH - 1) ln_phase_h<true>(XF, XB, X, ((const float*)ka->in[I_LNG]) + li, ((const float*)ka->in[I_LNB]) + li, (float*)(ws + WS_STATS), gw, NGW, lane);
            else ln_phase_h<false>(XH, XB, X, ((const float*)ka->in[I_LNG]) + li, ((const float*)ka->in[I_LNB]) + li, (float*)(ws + WS_STATS), gw, NGW, lane); SEAM(); }
        if (s == 0) {
            REP(4) if (RUN(4)) {
                KA();
                { pg8::Gemm g{XB, (const bf16*)(ws + WS_WINT), MTOK, NWIN, D}; pg8::StaticOrder S; S.init(MTOK, NWIN, G, (int)blockIdx.x);
                  pg8::EpiWin E{(bf16*)(ws + WS_UPOOL), (bf16*)(ws + WS_Q), (bf16*)(ws + WS_K), (bf16*)(ws + WS_GATES), (float*)(ws + WS_URWKV), (const float*)(ws + WS_CS), (bf16*)(ws + WS_VT)};
                  pg8::gemm_phase<pg8::EpiWin, pg8::StaticOrder, true, true>(lds + RING_OFF, g, S, E, wave_s); }
                SEAM();
            }
            REP(5) if (RUN(5)) {
                IDS();
                REP(19) prepa_phase(ka, L, gw, NGW, lane);
                SEAM();
            }
            REP(6) if (RUN(6)) {
                KA();
                pg8::Gemm g{(const bf16*)(ws + WS_AL), (const bf16*)(ws + WS_BL), MTOK, 2560, 384}; pg8::StaticOrder S; S.init(MTOK, 2560, G, (int)blockIdx.x);
                pg8::EpiLora E{((const float*)ka->in[I_W0]) + L * 1024, ((const float*)ka->in[I_A0]) + L * 1024, ((const float*)ka->in[I_KA]) + L * 512, (const float*)(ws + WS_SH), (const float*)(ws + WS_KBUF), (float*)(ws + WS_DIR), (bf16*)(ws + WS_G)};
                pg8::gemm_phase<pg8::EpiLora, pg8::StaticOrder, true, true>(lds + RING_OFF, g, S, E, wave_s);
                SEAM();
            }
            REP(7) if (RUN(7)) { IDS(); scan_phase(ka, lds, gw, NGW, wave, lane); SEAM(); }
            REP(8) if (RUN(8)) { IDS(); carry_phase(ka, lds, wave, lane); __syncthreads();
                mixq_phase(ka, L, lds, (volatile LAS unsigned*)(lds + MISC_OFF), (unsigned*)((unsigned long long)ka->ws + WS_CTL + 65536 + 256 * (L * 2 + rep_)), wave, lane); SEAM(); }
            REP(9) if (RUN(9)) { IDS(); post_phase(ka, L, lds, gw, NGW, wave, lane); SEAM(); }
            REP(10) if (RUN(10)) {
                KA();
#pragma unroll 1
                for (int b = 0; b < 3; ++b) {
                    const bf16* Ab = (const bf16*)(ws + (b == 0 ? WS_OPOOL : (b == 1 ? WS_OATT : WS_ORWKV)));
                    const bf16* Bb = (const bf16*)(ws + (b == 0 ? WS_WBR0 : (b == 1 ? WS_WBR1 : WS_WBR2)));
                    pg8::Gemm g{Ab, Bb, MTOK, D, b == 1 ? 1024 : 512}; pg8::StaticOrder S; S.init(MTOK, D, G, (int)blockIdx.x, 4);
                    pg8::EpiBranch E{(bf16*)(ws + WS_MERGED), (const bf16*)(ws + WS_GATES) + b * D, b == 0 ? 1 : 0};
                    pg8::gemm_phase<pg8::EpiBranch, pg8::StaticOrder, true, true>(lds + RING_OFF, g, S, E, wave_s);
                }
                SEAM();
            }
            REP(11) if (RUN(11)) {
                KA();
                pg8::Gemm g{(const bf16*)(ws + WS_MERGED), (const bf16*)(ws + WS_WOUT), MTOK, D, D}; pg8::StaticOrder S; S.init(MTOK, D, G, (int)blockIdx.x, 4);
                pg8::EpiResidH<true, false, false> E{XH, XF, (const float*)(ws + WS_STATS), ((const float*)ka->in[I_LNG]) + (L * 4 + 0) * D, ((const float*)ka->in[I_LNB]) + (L * 4 + 0) * D};
                pg8::gemm_phase<pg8::EpiResidH<true, false, false>, pg8::StaticOrder, true, true>(lds + RING_OFF, g, S, E, wave_s);
                SEAM();
            }
            REP(12) if (RUN(12)) { IDS(); const int li = (L * 4 + 1) * D; ln_phase_h<false>(XH, XB, X, ((const float*)ka->in[I_LNG]) + li, ((const float*)ka->in[I_LNB]) + li, (float*)(ws + WS_STATS), gw, NGW, lane); SEAM(); }
            REP(13) if (RUN(13)) {
                KA();
                static_assert((WS_XB & (MiB - 1)) == 0 && (WS_WQ & (MiB - 1)) == 0 && (WS_MEMB & (MiB - 1)) == 0 && (WS_WKV & (MiB - 1)) == 0 && WS_MEMB < WS_WKV && WS_WKV < WS_XB, "XqOrder indexes 1-MiB operand tiles of d_ws");
                pg8::Gemm g{(const bf16*)ws, (const bf16*)ws, 0, 0, D}; pg8::XqOrder S{G, (int)blockIdx.x};
                pg8::EpiXq E{(bf16*)(ws + WS_QX), (bf16*)(ws + WS_KX), (bf16*)(ws + WS_VXT)};
                pg8::gemm_phase<pg8::EpiXq, pg8::XqOrder, true, true>(lds + RING_OFF, g, S, E, wave_s);
                SEAM();
            }
            REP(14) if (RUN(14)) { IDS(); xattn_phase(ka, lds, wave, lane); SEAM(); }
            REP(15) if (RUN(15)) {
                KA();
                pg8::Gemm g{(const bf16*)(ws + WS_OX), (const bf16*)(ws + WS_WO), MTOK, D, 512}; pg8::StaticOrder S; S.init(MTOK, D, G, (int)blockIdx.x, 4);
                pg8::EpiResidH<true, false, false> E{XH, XF, (const float*)(ws + WS_STATS), ((const float*)ka->in[I_LNG]) + (L * 4 + 1) * D, ((const float*)ka->in[I_LNB]) + (L * 4 + 1) * D};
                pg8::gemm_phase<pg8::EpiResidH<true, false, false>, pg8::StaticOrder, true, true>(lds + RING_OFF, g, S, E, wave_s);
                SEAM();
            }
            REP(16) if (RUN(16)) { IDS(); const int li = (L * 4 + 2) * D; ln_phase_h<false>(XH, XB, X, ((const float*)ka->in[I_LNG]) + li, ((const float*)ka->in[I_LNB]) + li, (float*)(ws + WS_STATS), gw, NGW, lane); SEAM(); }
        }
}

__global__ void __launch_bounds__(NWAVES * 64, 2) fwd_kernel(Args a) {
    extern __shared__ __attribute__((aligned(16))) unsigned char lds_raw[];
    LAS unsigned char* lds = (LAS unsigned char*)lds_raw;
    volatile LAS unsigned* MISC = (volatile LAS unsigned*)(lds + MISC_OFF);
    const int G = gridDim.x, NGW = G * NWAVES, NT = G * NWAVES * 64, wave_s = __builtin_amdgcn_readfirstlane((int)threadIdx.x >> 6);
    { const int t0 = wave_s * 64 + hw_lane(); for (int u = t0; u < (LDS_BYTES - LDSCTL_OFF) / 4; u += NWAVES * 64) ((LAS unsigned*)(lds + LDSCTL_OFF))[u] = 0u; }
    __syncthreads();
    unsigned* const barw = (unsigned*)((unsigned long long)a.ws + WS_CTL + 4096 * 4);
    XcdBarrier bar; bar.bar = barw; bar.x = 0; bar.st = nullptr; bar.wv = (unsigned)wave_s;
    if (a.single) bar = xcd_barrier_post(barw, MISC + 8, (unsigned)wave_s);
    if (0 >= a.it_lo && 0 < a.it_hi) half_layer<0>(a, lds, bar, G, NGW, NT, wave_s);
    if (1 >= a.it_lo && 1 < a.it_hi) half_layer<1>(a, lds, bar, G, NGW, NT, wave_s);
    if (2 >= a.it_lo && 2 < a.it_hi) half_layer<2>(a, lds, bar, G, NGW, NT, wave_s);
    if (3 >= a.it_lo && 3 < a.it_hi) half_layer<3>(a, lds, bar, G, NGW, NT, wave_s);
    if (4 >= a.it_lo && 4 < a.it_hi) half_layer<4>(a, lds, bar, G, NGW, NT, wave_s);
    if (5 >= a.it_lo && 5 < a.it_hi) half_layer<5>(a, lds, bar, G, NGW, NT, wave_s);
    if (6 >= a.it_lo && 6 < a.it_hi) half_layer<6>(a, lds, bar, G, NGW, NT, wave_s);
    if (7 >= a.it_lo && 7 < a.it_hi) half_layer<7>(a, lds, bar, G, NGW, NT, wave_s);
}
#undef SEAM
#undef RUN

#ifndef MK_SINGLE
#define MK_SINGLE 1
#endif
extern "C" void kernel_launch(void* const* d_in, const int* in_sizes, int n_in, void* d_out, int out_size, void* d_ws, size_t ws_size, hipStream_t stream) {
    static int grid = 0;
    if (grid == 0) {
        if (n_in != 28 || out_size != MTOK * D || ws_size < WS_END) { fprintf(stderr, "kernel_launch: unexpected problem (n_in %d, out %d, ws %zu < %zu); nothing launched\n", n_in, out_size, ws_size, (size_t)WS_END); grid = -1; return; }
        int dev = 0, cus = 0, per_cu = 0;
        if (hipGetDevice(&dev) != hipSuccess || hipDeviceGetAttribute(&cus, hipDeviceAttributeMultiprocessorCount, dev) != hipSuccess) { grid = -1; return; }
        if (hipFuncSetAttribute((const void*)fwd_kernel, hipFuncAttributeMaxDynamicSharedMemorySize, LDS_BYTES) != hipSuccess) { fprintf(stderr, "kernel_launch: hipFuncSetAttribute failed\n"); grid = -1; return; }
        if (hipOccupancyMaxActiveBlocksPerMultiprocessor(&per_cu, (const void*)fwd_kernel, NWAVES * 64, LDS_BYTES) != hipSuccess || per_cu < 1) { fprintf(stderr, "kernel_launch: occupancy query says %d blocks per CU; nothing launched\n", per_cu); (void)hipGetLastError(); grid = -1; return; }
        grid = cus;
    }
    if (grid < 0) return;
    (void)hipMemsetAsync((char*)d_ws + WS_CTL, 0, CTL_ZERO_BYTES, stream);
    Args a{};
    for (int i = 0; i < 28; ++i) a.in[i] = (const GAS float*)d_in[i];
    a.out = (GAS float*)d_out; a.ws = (GAS unsigned char*)d_ws; a.pad = 0;
#if MK_SINGLE
    a.it_lo = 0; a.it_hi = 2 * DEPTH; a.ph_lo = 0; a.ph_hi = 17; a.single = 1;
    hipLaunchKernelGGL(fwd_kernel, dim3(grid), dim3(NWAVES * 64), LDS_BYTES, stream, a);
#else
    a.single = 0;
    for (int it = 0; it < 2 * DEPTH; ++it)
        for (int ph = 0; ph < 17; ++ph) {
            if ((it & 1) && (ph == 0 || ph > 3)) continue;
            a.it_lo = it; a.it_hi = it + 1; a.ph_lo = ph; a.ph_hi = ph + 1;
            hipLaunchKernelGGL(fwd_kernel, dim3(grid), dim3(NWAVES * 64), LDS_BYTES, stream, a);
        }
#endif
}
```

```cpp
#include <hip/hip_runtime.h>
#include <cstdio>
#include <cstdint>
#include <cmath>
constexpr int D = 2048, DFF = 5632, DEPTH = 4;
constexpr int SEQP = 16384, SEQS = 4096, NSAMP = 8, NSEQ = 9;
constexpr int MTOK = SEQP + NSAMP * SEQS;
constexpr int MEML = 256, MMEM = NSEQ * MEML;
constexpr int INC = 10112, NWIN = 10240;
constexpr int RWC = 1920;
constexpr float ALPHA = 1.681792830507429f;
constexpr float LN_EPS = 1e-5f, GN_EPS = 64e-5f;
constexpr int CH = 128;
constexpr int NCP = MTOK / CH;
constexpr float LOG2E = 1.4426950408889634f;
constexpr float ATT_C1 = 0.08838834764831845f * 1.4426950408889634f;

constexpr size_t MiB = 1u << 20;
constexpr size_t WS_CTL = 0, CTL_ZERO_BYTES = 1 * MiB;
constexpr size_t WS_CS = 1 * MiB;
constexpr size_t WS_MEMB = 9 * MiB;
constexpr size_t WS_W1T = 18 * MiB;
constexpr size_t WS_W2T = 106 * MiB;
constexpr size_t WS_WINT = 150 * MiB;
constexpr size_t WS_WBR0 = 190 * MiB;
constexpr size_t WS_WBR1 = 192 * MiB;
constexpr size_t WS_WBR2 = 196 * MiB;
constexpr size_t WS_WOUT = 198 * MiB;
constexpr size_t WS_WQ = 206 * MiB;
constexpr size_t WS_WKV = 208 * MiB;
constexpr size_t WS_WO = 212 * MiB;
constexpr size_t WS_BL = 214 * MiB;
constexpr size_t WS_XB = 216 * MiB;
constexpr size_t WS_RA = 408 * MiB;
constexpr size_t WS_Q = WS_RA;
constexpr size_t WS_K = WS_RA + 96 * MiB;
constexpr size_t WS_VT = WS_RA + 120 * MiB;
constexpr size_t WS_UPOOL = WS_RA + 144 * MiB;
constexpr size_t WS_URWKV = WS_RA + 192 * MiB;
constexpr size_t WS_GATES = WS_RA + 576 * MiB;
constexpr size_t WS_PM = WS_XB;
constexpr size_t WS_QM = WS_XB + 96 * MiB;
constexpr size_t WS_Y = WS_RA + 192 * MiB;
constexpr size_t WS_Z = WS_RA + 384 * MiB;
constexpr size_t WS_H = WS_RA;
constexpr size_t WS_QX = WS_RA;
constexpr size_t WS_KX = WS_RA + 48 * MiB;
constexpr size_t WS_VXT = WS_RA + 51 * MiB;
constexpr size_t WS_OX = WS_RA + 54 * MiB;
constexpr size_t WS_OPOOL = 1560 * MiB;
constexpr size_t WS_OATT = 1608 * MiB;
constexpr size_t WS_ORWKV = 1704 * MiB;
constexpr size_t WS_SH = 1752 * MiB;
constexpr size_t WS_MERGED = WS_SH;
constexpr size_t WS_DIR = 2040 * MiB;
constexpr size_t WS_KBUF = 2616 * MiB;
constexpr size_t WS_SST = WS_KBUF;
constexpr size_t WS_G = 2712 * MiB;
constexpr size_t WS_AL = 2760 * MiB;
constexpr size_t WS_STATS = 2796 * MiB;
constexpr size_t WS_END = 2797 * MiB;
static_assert(WS_GATES + 576 * MiB == WS_OPOOL, "region A");

typedef unsigned short bf16;
namespace pg8 {
#define PG8_LAS __attribute__((address_space(3)))
typedef unsigned short bf16_t;
typedef short bf16x8 __attribute__((ext_vector_type(8)));
typedef float f32x4 __attribute__((ext_vector_type(4)));
typedef unsigned u32x4 __attribute__((ext_vector_type(4)));
constexpr int BM = 256, BK = 64, HALF = 128, HTB = HALF * BK * 2  , STAGE_BYTES = 8 * HTB, NXCD = 8, WGM = 8;

__host__ __device__ __forceinline__ int lds_byte(int r, int c) { const int st = (r >> 4) * 2 + (c >> 5), rr = r & 15, cc = c & 31, ob = rr * 64 + cc * 2; return st * 1024 + (ob ^ (((ob >> 9) & 1) << 5)); }
__host__ __device__ __forceinline__ void stage_rc(int b, int& R, int& C) { const int st = b / 1024, sb = b % 1024, swz = sb ^ (((sb >> 9) & 1) << 5); R = (st >> 1) * 16 + swz / 64; C = (st & 1) * 32 + (swz % 64) / 2; }
__host__ __device__ __forceinline__ int perm32(int rho) { const int n = rho >> 4, i = rho & 15; return 8 * (i >> 2) + 4 * n + (i & 3); }

struct Unit { int pm, pn; };
struct Gemm { const bf16_t* A; const bf16_t* Bt; int M, N, K; };

struct StaticOrder {
    int nM, nN, nwg, G, c, wgm;
    __host__ __device__ void init(int M, int N, int G_, int c_, int wgm_ = WGM) { nM = M / BM; nN = N / BM; nwg = nM * nN; G = G_; c = c_; wgm = wgm_; }
    __host__ __device__ bool next(int i, Unit& u) const {
        const long L = (long)i * G + c; if (L >= nwg) return false;
        int wgid = (int)L; { const int q = nwg / NXCD, r = nwg % NXCD, xcd = wgid % NXCD, off = wgid / NXCD; wgid = (xcd < r ? xcd * (q + 1) : r * (q + 1) + (xcd - r) * q) + off; }
        const int nig = wgm * nN, gid = wgid / nig, fm = gid * wgm, gsz = (nM - fm) < wgm ? (nM - fm) : wgm;
        u.pm = fm + ((wgid % nig) % gsz); u.pn = (wgid % nig) / gsz; return true;
    }
    __device__ __forceinline__ void a_ready(const Unit&) const {}
    __device__ __forceinline__ void done(const Unit&) const {}
};

__device__ __forceinline__ unsigned cvt_pk_bf16(float lo, float hi) { unsigned r; asm volatile("v_cvt_pk_bf16_f32 %0, %1, %2" : "=v"(r) : "v"(lo), "v"(hi)); return r; }
typedef float f32x2 __attribute__((ext_vector_type(2)));
typedef unsigned u32x2 __attribute__((ext_vector_type(2)));
__device__ __forceinline__ int lane_now() { int l; asm volatile("v_mbcnt_lo_u32_b32 %0, -1, 0\n\tv_mbcnt_hi_u32_b32 %0, -1, %0" : "=v"(l)); return l; }
__device__ __forceinline__ float sigm(float x) { return __builtin_amdgcn_rcpf(1.f + __builtin_amdgcn_exp2f(-x * LOG2E)); }
__device__ __forceinline__ float bf_lo(unsigned w) { return __uint_as_float(w << 16); }
__device__ __forceinline__ float bf_hi(unsigned w) { return __uint_as_float(w & 0xffff0000u); }

struct EpiSwiglu {
    static constexpr bool PERM = true, AFTER_DRAIN = false;
    bf16_t* H;
    __device__ __forceinline__ void operator()(const f32x4 (&acc)[2][2][4][2], const Unit& u, int wr, int wc, int, int) const {
        const int ln_ = lane_now(), fr = ln_ & 15, fq = ln_ >> 4;
        const int row0 = u.pm * BM + wr * 64 + fr, col0 = u.pn * 128 + wc * 32 + 8 * fq;
#pragma unroll
        for (int ai = 0; ai < 2; ++ai)
#pragma unroll
            for (int m = 0; m < 4; ++m) {
                bf16_t* rowp = H + (size_t)(row0 + ai * HALF + m * 16) * DFF + col0;
                float o[8];
#pragma unroll
                for (int n = 0; n < 2; ++n)
#pragma unroll
                    for (int e = 0; e < 4; ++e) { const float g = acc[ai][0][m][n][e], up = acc[ai][1][m][n][e]; o[4 * n + e] = g * sigm(g) * up; }
                u32x4 w; w.x = cvt_pk_bf16(o[0], o[1]); w.y = cvt_pk_bf16(o[2], o[3]); w.z = cvt_pk_bf16(o[4], o[5]); w.w = cvt_pk_bf16(o[6], o[7]);
                __builtin_nontemporal_store(w, (u32x4*)rowp);
            }
    }
};
template <bool NORM, bool HALFSC> struct EpiResid {
    static constexpr bool PERM = false, AFTER_DRAIN = false;
    float* X; const float* stats; const float* g; const float* b;
    __device__ __forceinline__ void operator()(const f32x4 (&acc)[2][2][4][2], const Unit& u, int wr, int wc, int, int) const {
        const int ln_ = lane_now(), fr = ln_ & 15, fq = ln_ >> 4;
        const int row0 = u.pm * BM + wr * 64 + fr, col0 = u.pn * BM + wc * 32 + 4 * fq;
        float* const Xp = X; const float al = ALPHA, sc = HALFSC ? 0.5f : 1.f; const float* const stp = stats; const float* const gp = g + col0; const float* const bp = b + col0;
        f32x4 gg[2][2], bb[2][2]; f32x2 st_[2][4];
        if (NORM) {
#pragma unroll
            for (int bj = 0; bj < 2; ++bj)
#pragma unroll
                for (int n = 0; n < 2; ++n) { gg[bj][n] = *(const f32x4*)(gp + bj * HALF + n * 16); bb[bj][n] = *(const f32x4*)(bp + bj * HALF + n * 16); }
#pragma unroll
            for (int ai = 0; ai < 2; ++ai)
#pragma unroll
                for (int m = 0; m < 4; ++m) st_[ai][m] = *(const f32x2*)(stp + 2 * (size_t)(row0 + ai * HALF + m * 16));
        }
#pragma unroll
        for (int ai = 0; ai < 2; ++ai)
#pragma unroll
            for (int m = 0; m < 4; ++m) {
                const int row = row0 + ai * HALF + m * 16;
                float* rowp = Xp + (size_t)row * D + col0;
#pragma unroll
                for (int bj = 0; bj < 2; ++bj)
#pragma unroll
                    for (int n = 0; n < 2; ++n) { f32x4* p = (f32x4*)(rowp + bj * HALF + n * 16); f32x4 x;
                        if (NORM) { x = *p; x = (x - st_[ai][m].x) * st_[ai][m].y * gg[bj][n] + bb[bj][n]; }
                        else x = *(const f32x4*)((row < SEQP ? gp + (size_t)row * D : bp + (size_t)(row - SEQP) * D) + bj * HALF + n * 16);
                        *p = x * al + acc[ai][bj][m][n] * sc; }
                if (m & 1) asm volatile("" ::: "memory");
            }
    }
};
typedef _Float16 f16x2_t __attribute__((ext_vector_type(2)));
__device__ __forceinline__ f32x2 h2f(unsigned w) { const f16x2_t h = __builtin_bit_cast(f16x2_t, w); return (f32x2){(float)h[0], (float)h[1]}; }
__device__ __forceinline__ unsigned f2h(float a, float b) { f16x2_t h; h[0] = (_Float16)__builtin_amdgcn_fmed3f(a, -65504.f, 65504.f); h[1] = (_Float16)__builtin_amdgcn_fmed3f(b, -65504.f, 65504.f);
    return __builtin_bit_cast(unsigned, h); }
template <bool NORM, bool HALFSC, bool LAST> struct EpiResidH {
    static constexpr bool PERM = true, AFTER_DRAIN = false;
    unsigned short* XH; unsigned short* XF; const float* stats; const float* g; const float* b;
    __device__ __forceinline__ void operator()(const f32x4 (&acc)[2][2][4][2], const Unit& u, int wr, int wc, int, int) const {
        const int ln_ = lane_now(), fr = ln_ & 15, fq = ln_ >> 4;
        const int row0 = u.pm * BM + wr * 64 + fr, col0 = u.pn * BM + wc * 32 + 8 * fq;
        unsigned short* const Xp = XH; unsigned short* const Fp = XF; const float al = ALPHA, sc = HALFSC ? 0.5f : 1.f; const float* const stp = stats; const float* const gp = g + col0; const float* const bp = b + col0;
        f32x4 gg[2][2], bb[2][2]; f32x2 st_[2][4];
        if (NORM) {
#pragma unroll
            for (int bj = 0; bj < 2; ++bj)
#pragma unroll
                for (int n = 0; n < 2; ++n) { gg[bj][n] = *(const f32x4*)(gp + bj * HALF + n * 4); bb[bj][n] = *(const f32x4*)(bp + bj * HALF + n * 4); }
#pragma unroll
            for (int ai = 0; ai < 2; ++ai)
#pragma unroll
                for (int m = 0; m < 4; ++m) st_[ai][m] = *(const f32x2*)(stp + 2 * (size_t)(row0 + ai * HALF + m * 16));
        }
#pragma unroll
        for (int ai = 0; ai < 2; ++ai) {
            u32x4 hv[4][2];
            if (NORM) {
#pragma unroll
                for (int m = 0; m < 4; ++m)
#pragma unroll
                    for (int bj = 0; bj < 2; ++bj) hv[m][bj] = *(const u32x4*)(Xp + (size_t)(row0 + ai * HALF + m * 16) * D + col0 + bj * HALF);
                asm volatile("" ::: "memory");
            }
#pragma unroll
            for (int m = 0; m < 4; ++m) {
                const int row = row0 + ai * HALF + m * 16;
                unsigned short* rowp = Xp + (size_t)row * D + col0;
                f32x4 xi[2][2];
                if (!NORM) {
#pragma unroll
                    for (int bj = 0; bj < 2; ++bj) { const float* src = (row < SEQP ? gp + (size_t)row * D : bp + (size_t)(row - SEQP) * D) + bj * HALF; xi[bj][0] = *(const f32x4*)src; xi[bj][1] = *(const f32x4*)(src + 4); }
                    if (m & 1) asm volatile("" ::: "memory"); }
#pragma unroll
                for (int bj = 0; bj < 2; ++bj) { f32x4 x0, x1;
                    if (NORM) { const u32x4 h4 = hv[m][bj]; const f32x2 a0 = h2f(h4.x), a1 = h2f(h4.y), a2 = h2f(h4.z), a3 = h2f(h4.w);
                        x0 = ((f32x4){a0.x, a0.y, a1.x, a1.y} - st_[ai][m].x) * st_[ai][m].y * gg[bj][0] + bb[bj][0];
                        x1 = ((f32x4){a2.x, a2.y, a3.x, a3.y} - st_[ai][m].x) * st_[ai][m].y * gg[bj][1] + bb[bj][1]; }
                    else { x0 = xi[bj][0]; x1 = xi[bj][1]; }
                    const f32x4 o0 = x0 * al + acc[ai][bj][m][0] * sc, o1 = x1 * al + acc[ai][bj][m][1] * sc;
                    u32x4 w; w.x = f2h(o0[0], o0[1]); w.y = f2h(o0[2], o0[3]); w.z = f2h(o1[0], o1[1]); w.w = f2h(o1[2], o1[3]);
                    *(u32x4*)((LAST ? Fp + (size_t)row * D + col0 : rowp) + bj * HALF) = w; }
            }
            asm volatile("" ::: "memory");
        }
    }
};
struct EpiPlain {
    static constexpr bool PERM = true, AFTER_DRAIN = false;
    bf16_t* O; int ldc;
    __device__ __forceinline__ void operator()(const f32x4 (&acc)[2][2][4][2], const Unit& u, int wr, int wc, int, int) const {
        const int ln_ = lane_now(), fr = ln_ & 15, fq = ln_ >> 4;
        const int row0 = u.pm * BM + wr * 64 + fr, col0 = u.pn * BM + wc * 32 + 8 * fq;
#pragma unroll
        for (int ai = 0; ai < 2; ++ai)
#pragma unroll
            for (int m = 0; m < 4; ++m) {
                bf16_t* rowp = O + (size_t)(row0 + ai * HALF + m * 16) * ldc + col0;
#pragma unroll
                for (int bj = 0; bj < 2; ++bj) { const f32x4 v0 = acc[ai][bj][m][0], v1 = acc[ai][bj][m][1];
                    u32x4 w; w.x = cvt_pk_bf16(v0[0], v0[1]); w.y = cvt_pk_bf16(v0[2], v0[3]); w.z = cvt_pk_bf16(v1[0], v1[1]); w.w = cvt_pk_bf16(v1[2], v1[3]);
                    *(u32x4*)(rowp + bj * HALF) = w; }
            }
    }
};
struct EpiWin {
    static constexpr bool PERM = true, AFTER_DRAIN = false;
    bf16_t *UP, *Q, *K, *GT; float* UR; const float* CS; bf16_t* VT;
    __device__ __forceinline__ void operator()(const f32x4 (&acc)[2][2][4][2], const Unit& u, int wr, int wc, int, int) const {
        const int ln_ = lane_now(), fr = ln_ & 15, fq = ln_ >> 4;
        const int pn = u.pn, row0 = u.pm * BM + wr * 64 + fr, c8 = wc * 32 + 8 * fq;
        if (pn == 7) {
#pragma unroll
            for (int ai = 0; ai < 2; ++ai)
#pragma unroll
                for (int m = 0; m < 4; ++m) { const int row = row0 + ai * HALF + m * 16;
#pragma unroll
                    for (int bj = 0; bj < 2; ++bj)
#pragma unroll
                        for (int n = 0; n < 2; ++n) { const f32x4 v = acc[ai][bj][m][n]; const unsigned w01 = cvt_pk_bf16(v[0], v[1]), w23 = cvt_pk_bf16(v[2], v[3]);
                            bf16_t* dst = VT + (size_t)(bj * 128 + c8 + 4 * n) * MTOK + row;
                            dst[0] = (bf16_t)(w01 & 0xffffu); dst[MTOK] = (bf16_t)(w01 >> 16); dst[2 * (size_t)MTOK] = (bf16_t)(w23 & 0xffffu); dst[3 * (size_t)MTOK] = (bf16_t)(w23 >> 16); } }
            return;
        }
#pragma unroll
        for (int ai = 0; ai < 2; ++ai)
#pragma unroll
            for (int m = 0; m < 4; ++m) {
                const int row = row0 + ai * HALF + m * 16;
                if (pn >= 2 && pn < 7) {
                    const int pos = row < SEQP ? row : (row & (SEQS - 1));
                    const f32x4* csp = (const f32x4*)(CS + ((size_t)pos * 64 + 4 * (4 * wc + fq)) * 2);
                    const f32x4 c01 = csp[0], c23 = csp[1];
                    const float cs_[4] = {c01[0], c01[2], c23[0], c23[2]}, sn_[4] = {c01[1], c01[3], c23[1], c23[3]};
#pragma unroll
                    for (int bj = 0; bj < 2; ++bj) {
                        const f32x4 t1 = acc[ai][bj][m][0], t2 = acc[ai][bj][m][1]; float o1[4], o2[4];
#pragma unroll
                        for (int e = 0; e < 4; ++e) { o1[e] = t1[e] * cs_[e] - t2[e] * sn_[e]; o2[e] = t2[e] * cs_[e] + t1[e] * sn_[e]; }
                        u32x4 w; w.x = cvt_pk_bf16(o1[0], o1[1]); w.y = cvt_pk_bf16(o1[2], o1[3]); w.z = cvt_pk_bf16(o2[0], o2[1]); w.w = cvt_pk_bf16(o2[2], o2[3]);
                        bf16_t* dst = (pn == 6) ? K + (size_t)row * 256 + bj * 128 + c8 : Q + (size_t)row * 1024 + ((pn - 2) * 2 + bj) * 128 + c8;
                        __builtin_nontemporal_store(w, (u32x4*)dst);
                    }
                } else if (pn >= 8 && pn < 16) {
#pragma unroll
                    for (int bj = 0; bj < 2; ++bj) { float* p = UR + (size_t)row * 2048 + (pn - 8) * 256 + bj * 128 + c8; __builtin_nontemporal_store(acc[ai][bj][m][0], (f32x4*)p); __builtin_nontemporal_store(acc[ai][bj][m][1], (f32x4*)(p + 4)); }
                } else {
#pragma unroll
                    for (int bj = 0; bj < 2; ++bj) {
                        f32x4 v0 = acc[ai][bj][m][0], v1 = acc[ai][bj][m][1]; bf16_t* dst;
                        if (pn < 2) dst = UP + (size_t)row * 512 + pn * 256 + bj * 128 + c8;
                        else { dst = GT + (size_t)row * 6144 + (pn - 16) * 256 + bj * 128 + c8;
#pragma unroll
                            for (int e = 0; e < 4; ++e) { v0[e] = sigm(v0[e]); v1[e] = sigm(v1[e]); } }
                        u32x4 w; w.x = cvt_pk_bf16(v0[0], v0[1]); w.y = cvt_pk_bf16(v0[2], v0[3]); w.z = cvt_pk_bf16(v1[0], v1[1]); w.w = cvt_pk_bf16(v1[2], v1[3]);
                        __builtin_nontemporal_store(w, (u32x4*)dst);
                    }
                }
                asm volatile("" ::: "memory");
            }
    }
};
struct EpiBranch {
    static constexpr bool PERM = true, AFTER_DRAIN = false;
    bf16_t* MG; const bf16_t* GT; int first;
    __device__ __forceinline__ void operator()(const f32x4 (&acc)[2][2][4][2], const Unit& u, int wr, int wc, int, int) const {
        const int ln_ = lane_now(), fr = ln_ & 15, fq = ln_ >> 4;
        const int row0 = u.pm * BM + wr * 64 + fr, col0 = u.pn * BM + wc * 32 + 8 * fq;
#pragma unroll
        for (int ai = 0; ai < 2; ++ai) {
            u32x4 gwv[4][2], mwv[4][2];
#pragma unroll
            for (int m = 0; m < 4; ++m)
#pragma unroll
                for (int bj = 0; bj < 2; ++bj) { const int row = row0 + ai * HALF + m * 16, col = col0 + bj * HALF;
                    gwv[m][bj] = __builtin_nontemporal_load((const u32x4*)(GT + (size_t)row * 6144 + col));
                    mwv[m][bj] = first ? (u32x4){0u, 0u, 0u, 0u} : *(const u32x4*)(MG + (size_t)row * D + col); }
            asm volatile("" ::: "memory");
#pragma unroll
            for (int m = 0; m < 4; ++m)
#pragma unroll
                for (int bj = 0; bj < 2; ++bj) { const int row = row0 + ai * HALF + m * 16, col = col0 + bj * HALF;
                    const u32x4 gw = gwv[m][bj], mw = mwv[m][bj]; const f32x4 v0 = acc[ai][bj][m][0], v1 = acc[ai][bj][m][1];
                    u32x4 w;
                    w.x = cvt_pk_bf16(bf_lo(mw.x) + bf_lo(gw.x) * v0[0], bf_hi(mw.x) + bf_hi(gw.x) * v0[1]);
                    w.y = cvt_pk_bf16(bf_lo(mw.y) + bf_lo(gw.y) * v0[2], bf_hi(mw.y) + bf_hi(gw.y) * v0[3]);
                    w.z = cvt_pk_bf16(bf_lo(mw.z) + bf_lo(gw.z) * v1[0], bf_hi(mw.z) + bf_hi(gw.z) * v1[1]);
                    w.w = cvt_pk_bf16(bf_lo(mw.w) + bf_lo(gw.w) * v1[2], bf_hi(mw.w) + bf_hi(gw.w) * v1[3]);
                    *(u32x4*)(MG + (size_t)row * D + col) = w; }
            asm volatile("" ::: "memory");
        }
    }
};
struct EpiLora {
    static constexpr bool PERM = false, AFTER_DRAIN = false;
    const float *w0, *a0, *k_a; const float* SH; const float* KB; float* DIR; bf16_t* G;
    __device__ __forceinline__ void operator()(const f32x4 (&acc)[2][2][4][2], const Unit& u, int wr, int wc, int, int) const {
        const int ln_ = lane_now(), fr = ln_ & 15, fq = ln_ >> 4;
        const int pn = u.pn, row0 = u.pm * BM + wr * 64 + fr, cq = wc * 32 + 4 * fq;
        const int ed = (pn >> 1) & 1;
        if (pn < 4) {
            f32x4 bv[2][2];
#pragma unroll
            for (int bj = 0; bj < 2; ++bj)
#pragma unroll
                for (int n = 0; n < 2; ++n) bv[bj][n] = *(const f32x4*)(w0 + ed * 512 + ((pn * BM + bj * HALF + cq + 16 * n) & 511));
#pragma unroll
            for (int ai = 0; ai < 2; ++ai)
#pragma unroll
                for (int m = 0; m < 4; ++m) {
                    const int row = row0 + ai * HALF + m * 16;
#pragma unroll
                    for (int bj = 0; bj < 2; ++bj)
#pragma unroll
                        for (int n = 0; n < 2; ++n) {
                            const int ch = (pn * BM + bj * HALF + cq + 16 * n) & 511, hh = ch >> 6, j = ch & 63; const f32x4 v = acc[ai][bj][m][n], b = bv[bj][n]; f32x4 o;
#pragma unroll
                            for (int e = 0; e < 4; ++e) { const float x = -(b[e] + v[e]);
                                const float sp = fmaxf(x, 0.f) + 0.6931471805599453f * __builtin_amdgcn_logf(1.f + __builtin_amdgcn_exp2f(-fabsf(x) * LOG2E));
                                o[e] = __builtin_amdgcn_exp2f(-LOG2E * __builtin_amdgcn_exp2f((-sp - 0.5f) * LOG2E)); }
                            *(f32x4*)(DIR + (((size_t)row * 2 + ed) * 8 + hh) * 192 + j) = o;
                        }
                    asm volatile("" ::: "memory");
                }
        } else if (pn < 8) {
            f32x4 bv[2][2], kav[2][2];
#pragma unroll
            for (int bj = 0; bj < 2; ++bj)
#pragma unroll
                for (int n = 0; n < 2; ++n) { const int ch = (pn * BM + bj * HALF + cq + 16 * n) & 511; bv[bj][n] = *(const f32x4*)(a0 + ed * 512 + ch); kav[bj][n] = *(const f32x4*)(k_a + ch); }
#pragma unroll
            for (int ai = 0; ai < 2; ++ai)
#pragma unroll
                for (int m = 0; m < 4; ++m) {
                    const int row = row0 + ai * HALF + m * 16;
                    f32x4 nkv[2][2], kkv[2][2];
#pragma unroll
                    for (int bj = 0; bj < 2; ++bj)
#pragma unroll
                        for (int n = 0; n < 2; ++n) { const int ch = (pn * BM + bj * HALF + cq + 16 * n) & 511;
                            nkv[bj][n] = *(const f32x4*)(SH + ((size_t)row * 8 + (ch >> 6)) * 192 + (ch & 63)); kkv[bj][n] = *(const f32x4*)(KB + (size_t)row * 512 + ch); }
                    asm volatile("" ::: "memory");
#pragma unroll
                    for (int bj = 0; bj < 2; ++bj)
#pragma unroll
                        for (int n = 0; n < 2; ++n) {
                            const int ch = (pn * BM + bj * HALF + cq + 16 * n) & 511, hh = ch >> 6, j = ch & 63; const f32x4 v = acc[ai][bj][m][n], b = bv[bj][n], ka = kav[bj][n], nk = nkv[bj][n], kk_ = kkv[bj][n];
                            float* dp = DIR + (((size_t)row * 2 + ed) * 8 + hh) * 192 + j; f32x4 o1, o2;
#pragma unroll
                            for (int e = 0; e < 4; ++e) { const float a = sigm(b[e] + v[e]); o1[e] = -nk[e] * a; o2[e] = kk_[e] * (1.f + (a - 1.f) * ka[e]); }
                            *(f32x4*)(dp + 64) = o1; *(f32x4*)(dp + 128) = o2;
                        }
                    asm volatile("" ::: "memory");
                }
        } else {
#pragma unroll
            for (int ai = 0; ai < 2; ++ai)
#pragma unroll
                for (int m = 0; m < 4; ++m) {
                    const int row = row0 + ai * HALF + m * 16;
#pragma unroll
                    for (int bj = 0; bj < 2; ++bj)
#pragma unroll
                        for (int n = 0; n < 2; ++n) { const int c = pn * BM + bj * HALF + cq + 16 * n; const f32x4 v = acc[ai][bj][m][n];
                            u32x2 w; w.x = cvt_pk_bf16(v[0], v[1]); w.y = cvt_pk_bf16(v[2], v[3]);
                            *(u32x2*)(G + (size_t)row * 512 + (c - 2048)) = w; }
                    asm volatile("" ::: "memory");
                }
        }
    }
};

constexpr int XQ_UNITS = 420;
struct XqOrder {
    int G, c;
    __device__ __forceinline__ bool next(int i, Unit& u) const {
        const int L = i * G + c; if (L >= XQ_UNITS) return false;
        if (L < 384) { u.pm = (int)(WS_XB >> 20) + (L >> 1); u.pn = (int)(WS_WQ >> 20) + (L & 1); }
        else if (L < 402) { const int t = L - 384; u.pm = (int)(WS_MEMB >> 20) + (t >> 1); u.pn = (int)(WS_WKV >> 20) + (t & 1); }
        else { const int t = L - 402; u.pm = (int)(WS_WKV >> 20) + 2 + t / 9; u.pn = (int)(WS_MEMB >> 20) + t % 9; }
        return true;
    }
    __device__ __forceinline__ void a_ready(const Unit&) const {}
    __device__ __forceinline__ void done(const Unit&) const {}
};
struct EpiXq {
    static constexpr bool PERM = true, AFTER_DRAIN = false;
    bf16_t *QX, *KX, *VXT;
    __device__ __forceinline__ void operator()(const f32x4 (&acc)[2][2][4][2], const Unit& u, int wr, int wc, int, int) const {
        const int ln_ = lane_now(), fr = ln_ & 15, fq = ln_ >> 4;
        bf16_t* O; int ldc, tm, tn;
        if (u.pm >= (int)(WS_XB >> 20)) { O = QX; ldc = 512; tm = u.pm - (int)(WS_XB >> 20); tn = u.pn - (int)(WS_WQ >> 20); }
        else if (u.pm < (int)(WS_WKV >> 20)) { O = KX; ldc = 512; tm = u.pm - (int)(WS_MEMB >> 20); tn = u.pn - (int)(WS_WKV >> 20); }
        else { O = VXT; ldc = MMEM; tm = u.pm - (int)(WS_WKV >> 20) - 2; tn = u.pn - (int)(WS_MEMB >> 20); }
        const int row0 = tm * BM + wr * 64 + fr, col0 = tn * BM + wc * 32 + 8 * fq;
#pragma unroll
        for (int ai = 0; ai < 2; ++ai)
#pragma unroll
            for (int m = 0; m < 4; ++m) {
                bf16_t* rowp = O + (size_t)(row0 + ai * HALF + m * 16) * ldc + col0;
#pragma unroll
                for (int bj = 0; bj < 2; ++bj) { const f32x4 v0 = acc[ai][bj][m][0], v1 = acc[ai][bj][m][1];
                    u32x4 w; w.x = cvt_pk_bf16(v0[0], v0[1]); w.y = cvt_pk_bf16(v0[2], v0[3]); w.z = cvt_pk_bf16(v1[0], v1[1]); w.w = cvt_pk_bf16(v1[2], v1[3]);
                    *(u32x4*)(rowp + bj * HALF) = w; }
            }
    }
};
template <class Epi, class Sched, bool ALIGN_EPI = false, bool SP2 = false>
__device__ __forceinline__ void gemm_phase(PG8_LAS unsigned char* lds, const Gemm g, const Sched& S, const Epi E, int wid_in) {
    int lane_o; asm volatile("v_mbcnt_lo_u32_b32 %0, -1, 0\n\tv_mbcnt_hi_u32_b32 %0, -1, %0" : "=v"(lane_o));
    const int wid = wid_in, lane = lane_o, tid = wid * 64 + lane, wr = wid >> 2, wc = wid & 3, fr = lane & 15, fq = lane >> 4;
    const int K = g.K, nt = K / BK;
    unsigned voffA[2], voffB[2];
#pragma unroll
    for (int i = 0; i < 2; ++i) { int R, C; stage_rc(tid * 16 + i * 8192, R, C); const int Rb = Epi::PERM ? ((R & ~31) + perm32(R & 31)) : R;
        voffA[i] = (unsigned)(R * K + C) * 2u; voffB[i] = (unsigned)(Rb * K + C) * 2u; }
    const size_t kstep = (size_t)(BK * 2);
    const size_t hstep = (size_t)HALF * K * 2;
    const size_t tstep = 2 * hstep;
    const unsigned ldsw = (unsigned)wid * 1024u;
    const int aoff = lds_byte(wr * 64 + fr, fq * 8), boff = lds_byte(wc * 32 + fr, fq * 8);
#define PG8_SA(b, h) (((b) * 2 + (h)) * HTB)
#define PG8_SB(b, h) ((4 + (b) * 2 + (h)) * HTB)
#define PG8_STAGE(bufoff, gbase, voff) do { _Pragma("unroll") for (int _i = 0; _i < 2; ++_i) \
        __builtin_amdgcn_global_load_lds((const unsigned*)((const char*)(gbase) + (voff)[_i]), (PG8_LAS unsigned*)(lds + (bufoff) + ldsw + _i * 8192), 16, 0, 0); } while (0)
#define PG8_LDA(dst, b, h) do { _Pragma("unroll") for (int m = 0; m < 4; ++m) _Pragma("unroll") for (int k = 0; k < 2; ++k) dst[m][k] = *(const PG8_LAS bf16x8*)(lds + PG8_SA(b, h) + aoff + m * 2048 + k * 1024); } while (0)
#define PG8_LDB(dst, b, h) do { _Pragma("unroll") for (int n = 0; n < 2; ++n) _Pragma("unroll") for (int k = 0; k < 2; ++k) dst[n][k] = *(const PG8_LAS bf16x8*)(lds + PG8_SB(b, h) + boff + n * 2048 + k * 1024); } while (0)
#define PG8_MMA(ai, bj, At, Bt) do { __builtin_amdgcn_s_setprio(1); _Pragma("unroll") for (int m = 0; m < 4; ++m) _Pragma("unroll") for (int n = 0; n < 2; ++n) _Pragma("unroll") for (int k = 0; k < 2; ++k) \
        acc[ai][bj][m][n] = __builtin_amdgcn_mfma_f32_16x16x32_bf16(Bt[n][k], At[m][k], acc[ai][bj][m][n], 0, 0, 0); __builtin_amdgcn_s_setprio(0); } while (0)
#define PG8_WAIT_V(n) asm volatile("s_waitcnt vmcnt(" #n ")" ::: "memory")
#define PG8_WAIT_L(n) asm volatile("s_waitcnt lgkmcnt(" #n ")" ::: "memory")
#define PG8_BAR __builtin_amdgcn_s_barrier()
#define PG8_SCHED __builtin_amdgcn_sched_barrier(0)
    Unit cur, nxt; int ui = 0;
    if (!S.next(0, cur)) return;
    f32x4 acc[2][2][4][2];
#pragma unroll
    for (int a = 0; a < 2; ++a)
#pragma unroll
        for (int b = 0; b < 2; ++b)
#pragma unroll
            for (int m = 0; m < 4; ++m)
#pragma unroll
                for (int n = 0; n < 2; ++n) acc[a][b][m][n] = (f32x4){0.f, 0.f, 0.f, 0.f};
    bf16x8 At[4][2], B0[2][2], B1[2][2];
    const char* cA = (const char*)g.A + (size_t)cur.pm * tstep; const char* cB = (const char*)g.Bt + (size_t)cur.pn * tstep;
    S.a_ready(cur);
    if constexpr (SP2) {
        PG8_STAGE(PG8_SB(0, 0), cB, voffB); PG8_STAGE(PG8_SB(0, 1), cB + hstep, voffB); PG8_STAGE(PG8_SA(0, 0), cA, voffA); PG8_STAGE(PG8_SA(0, 1), cA + hstep, voffA);
        if (wr == 1) PG8_BAR;
        PG8_WAIT_V(2); PG8_BAR;
        PG8_STAGE(PG8_SB(1, 0), cB + kstep, voffB); PG8_STAGE(PG8_SA(1, 0), cA + kstep, voffA); PG8_STAGE(PG8_SB(1, 1), cB + hstep + kstep, voffB);
        PG8_WAIT_V(6); PG8_BAR;
    } else {
        PG8_STAGE(PG8_SB(0, 0), cB, voffB); PG8_STAGE(PG8_SA(0, 0), cA, voffA); PG8_STAGE(PG8_SB(0, 1), cB + hstep, voffB); PG8_STAGE(PG8_SA(0, 1), cA + hstep, voffA);
        if (wr == 1) PG8_BAR;
        PG8_WAIT_V(4); PG8_BAR;
        PG8_STAGE(PG8_SB(1, 0), cB + kstep, voffB); PG8_STAGE(PG8_SA(1, 0), cA + kstep, voffA); PG8_STAGE(PG8_SB(1, 1), cB + hstep + kstep, voffB);
        PG8_WAIT_V(6); PG8_BAR;
    }
    for (;;) {
        const bool has_next = S.next(ui + 1, nxt);
        const char* nA = has_next ? (const char*)g.A + (size_t)nxt.pm * tstep : cA; const char* nB = has_next ? (const char*)g.Bt + (size_t)nxt.pn * tstep : cB;
        for (int t = 0; t < nt; t += 2) {
            const bool last = (t == nt - 2);
            const char* a1 = cA + (size_t)(t + 1) * kstep;
            const char* a2 = last ? nA : cA + (size_t)(t + 2) * kstep; const char* b2 = last ? nB : cB + (size_t)(t + 2) * kstep;
            const char* a3 = a2 + kstep; const char* b3 = b2 + kstep;
            if (last && has_next) S.a_ready(nxt);
            if constexpr (SP2) {
            PG8_LDB(B0, 0, 0); PG8_LDB(B1, 0, 1); PG8_SCHED; PG8_LDA(At, 0, 0); PG8_STAGE(PG8_SA(1, 1), a1 + hstep, voffA);
            PG8_WAIT_V(8); PG8_WAIT_L(0); PG8_BAR; PG8_MMA(0, 0, At, B0); PG8_MMA(0, 1, At, B1); PG8_BAR; PG8_SCHED;
            PG8_LDA(At, 0, 1); PG8_STAGE(PG8_SB(0, 0), b2, voffB); PG8_STAGE(PG8_SB(0, 1), b2 + hstep, voffB); PG8_STAGE(PG8_SA(0, 0), a2, voffA);
            PG8_WAIT_V(8); PG8_WAIT_L(0); PG8_BAR; PG8_MMA(1, 0, At, B0); PG8_MMA(1, 1, At, B1); PG8_BAR; PG8_SCHED;
            PG8_LDB(B0, 1, 0); PG8_LDB(B1, 1, 1); PG8_SCHED; PG8_LDA(At, 1, 0); PG8_STAGE(PG8_SA(0, 1), a2 + hstep, voffA);
            PG8_WAIT_V(8); PG8_WAIT_L(0); PG8_BAR; PG8_MMA(0, 0, At, B0); PG8_MMA(0, 1, At, B1); PG8_BAR; PG8_SCHED;
            PG8_LDA(At, 1, 1); PG8_STAGE(PG8_SB(1, 0), b3, voffB); PG8_STAGE(PG8_SB(1, 1), b3 + hstep, voffB); PG8_STAGE(PG8_SA(1, 0), a3, voffA);
            PG8_WAIT_V(8); PG8_WAIT_L(0); PG8_BAR; PG8_MMA(1, 0, At, B0); PG8_MMA(1, 1, At, B1); PG8_BAR; PG8_SCHED;
            } else {
            PG8_LDB(B0, 0, 0); PG8_SCHED; PG8_LDA(At, 0, 0); PG8_STAGE(PG8_SA(1, 1), a1 + hstep, voffA);
            PG8_WAIT_L(8); PG8_BAR; PG8_WAIT_L(0); PG8_MMA(0, 0, At, B0); PG8_BAR; PG8_SCHED;
            PG8_LDB(B1, 0, 1); PG8_STAGE(PG8_SB(0, 0), b2, voffB);
            PG8_BAR; PG8_WAIT_L(0); PG8_MMA(0, 1, At, B1); PG8_BAR;
            PG8_LDA(At, 0, 1); PG8_STAGE(PG8_SA(0, 0), a2, voffA);
            PG8_BAR; PG8_WAIT_L(0); PG8_MMA(1, 0, At, B0); PG8_BAR; PG8_SCHED;
            PG8_STAGE(PG8_SB(0, 1), b2 + hstep, voffB);
            PG8_WAIT_V(6); PG8_BAR; PG8_MMA(1, 1, At, B1); PG8_BAR;
            PG8_LDB(B0, 1, 0); PG8_SCHED; PG8_LDA(At, 1, 0); PG8_STAGE(PG8_SA(0, 1), a2 + hstep, voffA);
            PG8_WAIT_L(8); PG8_BAR; PG8_WAIT_L(0); PG8_MMA(0, 0, At, B0); PG8_BAR; PG8_SCHED;
            PG8_LDB(B1, 1, 1); PG8_STAGE(PG8_SB(1, 0), b3, voffB);
            PG8_BAR; PG8_WAIT_L(0); PG8_MMA(0, 1, At, B1); PG8_BAR;
            PG8_LDA(At, 1, 1); PG8_STAGE(PG8_SA(1, 0), a3, voffA);
            PG8_BAR; PG8_WAIT_L(0); PG8_MMA(1, 0, At, B0); PG8_BAR; PG8_SCHED;
            PG8_STAGE(PG8_SB(1, 1), b3 + hstep, voffB);
            PG8_WAIT_V(6); PG8_BAR; PG8_MMA(1, 1, At, B1); PG8_BAR;
            }
        }
        if constexpr (ALIGN_EPI) { if (wr == 0) PG8_BAR; }
        if constexpr (!Epi::AFTER_DRAIN) { E(acc, cur, wr, wc, fr, fq); S.done(cur); }
        if (!has_next) break;
#pragma unroll
        for (int a = 0; a < 2; ++a)
#pragma unroll
            for (int b = 0; b < 2; ++b)
#pragma unroll
                for (int m = 0; m < 4; ++m)
#pragma unroll
                    for (int n = 0; n < 2; ++n) acc[a][b][m][n] = (f32x4){0.f, 0.f, 0.f, 0.f};
        cur = nxt; cA = nA; cB = nB; ++ui;
        if constexpr (ALIGN_EPI) { if (wr == 1) PG8_BAR; }
    }
    PG8_WAIT_V(0);
    if constexpr (!ALIGN_EPI) { if (wr == 0) PG8_BAR; }
    PG8_BAR;
    if constexpr (Epi::AFTER_DRAIN) { E.fused(acc, cur, wr, wc, fr, fq, lds, wid, lane); S.done(cur); }
#undef PG8_SA
#undef PG8_SB
#undef PG8_STAGE
#undef PG8_LDA
#undef PG8_LDB
#undef PG8_MMA
#undef PG8_WAIT_V
#undef PG8_WAIT_L
#undef PG8_BAR
#undef PG8_SCHED
}
}

constexpr int NWAVES = 8;
constexpr int RING_OFF = 0, RING_BYTES = 131072;
constexpr int LDSCTL_OFF = RING_BYTES, MISC_OFF = LDSCTL_OFF + 320;
constexpr int LDS_BYTES = 147456;

#define LAS __attribute__((address_space(3)))
typedef unsigned u32x2 __attribute__((ext_vector_type(2)));
typedef unsigned u32x4 __attribute__((ext_vector_type(4)));
typedef float f32x2 __attribute__((ext_vector_type(2)));
typedef float f32x4 __attribute__((ext_vector_type(4)));
typedef short bf16x8 __attribute__((ext_vector_type(8)));
#define LDS_WAIT() asm volatile("s_waitcnt lgkmcnt(0)" ::: "memory")
#define VM_WAIT() asm volatile("s_waitcnt vmcnt(0)" ::: "memory")
__device__ __forceinline__ unsigned pk2(float lo, float hi) { return pg8::cvt_pk_bf16(lo, hi); }
__device__ __forceinline__ float bflo(unsigned w) { return __uint_as_float(w << 16); }
__device__ __forceinline__ float bfhi(unsigned w) { return __uint_as_float(w & 0xffff0000u); }
__device__ __forceinline__ float wave_sum(float v) {
#pragma unroll
    for (int o = 1; o < 64; o <<= 1) v += __shfl_xor(v, o);
    return v;
}
__device__ __forceinline__ int hw_lane() { int l; asm volatile("v_mbcnt_lo_u32_b32 %0, -1, 0\n\tv_mbcnt_hi_u32_b32 %0, -1, %0" : "=v"(l)); return l; }
__device__ __forceinline__ int row_pos(int row) { return row < SEQP ? row : (row & (SEQS - 1)); }
__device__ __forceinline__ int row_slen(int row) { return row < SEQP ? SEQP : SEQS; }

__device__ const float INV_FREQ[64] = {
    1.000000000e+00f, 8.659643531e-01f, 7.498942018e-01f, 6.493816376e-01f,
    5.623413324e-01f, 4.869675338e-01f, 4.216965139e-01f, 3.651741147e-01f,
    3.162277639e-01f, 2.738419771e-01f, 2.371373773e-01f, 2.053525001e-01f,
    1.778279394e-01f, 1.539926529e-01f, 1.333521456e-01f, 1.154781953e-01f,
    1.000000015e-01f, 8.659642935e-02f, 7.498942316e-02f, 6.493816525e-02f,
    5.623413250e-02f, 4.869675264e-02f, 4.216964915e-02f, 3.651741147e-02f,
    3.162277490e-02f, 2.738419548e-02f, 2.371373773e-02f, 2.053525113e-02f,
    1.778279431e-02f, 1.539926510e-02f, 1.333521400e-02f, 1.154781971e-02f,
    9.999999776e-03f, 8.659643121e-03f, 7.498942316e-03f, 6.493816152e-03f,
    5.623413250e-03f, 4.869675264e-03f, 4.216964822e-03f, 3.651741194e-03f,
    3.162277630e-03f, 2.738419687e-03f, 2.371373819e-03f, 2.053525066e-03f,
    1.778279431e-03f, 1.539926510e-03f, 1.333521446e-03f, 1.154782018e-03f,
    1.000000047e-03f, 8.659643354e-04f, 7.498941850e-04f, 6.493816036e-04f,
    5.623413017e-04f, 4.869675322e-04f, 4.216965172e-04f, 3.651741135e-04f,
    3.162277571e-04f, 2.738419571e-04f, 2.371373703e-04f, 2.053525095e-04f,
    1.778279402e-04f, 1.539926598e-04f, 1.333521504e-04f, 1.154782003e-04f
};

#define XB_TMO      128
#define XB_XCNT(j)  (256  + 64 * (j))
#define XB_XSUB(j)  (1280 + 64 * (j))
#define XB_XGEN(j)  (2304 + 64 * (j))
#define XB_TOP      3328
#define XB_TOPGEN   3392
#define XCD_BAR_WORDS 3456
#define XB_SPIN_CAP (1u << 18)
__device__ __forceinline__ unsigned xb_ld(unsigned* p)              { return __hip_atomic_load(p, __ATOMIC_RELAXED, __HIP_MEMORY_SCOPE_AGENT); }
__device__ __forceinline__ unsigned xb_add(unsigned* p, unsigned v) { return __hip_atomic_fetch_add(p, v, __ATOMIC_RELAXED, __HIP_MEMORY_SCOPE_AGENT); }
__device__ __forceinline__ unsigned xb_xcc_id() { return (unsigned)__builtin_amdgcn_s_getreg((3 << 11) | 20) & 0xFu; }
#define XB_SPIN(cond, bar) do { unsigned _sp = 0; while (cond) { __builtin_amdgcn_s_sleep(1); \
    if ((++_sp & 255u) == 0u) { if (xb_ld(&(bar)[XB_TMO])) break; if (_sp > XB_SPIN_CAP) { atomicAdd(&(bar)[XB_TMO], 1u); break; } } } } while (0)
struct XcdBarrier { unsigned* bar; unsigned x; volatile LAS unsigned* st; unsigned wv; };
__device__ __forceinline__ bool xb_thread0(unsigned wv) { return wv == 0u && hw_lane() == 0; }
__device__ __forceinline__ XcdBarrier xcd_barrier_post(unsigned* bar, volatile LAS unsigned* st, unsigned wv) {
    XcdBarrier b; b.bar = bar; b.x = xb_xcc_id(); b.st = st; b.wv = wv;
    if (xb_thread0(wv)) (void)xb_add(&bar[XB_XCNT(b.x)], 1u);
    return b;
}
__device__ __forceinline__ void xcd_barrier_complete(unsigned* bar, unsigned x, unsigned& nloc, unsigned& nx) {
    const unsigned G = gridDim.x * gridDim.y * gridDim.z;
    unsigned sum, cnt, mine, sp = 0u;
    for (;;) {
        sum = 0u; cnt = 0u; mine = 0u;
#pragma unroll
        for (unsigned j = 0; j < 16; ++j) { const unsigned c = xb_ld(&bar[XB_XCNT(j)]); sum += c; cnt += (c > 0u) ? 1u : 0u; mine = (j == x) ? c : mine; }
        if (sum == G) break;
        __builtin_amdgcn_s_sleep(1);
        if ((++sp & 255u) == 0u) { if (xb_ld(&bar[XB_TMO])) break; if (sp > XB_SPIN_CAP) { atomicAdd(&bar[XB_TMO], 1u); break; } }
    }
    nloc = mine > 0u ? mine : 1u; nx = cnt > 0u ? cnt : 1u;
}
__device__ __forceinline__ void xcd_barrier(const XcdBarrier& b) {
    asm volatile("s_waitcnt vmcnt(0)" ::: "memory");
    __syncthreads();
    if (xb_thread0(b.wv)) {
        unsigned* bar = b.bar;
        __builtin_amdgcn_s_waitcnt(0);
        unsigned nloc = b.st[0], nx = b.st[1];
        if (nloc == 0u) { xcd_barrier_complete(bar, b.x, nloc, nx); b.st[0] = nloc; b.st[1] = nx; }
        const unsigned old = xb_add(&bar[XB_XSUB(b.x)], 1u);
        const unsigned gen = old / nloc;
        if (old + 1u == (gen + 1u) * nloc) {
            __builtin_amdgcn_fence(__ATOMIC_RELEASE, "agent");
            asm volatile("s_waitcnt vmcnt(0)" ::: "memory");
            const unsigned og = xb_add(&bar[XB_TOP], 1u);
            const unsigned tg = og / nx;
            if (og + 1u == (tg + 1u) * nx) xb_add(&bar[XB_TOPGEN], 1u);
            else XB_SPIN(xb_ld(&bar[XB_TOPGEN]) == tg, bar);
            __builtin_amdgcn_fence(__ATOMIC_ACQUIRE, "agent");
            xb_add(&bar[XB_XGEN(b.x)], 1u);
            asm volatile("s_waitcnt vmcnt(0)" ::: "memory");
        } else {
            XB_SPIN(xb_ld(&bar[XB_XGEN(b.x)]) == gen, bar);
            __builtin_amdgcn_fence(__ATOMIC_ACQUIRE, "agent");
            asm volatile("s_waitcnt vmcnt(0)" ::: "memory");
        }
    }
    __syncthreads();
}

#define GAS __attribute__((address_space(1)))
struct Args {
    const GAS float* in[28]; GAS float* out; GAS unsigned char* ws;
    int it_lo, it_hi, ph_lo, ph_hi;
    int single, pad;
};
typedef const __attribute__((address_space(4))) Args* KArgs;
enum { I_XP = 0, I_XS, I_MP, I_MS, I_LNG, I_LNB, I_FWI, I_FWO, I_WIN, I_POOLW, I_POOLS, I_SINK, I_MU, I_W0, I_W2, I_A0, I_A2, I_G2, I_KK, I_KA, I_RK, I_GNG, I_GNB, I_WBR, I_WOUT, I_XWQ, I_XWKV, I_XWO };

__device__ __forceinline__ int map_row(int kind, int n) {
    if (kind == 1) { const int up = n >= DFF ? 1 : 0; const int j = up ? n - DFF : n; return (j >> 7) * 256 + (up << 7) + (j & 127); }
    if (kind == 2) {
        if (n >= 512 && n < 1792) { const int d = n & 127; return (n & ~127) + 8 * ((d & 63) >> 2) + (d & 3) + 4 * (d >> 6); }
        return n >= 3968 ? n + 128 : n;
    }
    return n;
}
__device__ __forceinline__ void transpose_item(const float* W, int K, int N, bf16* WT, int kind, LAS float* scr, int item, int lane) {
    const int nblk = N / 32, kb = item / nblk, nb = item % nblk, k0 = 64 * kb, n0 = 32 * nb;
#pragma unroll
    for (int i = 0; i < 32; ++i) { const int kk = 2 * i + (lane >> 5); scr[kk * 33 + (lane & 31)] = __builtin_nontemporal_load(W + (size_t)(k0 + kk) * N + n0 + (lane & 31)); }
    LDS_WAIT(); asm volatile("" ::: "memory");
    const int c = lane & 7;
#pragma unroll
    for (int j = 0; j < 4; ++j) { const int n = (lane >> 3) + 8 * j; const LAS float* s = scr + (8 * c) * 33 + n;
        u32x4 o; o.x = pk2(s[0 * 33], s[1 * 33]); o.y = pk2(s[2 * 33], s[3 * 33]); o.z = pk2(s[4 * 33], s[5 * 33]); o.w = pk2(s[6 * 33], s[7 * 33]);
        *(u32x4*)(WT + (size_t)map_row(kind, n0 + n) * K + k0 + 8 * c) = o; }
    LDS_WAIT(); asm volatile("" ::: "memory");
}

__device__ __forceinline__ void conv_phase(KArgs a, int L, LAS unsigned char* lds, int gw, int NGW, int wave, int lane, int gtid, int NT) {
    unsigned char* ws = (unsigned char*)a->ws;
    LAS float* scr = (LAS float*)(lds + RING_OFF + wave * 16384);
    constexpr int N_W1 = 32 * 352, N_W2 = 88 * 64, N_WI = 32 * 316, N_B1 = 16 * 64, N_B2 = 8 * 64, N_OU = 32 * 64, N_Q = 32 * 16, N_KV = 32 * 32, N_O = 8 * 64;
    constexpr int NITEMS = 2 * N_W1 + 2 * N_W2 + N_WI + N_B1 + N_B2 + N_OU + N_Q + N_KV + N_O;
    const float* fwi = ((const float*)a->in[I_FWI]) + (size_t)L * 2 * D * 2 * DFF;
    const float* fwo = ((const float*)a->in[I_FWO]) + (size_t)L * 2 * DFF * D;
    const float* wbr = ((const float*)a->in[I_WBR]) + (size_t)L * D * D;
    for (int it = gw; it < NITEMS; it += NGW) {
        int r = it;
        if (r < N_W1) { transpose_item(fwi, D, 2 * DFF, (bf16*)(ws + WS_W1T), 1, scr, r, lane); continue; } r -= N_W1;
        if (r < N_W1) { transpose_item(fwi + (size_t)D * 2 * DFF, D, 2 * DFF, (bf16*)(ws + WS_W1T) + (size_t)2 * DFF * D, 1, scr, r, lane); continue; } r -= N_W1;
        if (r < N_W2) { transpose_item(fwo, DFF, D, (bf16*)(ws + WS_W2T), 0, scr, r, lane); continue; } r -= N_W2;
        if (r < N_W2) { transpose_item(fwo + (size_t)DFF * D, DFF, D, (bf16*)(ws + WS_W2T) + (size_t)D * DFF, 0, scr, r, lane); continue; } r -= N_W2;
        if (r < N_WI) { transpose_item(((const float*)a->in[I_WIN]) + (size_t)L * D * INC, D, INC, (bf16*)(ws + WS_WINT), 2, scr, r, lane); continue; } r -= N_WI;
        if (r < N_B1) { transpose_item(wbr + (size_t)512 * D, 1024, D, (bf16*)(ws + WS_WBR1), 0, scr, r, lane); continue; } r -= N_B1;
        if (r < N_B2) { transpose_item(wbr + (size_t)1536 * D, 512, D, (bf16*)(ws + WS_WBR2), 0, scr, r, lane); continue; } r -= N_B2;
        if (r < N_OU) { transpose_item(((const float*)a->in[I_WOUT]) + (size_t)L * D * D, D, D, (bf16*)(ws + WS_WOUT), 0, scr, r, lane); continue; } r -= N_OU;
        if (r < N_Q) { transpose_item(((const float*)a->in[I_XWQ]) + (size_t)L * D * 512, D, 512, (bf16*)(ws + WS_WQ), 0, scr, r, lane); continue; } r -= N_Q;
        if (r < N_KV) { transpose_item(((const float*)a->in[I_XWKV]) + (size_t)L * D * 1024, D, 1024, (bf16*)(ws + WS_WKV), 0, scr, r, lane); continue; } r -= N_KV;
        transpose_item(((const float*)a->in[I_XWO]) + (size_t)L * 512 * D, 512, D, (bf16*)(ws + WS_WO), 0, scr, r, lane);
    }
    {
        const float* pw = ((const float*)a->in[I_POOLW]) + (size_t)L * 4 * 128 * 128; const float* ps = ((const float*)a->in[I_POOLS]) + (size_t)L * 512;
        bf16* dst = (bf16*)(ws + WS_WBR0);
        for (int id = gtid; id < 2048 * 64; id += NT) {
            const int n = id & 2047, kg = id >> 11, g = kg >> 4, c0 = (8 * kg) & 127;
            float acc[8];
#pragma unroll
            for (int i = 0; i < 8; ++i) acc[i] = 0.f;
            const float* pwr = pw + ((size_t)g * 128 + c0) * 128;
            for (int e = 0; e < 128; ++e) {
                const float wb = wbr[(size_t)(g * 128 + e) * D + n] * ps[g * 128 + e];
#pragma unroll
                for (int i = 0; i < 8; ++i) acc[i] += pwr[i * 128 + e] * wb;
            }
            u32x4 o; o.x = pk2(acc[0], acc[1]); o.y = pk2(acc[2], acc[3]); o.z = pk2(acc[4], acc[5]); o.w = pk2(acc[6], acc[7]);
            *(u32x4*)(dst + (size_t)n * 512 + 8 * kg) = o;
        }
    }
    {
        const float* w2 = ((const float*)a->in[I_W2]) + (size_t)L * 2 * 64 * 512; const float* a2 = ((const float*)a->in[I_A2]) + (size_t)L * 2 * 64 * 512; const float* g2 = ((const float*)a->in[I_G2]) + (size_t)L * 128 * 512;
        bf16* dst = (bf16*)(ws + WS_BL);
        for (int id = gtid; id < 2560 * 48; id += NT) {
            const int n = id / 48, k0 = 8 * (id % 48);
            float v[8];
#pragma unroll
            for (int i = 0; i < 8; ++i) {
                const int k = k0 + i; float x = 0.f;
                if (n < 512) { if (k < 64) x = w2[(size_t)k * 512 + n]; }
                else if (n < 1024) { if (k >= 64 && k < 128) x = w2[(size_t)(64 + k - 64) * 512 + (n - 512)]; }
                else if (n < 1536) { if (k >= 128 && k < 192) x = a2[(size_t)(k - 128) * 512 + (n - 1024)]; }
                else if (n < 2048) { if (k >= 192 && k < 256) x = a2[(size_t)(64 + k - 192) * 512 + (n - 1536)]; }
                else { if (k >= 256) x = g2[(size_t)(k - 256) * 512 + (n - 2048)]; }
                v[i] = x;
            }
            u32x4 o; o.x = pk2(v[0], v[1]); o.y = pk2(v[2], v[3]); o.z = pk2(v[4], v[5]); o.w = pk2(v[6], v[7]);
            *(u32x4*)(dst + (size_t)n * 384 + k0) = o;
        }
    }
    { u32x4* p = (u32x4*)((bf16*)(ws + WS_WINT) + (size_t)3968 * D); for (int id = gtid; id < 128 * D / 8; id += NT) p[id] = (u32x4){0u, 0u, 0u, 0u}; }
}

__device__ __forceinline__ void prologue_phase(KArgs a, int gtid, int NT) {
    unsigned char* ws = (unsigned char*)a->ws;
    { f32x2* cs = (f32x2*)(ws + WS_CS);
      for (int id = gtid; id < SEQP * 64; id += NT) { const int t = id >> 6, j = id & 63; const float ang = (float)t * INV_FREQ[j]; float s, c; sincosf(ang, &s, &c); cs[id] = (f32x2){c, s}; } }
    { bf16* mb = (bf16*)(ws + WS_MEMB);
      for (int id = gtid; id < MMEM * D / 4; id += NT) { const int row = id / (D / 4), c4 = id % (D / 4);
          const float* src = row < MEML ? ((const float*)a->in[I_MP]) + (size_t)row * D : ((const float*)a->in[I_MS]) + (size_t)(row - MEML) * D;
          const f32x4 v = *(const f32x4*)(src + 4 * c4); u32x2 o; o.x = pk2(v[0], v[1]); o.y = pk2(v[2], v[3]); *(u32x2*)(mb + (size_t)row * D + 4 * c4) = o; } }
    { bf16* xb = (bf16*)(ws + WS_XB);
      for (int id = gtid; id < MTOK * (D / 4); id += NT) { const int row = id / (D / 4), c4 = id % (D / 4);
          const float* src = row < SEQP ? ((const float*)a->in[I_XP]) + (size_t)row * D : ((const float*)a->in[I_XS]) + (size_t)(row - SEQP) * D;
          const f32x4 v = *(const f32x4*)(src + 4 * c4);
          u32x2 o; o.x = pk2(v[0], v[1]); o.y = pk2(v[2], v[3]); *(u32x2*)(xb + (size_t)row * D + 4 * c4) = o; } }
}

__device__ __forceinline__ void ln_phase(const float* x, float* xo, bf16* xb, const float* g, const float* b, float* stats, bool write_x, int gw, int NGW, int lane) {
    f32x4 v[8], nx[8];
    if (gw < MTOK) { const f32x4* xr = (const f32x4*)(x + (size_t)gw * D) + lane;
#pragma unroll
        for (int j = 0; j < 8; ++j) v[j] = __builtin_nontemporal_load(xr + 64 * j); }
#pragma unroll 1
    for (int m = gw; m < MTOK; m += NGW) {
        f32x4* xr = (f32x4*)(xo + (size_t)m * D) + lane;
        if (m + NGW < MTOK) { const f32x4* xn = (const f32x4*)(x + (size_t)(m + NGW) * D) + lane;
#pragma unroll
            for (int j = 0; j < 8; ++j) nx[j] = __builtin_nontemporal_load(xn + 64 * j); }
        float s = 0.f;
#pragma unroll
        for (int j = 0; j < 8; ++j) s += (v[j][0] + v[j][1]) + (v[j][2] + v[j][3]);
        const float mean = wave_sum(s) * (1.f / D); float s2 = 0.f;
#pragma unroll
        for (int j = 0; j < 8; ++j) { v[j] = v[j] - mean; s2 += (v[j][0] * v[j][0] + v[j][1] * v[j][1]) + (v[j][2] * v[j][2] + v[j][3] * v[j][3]); }
        const float rstd = 1.f / sqrtf(wave_sum(s2) * (1.f / D) + LN_EPS);
        if (!write_x && lane == 0) *(f32x2*)(stats + 2 * (size_t)m) = (f32x2){mean, rstd};
        u32x2* o8 = (u32x2*)(xb + (size_t)m * D) + lane;
#pragma unroll
        for (int j = 0; j < 8; ++j) { const f32x4 gg = *((const f32x4*)g + lane + 64 * j), bb = *((const f32x4*)b + lane + 64 * j);
            const f32x4 o = v[j] * rstd * gg + bb; if (write_x) xr[64 * j] = o; u32x2 w; w.x = pk2(o[0], o[1]); w.y = pk2(o[2], o[3]); o8[64 * j] = w; }
#pragma unroll
        for (int j = 0; j < 8; ++j) v[j] = nx[j];
    }
}

template <bool FINAL> __device__ __forceinline__ void ln_phase_h(const unsigned short* xh, bf16* xb, float* xout, const float* g, const float* b, float* stats, int gw, int NGW, int lane) {
    u32x4 hv[4], nx[4];
    if (gw < MTOK) { const u32x4* xr = (const u32x4*)(xh + (size_t)gw * D) + lane;
#pragma unroll
        for (int j = 0; j < 4; ++j) hv[j] = __builtin_nontemporal_load(xr + 64 * j); }
#pragma unroll 1
    for (int m = gw; m < MTOK; m += NGW) {
        if (m + NGW < MTOK) { const u32x4* xn = (const u32x4*)(xh + (size_t)(m + NGW) * D) + lane;
#pragma unroll
            for (int j = 0; j < 4; ++j) nx[j] = __builtin_nontemporal_load(xn + 64 * j); }
        f32x4 v[8];
#pragma unroll
        for (int j = 0; j < 4; ++j) { const f32x2 a0 = pg8::h2f(hv[j].x), a1 = pg8::h2f(hv[j].y), a2 = pg8::h2f(hv[j].z), a3 = pg8::h2f(hv[j].w);
            v[2 * j] = (f32x4){a0.x, a0.y, a1.x, a1.y}; v[2 * j + 1] = (f32x4){a2.x, a2.y, a3.x, a3.y}; }
        float s = 0.f;
#pragma unroll
        for (int j = 0; j < 8; ++j) s += (v[j][0] + v[j][1]) + (v[j][2] + v[j][3]);
        const float mean = wave_sum(s) * (1.f / D); float s2 = 0.f;
#pragma unroll
        for (int j = 0; j < 8; ++j) { v[j] = v[j] - mean; s2 += (v[j][0] * v[j][0] + v[j][1] * v[j][1]) + (v[j][2] * v[j][2] + v[j][3] * v[j][3]); }
        const float rstd = 1.f / sqrtf(wave_sum(s2) * (1.f / D) + LN_EPS);
        if (!FINAL && lane == 0) *(f32x2*)(stats + 2 * (size_t)m) = (f32x2){mean, rstd};
        u32x4* o8 = (u32x4*)(xb + (size_t)m * D) + lane; f32x4* of = (f32x4*)(xout + (size_t)m * D) + 2 * lane;
#pragma unroll
        for (int j = 0; j < 4; ++j) { const f32x4* gq = (const f32x4*)g + 2 * (lane + 64 * j); const f32x4* bq = (const f32x4*)b + 2 * (lane + 64 * j);
            const f32x4 o0 = v[2 * j] * rstd * gq[0] + bq[0], o1 = v[2 * j + 1] * rstd * gq[1] + bq[1];
            if (FINAL) { of[128 * j] = o0; of[128 * j + 1] = o1; }
            else { u32x4 w; w.x = pk2(o0[0], o0[1]); w.y = pk2(o0[2], o0[3]); w.z = pk2(o1[0], o1[1]); w.w = pk2(o1[2], o1[3]); o8[64 * j] = w; } }
#pragma unroll
        for (int j = 0; j < 4; ++j) hv[j] = nx[j];
    }
}

__device__ __forceinline__ void pool_rows(const bf16* UP, bf16* OP, int row_lo, int row_hi, int step, int lane) {
    const int g = lane >> 4, half = 1 << g;
    for (int row = row_lo; row < row_hi; row += step) {
        const int pos = row_pos(row), S = row_slen(row), lo = max(pos - half, 0), hi = min(pos + half, S);
        const bf16* base = UP + (size_t)(row - pos) * 512 + 8 * lane;
        u32x4 w[16];
#pragma unroll
        for (int k = 0; k < 16; ++k) { const int s = pos - 8 + k; w[k] = (s >= lo && s < hi) ? *(const u32x4*)(base + (size_t)s * 512) : (u32x4){0u, 0u, 0u, 0u}; }
        float sum[8];
#pragma unroll
        for (int i = 0; i < 8; ++i) sum[i] = 0.f;
#pragma unroll
        for (int k = 0; k < 16; ++k) { sum[0] += bflo(w[k].x); sum[1] += bfhi(w[k].x); sum[2] += bflo(w[k].y); sum[3] += bfhi(w[k].y); sum[4] += bflo(w[k].z); sum[5] += bfhi(w[k].z); sum[6] += bflo(w[k].w); sum[7] += bfhi(w[k].w); }
        const u32x4 ws = w[8]; const float inv = 1.f / (float)(hi - lo);
        u32x4 o; o.x = pk2(sum[0] * inv - bflo(ws.x), sum[1] * inv - bfhi(ws.x)); o.y = pk2(sum[2] * inv - bflo(ws.y), sum[3] * inv - bfhi(ws.y));
        o.z = pk2(sum[4] * inv - bflo(ws.z), sum[5] * inv - bfhi(ws.z)); o.w = pk2(sum[6] * inv - bflo(ws.w), sum[7] * inv - bfhi(ws.w));
        *(u32x4*)(OP + (size_t)row * 512 + 8 * lane) = o;
    }
}

template <bool WINDOW>
__device__ __forceinline__ void attn_unit(LAS unsigned char* lds, int wave, int lane_in, const bf16* Qw, int ldq, const bf16* Kg, int ldk, const bf16* VTg, int ldvt, bf16* Ow, int ldo,
                                          int nkb, int qrel0, float m0, float l0) {
    int lane = lane_in; asm volatile("" : "+v"(lane));
    int lr = lane & 15, quad = lane >> 4;
    const int tid = wave * 64 + lane;
#define ATT_DMA(kb, b) do { _Pragma("unroll") for (int j_ = 0; j_ < 4; ++j_) { const int r_ = 32 * j_ + (tid >> 4), sc_ = 8 * ((tid & 15) ^ (r_ & 15)); \
        __builtin_amdgcn_global_load_lds((const GAS unsigned*)(Kg + (size_t)(128 * (kb) + r_) * ldk + sc_), (LAS unsigned*)(lds + (b) * 65536 + (j_ * 8 + wave) * 1024), 16, 0, 0); \
        __builtin_amdgcn_global_load_lds((const GAS unsigned*)(VTg + (size_t)r_ * ldvt + 128 * (kb) + sc_), (LAS unsigned*)(lds + (b) * 65536 + 32768 + (j_ * 8 + wave) * 1024), 16, 0, 0); } } while (0)
    bf16x8 qf[2][4];
#pragma unroll
    for (int G = 0; G < 2; ++G)
#pragma unroll
        for (int ds = 0; ds < 4; ++ds) qf[G][ds] = *(const bf16x8*)(Qw + (unsigned)((16 * G + lr) * ldq + 32 * ds + 8 * quad));
    ATT_DMA(0, 0);
    f32x4 oacc[2][8];
#pragma unroll
    for (int G = 0; G < 2; ++G)
#pragma unroll
        for (int dt = 0; dt < 8; ++dt) oacc[G][dt] = (f32x4){0.f, 0.f, 0.f, 0.f};
    float mrun[2] = {m0, m0}, lrun[2] = {l0, l0};
#pragma unroll 1
    for (int kb = 0; kb < nkb; ++kb) {
        asm volatile("" : "+v"(lr), "+v"(quad));
        if (kb + 1 < nkb) { ATT_DMA(kb + 1, (kb + 1) & 1); asm volatile("s_waitcnt vmcnt(8)" ::: "memory"); }
        else asm volatile("s_waitcnt vmcnt(0)" ::: "memory");
        asm volatile("" ::: "memory"); __builtin_amdgcn_s_barrier(); asm volatile("" ::: "memory");
        const LAS unsigned char* Kb = lds + (kb & 1) * 65536; const LAS unsigned char* Vb = Kb + 32768;
        f32x4 sacc[2][8];
#pragma unroll
        for (int T = 0; T < 8; ++T) {
            bf16x8 kf[4];
#pragma unroll
            for (int ds = 0; ds < 4; ++ds) kf[ds] = *(const LAS bf16x8*)(Kb + (16 * T + lr) * 256 + 16 * ((4 * ds + quad) ^ lr));
#pragma unroll
            for (int G = 0; G < 2; ++G) { f32x4 cc = (f32x4){0.f, 0.f, 0.f, 0.f};
#pragma unroll
                for (int ds = 0; ds < 4; ++ds) cc = __builtin_amdgcn_mfma_f32_16x16x32_bf16(kf[ds], qf[G][ds], cc, 0, 0, 0);
                sacc[G][T] = cc; }
        }
#pragma unroll
        for (int G = 0; G < 2; ++G) {
            float mx = -3.0e38f;
#pragma unroll
            for (int T = 0; T < 8; ++T)
#pragma unroll
                for (int r = 0; r < 4; ++r) { float t = sacc[G][T][r] * ATT_C1;
                    if (WINDOW) { const int dd = (qrel0 + 16 * G + lr) - (128 * kb + 16 * T + 4 * quad + r); if (dd > 128 || dd < -128) t = -1.0e30f; }
                    sacc[G][T][r] = t; mx = fmaxf(mx, t); }
            mx = fmaxf(mx, __shfl_xor(mx, 16)); mx = fmaxf(mx, __shfl_xor(mx, 32));
            const float mnew = fmaxf(mrun[G], mx), alpha = __builtin_amdgcn_exp2f(mrun[G] - mnew); mrun[G] = mnew;
            float sum = 0.f;
#pragma unroll
            for (int T = 0; T < 8; ++T)
#pragma unroll
                for (int r = 0; r < 4; ++r) { const float p = __builtin_amdgcn_exp2f(sacc[G][T][r] - mnew); sacc[G][T][r] = p; sum += p; }
            sum += __shfl_xor(sum, 16); sum += __shfl_xor(sum, 32);
            lrun[G] = lrun[G] * alpha + sum;
#pragma unroll
            for (int dt = 0; dt < 8; ++dt) oacc[G][dt] = oacc[G][dt] * alpha;
        }
#pragma unroll
        for (int s = 0; s < 4; ++s) {
            bf16x8 pf[2];
#pragma unroll
            for (int G = 0; G < 2; ++G) { u32x4 w; w.x = pk2(sacc[G][2 * s][0], sacc[G][2 * s][1]); w.y = pk2(sacc[G][2 * s][2], sacc[G][2 * s][3]);
                w.z = pk2(sacc[G][2 * s + 1][0], sacc[G][2 * s + 1][1]); w.w = pk2(sacc[G][2 * s + 1][2], sacc[G][2 * s + 1][3]); pf[G] = __builtin_bit_cast(bf16x8, w); }
#pragma unroll
            for (int dt = 0; dt < 8; ++dt) {
                const int p8 = 8 * s + quad;
                const LAS unsigned char* vrow = Vb + (16 * dt + lr) * 256 + 8 * (p8 & 1);
                const u32x2 lo = *(const LAS u32x2*)(vrow + 16 * ((p8 >> 1) ^ lr)), hi = *(const LAS u32x2*)(vrow + 16 * (((p8 >> 1) + 2) ^ lr));
                const bf16x8 vf = __builtin_bit_cast(bf16x8, (u32x4){lo.x, lo.y, hi.x, hi.y});
#pragma unroll
                for (int G = 0; G < 2; ++G) oacc[G][dt] = __builtin_amdgcn_mfma_f32_16x16x32_bf16(vf, pf[G], oacc[G][dt], 0, 0, 0);
            }
        }
        asm volatile("" ::: "memory"); __builtin_amdgcn_s_barrier(); asm volatile("" ::: "memory");
    }
#undef ATT_DMA
#pragma unroll
    for (int G = 0; G < 2; ++G) { const float inv = 1.f / lrun[G];
#pragma unroll
        for (int dt = 0; dt < 8; ++dt) { const f32x4 o = oacc[G][dt] * inv; u32x2 w; w.x = pk2(o[0], o[1]); w.y = pk2(o[2], o[3]);
            *(u32x2*)(Ow + (unsigned)((16 * G + lr) * ldo + 16 * dt + 4 * quad)) = w; } }
}

__device__ __forceinline__ void winattn_unit(KArgs a, int L, LAS unsigned char* lds, int wave, int lane, int unit) {
    unsigned char* ws = (unsigned char*)a->ws;
    const bf16* Q = (const bf16*)(ws + WS_Q); const bf16* K = (const bf16*)(ws + WS_K); const bf16* VT = (const bf16*)(ws + WS_VT); bf16* O = (bf16*)(ws + WS_OATT);
    const float* sink = ((const float*)a->in[I_SINK]) + L * 8;
    const int hkv = unit & 1, row0 = (unit >> 1) * 64, pos0 = row_pos(row0), S = row_slen(row0), qb = pos0 >> 7;
    const int kb_lo = max(qb - 1, 0), kb_hi = min(qb + 1, (S >> 7) - 1), keyrow0 = (row0 - pos0) + 128 * kb_lo;
    const int hq = hkv * 4 + (wave & 3), rw = row0 + 32 * (wave >> 2);
    attn_unit<true>(lds, wave, lane, Q + (size_t)rw * 1024 + hq * 128, 1024, K + (size_t)keyrow0 * 256 + hkv * 128, 256, VT + (size_t)(hkv * 128) * MTOK + keyrow0, MTOK,
                    O + (size_t)rw * 1024 + hq * 128, 1024, kb_hi - kb_lo + 1, (pos0 + 32 * (wave >> 2)) - 128 * kb_lo, sink[hq] * LOG2E, 1.f);
}
constexpr int NQ_ATT = (MTOK / 64) * 2, NQ_POOL = MTOK / 64;
__device__ __forceinline__ void mixq_phase(KArgs a, int L, LAS unsigned char* lds, volatile LAS unsigned* MISC, unsigned* ctr, int wave, int lane) {
    unsigned char* ws = (unsigned char*)a->ws;
    for (;;) {
        if (wave == 0 && lane == 0) MISC[0] = __hip_atomic_fetch_add(ctr, 1u, __ATOMIC_RELAXED, __HIP_MEMORY_SCOPE_AGENT);
        __syncthreads();
        const int u = (int)MISC[0];
        __syncthreads();
        if (u >= NQ_ATT + NQ_POOL) break;
        if (u < NQ_ATT) winattn_unit(a, L, lds, wave, lane, u);
        else { const int r0 = (u - NQ_ATT) * 64 + wave * 8; pool_rows((const bf16*)(ws + WS_UPOOL), (bf16*)(ws + WS_OPOOL), r0, r0 + 8, 1, lane); }
    }
}
__device__ __forceinline__ void xattn_phase(KArgs a, LAS unsigned char* lds, int wave, int lane) {
    unsigned char* ws = (unsigned char*)a->ws;
    const bf16* Q = (const bf16*)(ws + WS_QX); const bf16* K = (const bf16*)(ws + WS_KX); const bf16* VT = (const bf16*)(ws + WS_VXT); bf16* O = (bf16*)(ws + WS_OX);
    for (int unit = blockIdx.x; unit < (MTOK / 256) * 4; unit += gridDim.x) {
        const int h = unit & 3, row0 = (unit >> 2) * 256, seq = row0 < SEQP ? 0 : 1 + ((row0 - SEQP) >> 12), rw = row0 + 32 * wave;
        attn_unit<false>(lds, wave, lane, Q + (size_t)rw * 512 + h * 128, 512, K + (size_t)(MEML * seq) * 512 + h * 128, 512, VT + (size_t)(h * 128) * MMEM + MEML * seq, MMEM,
                         O + (size_t)rw * 512 + h * 128, 512, 2, 0, -1.0e30f, 0.f);
    }
}

__device__ __forceinline__ void prepa_phase(KArgs a, int L, int gw, int NGW, int lane_in) {
    unsigned char* ws = (unsigned char*)a->ws;
    const float* U = (const float*)(ws + WS_URWKV); float* SH = (float*)(ws + WS_SH); float* KB = (float*)(ws + WS_KBUF); bf16* AL = (bf16*)(ws + WS_AL);
    const float* mu0p = ((const float*)a->in[I_MU]) + (size_t)L * 2 * RWC; const float* mu1p = mu0p + RWC; const float* k_k = ((const float*)a->in[I_KK]) + L * 512;
    int lane = lane_in; asm volatile("" : "+v"(lane));
    f32x4 m0[8], m1[8];
#pragma unroll
    for (int j = 0; j < 8; ++j) { const int c = 256 * j + 4 * lane; const bool ok = c < RWC; m0[j] = ok ? *(const f32x4*)(mu0p + c) : (f32x4){0.f, 0.f, 0.f, 0.f}; m1[j] = ok ? *(const f32x4*)(mu1p + c) : (f32x4){0.f, 0.f, 0.f, 0.f}; }
    const f32x4 kk0 = *(const f32x4*)(k_k + 4 * lane), kk1 = *(const f32x4*)(k_k + 256 + 4 * lane);
    const f32x4 zero4 = {0.f, 0.f, 0.f, 0.f};
    for (int run = gw; run < MTOK / 8; run += NGW) {
        const int r0 = run * 8, pos0 = row_pos(r0), S = row_slen(r0);
        f32x4 P[8], C[8], N[8];
        { const float* up = U + (size_t)(r0 - 1) * 2048 + 4 * lane; const float* uc = U + (size_t)r0 * 2048 + 4 * lane; const bool hp = pos0 > 0;
#pragma unroll
          for (int j = 0; j < 8; ++j) { P[j] = hp ? *(const f32x4*)(up + 256 * j) : zero4; C[j] = *(const f32x4*)(uc + 256 * j); } }
#pragma unroll 1
        for (int t = 0; t < 8; ++t) {
            const int row = r0 + t; const bool hn = (pos0 + t) < S - 1;
            { const float* un = U + (size_t)(row + 1) * 2048 + 4 * lane;
#pragma unroll
              for (int j = 0; j < 8; ++j) N[j] = hn ? *(const f32x4*)(un + 256 * j) : zero4; }
            f32x4 xs[8];
#pragma unroll
            for (int j = 0; j < 8; ++j) xs[j] = C[j] + m0[j] * (P[j] - C[j]) + m1[j] * (N[j] - C[j]);
            const int hl = lane >> 4, jj = 4 * (lane & 15);
#pragma unroll
            for (int j2 = 0; j2 < 2; ++j2) { float* sh = SH + ((size_t)row * 8 + 4 * j2 + hl) * 192 + jj;
                *(f32x4*)(sh + 64) = xs[j2]; *(f32x4*)(sh + 128) = xs[4 + j2];
                const f32x4 kv = xs[2 + j2]; *(f32x4*)(KB + (size_t)row * 512 + 256 * j2 + 4 * lane) = kv;
                const f32x4 ku = kv * (j2 ? kk1 : kk0); float ss = (ku[0] * ku[0] + ku[1] * ku[1]) + (ku[2] * ku[2] + ku[3] * ku[3]);
                ss += __shfl_xor(ss, 1); ss += __shfl_xor(ss, 2); ss += __shfl_xor(ss, 4); ss += __shfl_xor(ss, 8);
                const float inv = -1.f / fmaxf(sqrtf(ss), 1e-12f); *(f32x4*)sh = ku * inv; }
            { const f32x4 x6 = xs[6]; f32x4 o6;
#pragma unroll
              for (int e = 0; e < 4; ++e) o6[e] = lane < 32 ? tanhf(x6[e]) : x6[e];
              u32x2 w; w.x = pk2(o6[0], o6[1]); w.y = pk2(o6[2], o6[3]); *(u32x2*)(AL + (size_t)row * 384 + 4 * lane) = w;
              if (lane < 32) { const f32x4 x7 = xs[7]; u32x2 w7; w7.x = pk2(1.f / (1.f + expf(-x7[0])), 1.f / (1.f + expf(-x7[1]))); w7.y = pk2(1.f / (1.f + expf(-x7[2])), 1.f / (1.f + expf(-x7[3])));
                  *(u32x2*)(AL + (size_t)row * 384 + 256 + 4 * lane) = w7; } }
#pragma unroll
            for (int j = 0; j < 8; ++j) { P[j] = C[j]; C[j] = N[j]; }
        }
    }
}

__device__ __forceinline__ void scan_phase(KArgs a, LAS unsigned char* lds, int gw, int NGW, int wave, int lane) {
    unsigned char* ws = (unsigned char*)a->ws;
    const float* SH = (const float*)(ws + WS_SH); const float* DIR = (const float*)(ws + WS_DIR);
    float* Y = (float*)(ws + WS_Y); float* Z = (float*)(ws + WS_Z); float* QM = (float*)(ws + WS_QM); float* PM = (float*)(ws + WS_PM);
    LAS unsigned char* wlb = lds + RING_OFF + wave * 12288;
    for (int task = gw; task < NCP * 16; task += NGW) {
        const int cp = task >> 4, e = (task >> 3) & 1, h = task & 7;
#define SCAN_DMA(bb) do { int ln_ = lane; asm volatile("" : "+v"(ln_)); _Pragma("unroll") for (int pr_ = 0; pr_ < 2; ++pr_) _Pragma("unroll") for (int k_ = 0; k_ < 3; ++k_) { \
            const int o_ = 1024 * k_ + 16 * ln_, stp_ = o_ >= 1536 ? 1 : 0, wi_ = o_ - 1536 * stp_, blk_ = wi_ >= 768 ? 1 : 0, off_ = (wi_ - 768 * blk_) >> 2; \
            const int tau_ = 4 * (bb) + 2 * pr_ + stp_, row_ = cp * CH + (e ? CH - 1 - tau_ : tau_); \
            const float* src_ = blk_ ? DIR + (((size_t)row_ * 2 + e) * 8 + h) * 192 + off_ : SH + ((size_t)row_ * 8 + h) * 192 + off_; \
            __builtin_amdgcn_global_load_lds((const GAS unsigned*)src_, (LAS unsigned*)(wlb + (((bb) & 1) * 4 + 2 * pr_) * 1536 + 1024 * k_), 16, 0, 0); } } while (0)
        LDS_WAIT(); asm volatile("" ::: "memory");
        SCAN_DMA(0);
        asm volatile("" ::: "memory");
        f32x2 S2[32], X2[32];
        { int ln = lane; asm volatile("" : "+v"(ln));
#pragma unroll
          for (int q = 0; q < 32; ++q) { S2[q] = (f32x2){0.f, 0.f}; X2[q] = (f32x2){(2 * q == ln) ? 1.f : 0.f, (2 * q + 1 == ln) ? 1.f : 0.f}; } }
        f32x4 buf[2][8];
#pragma unroll 1
        for (int bb = 0; bb < CH / 4; ++bb) {
            if (bb == 0) asm volatile("s_waitcnt vmcnt(0)" ::: "memory");
            else asm volatile("s_waitcnt vmcnt(8)" ::: "memory");
            if (bb + 1 < CH / 4) SCAN_DMA(bb + 1);
            const LAS float* p0 = (const LAS float*)(wlb + ((bb & 1) * 4) * 1536);
#pragma unroll
            for (int i = 0; i < 8; ++i) buf[0][i] = *(const LAS f32x4*)(p0 + 4 * i);
#pragma unroll 1
            for (int st = 0; st < 4; ++st) {
                const LAS float* p = p0 + st * 384;
                const int tau = 4 * bb + st, row = cp * CH + (e ? CH - 1 - tau : tau);
                const float vi = p[128 + lane];
                f32x2 sa0 = {0.f, 0.f}, sa1 = {0.f, 0.f}, sx0 = {0.f, 0.f}, sx1 = {0.f, 0.f};
#pragma unroll
                for (int i = 0; i < 8; ++i) buf[1][i] = *(const LAS f32x4*)(p + 32 + 4 * i);
                asm volatile("" : "+v"(sa0), "+v"(sx0) :: "memory");
#pragma unroll
                for (int i = 0; i < 8; ++i) { const f32x4 nk = buf[0][i]; sa0 += S2[2 * i] * nk.xy; sa1 += S2[2 * i + 1] * nk.zw; sx0 += X2[2 * i] * nk.xy; sx1 += X2[2 * i + 1] * nk.zw; }
                asm volatile("" : "+v"(sa0), "+v"(sa1), "+v"(sx0), "+v"(sx1) :: "memory");
#pragma unroll
                for (int j = 0; j < 2; ++j) { buf[0][j] = *(const LAS f32x4*)(p + 64 + 4 * j); buf[0][2 + j] = *(const LAS f32x4*)(p + 192 + 4 * j); buf[0][4 + j] = *(const LAS f32x4*)(p + 256 + 4 * j); buf[0][6 + j] = *(const LAS f32x4*)(p + 320 + 4 * j); }
                asm volatile("" : "+v"(sa0), "+v"(sx0) :: "memory");
#pragma unroll
                for (int i = 0; i < 8; ++i) { const f32x4 nk = buf[1][i]; sa0 += S2[16 + 2 * i] * nk.xy; sa1 += S2[16 + 2 * i + 1] * nk.zw; sx0 += X2[16 + 2 * i] * nk.xy; sx1 += X2[16 + 2 * i + 1] * nk.zw; }
                asm volatile("" : "+v"(sa0), "+v"(sa1), "+v"(sx0), "+v"(sx1) :: "memory");
                const float sa = (sa0.x + sa0.y) + (sa1.x + sa1.y), sx = (sx0.x + sx0.y) + (sx1.x + sx1.y);
                const f32x2 sav = {sa, sa}, sxv = {sx, sx}, vv = {vi, vi};
                f32x2 y0 = {0.f, 0.f}, y1 = {0.f, 0.f}, z0 = {0.f, 0.f}, z1 = {0.f, 0.f};
#pragma unroll
                for (int g = 0; g < 8; ++g) {
                    if (g < 7) {
#pragma unroll
                        for (int j = 0; j < 2; ++j) { const int q = 2 * (g + 1) + j; buf[(g + 1) & 1][j] = *(const LAS f32x4*)(p + 64 + 4 * q); buf[(g + 1) & 1][2 + j] = *(const LAS f32x4*)(p + 192 + 4 * q);
                            buf[(g + 1) & 1][4 + j] = *(const LAS f32x4*)(p + 256 + 4 * q); buf[(g + 1) & 1][6 + j] = *(const LAS f32x4*)(p + 320 + 4 * q); }
                    } else if (st < 3) {
#pragma unroll
                        for (int i = 0; i < 8; ++i) buf[0][i] = *(const LAS f32x4*)(p + 384 + 4 * i);
                    }
                    asm volatile("" : "+v"(y0), "+v"(z0) :: "memory");
#pragma unroll
                    for (int j = 0; j < 2; ++j) { const int q = 2 * g + j; const f32x4 r4 = buf[g & 1][j], w4 = buf[g & 1][2 + j], ka4 = buf[g & 1][4 + j], kd4 = buf[g & 1][6 + j];
                        S2[2 * q] = S2[2 * q] * w4.xy + sav * ka4.xy + vv * kd4.xy; y0 += S2[2 * q] * r4.xy;
                        S2[2 * q + 1] = S2[2 * q + 1] * w4.zw + sav * ka4.zw + vv * kd4.zw; y1 += S2[2 * q + 1] * r4.zw;
                        X2[2 * q] = X2[2 * q] * w4.xy + sxv * ka4.xy; z0 += X2[2 * q] * r4.xy;
                        X2[2 * q + 1] = X2[2 * q + 1] * w4.zw + sxv * ka4.zw; z1 += X2[2 * q + 1] * r4.zw; }
                    asm volatile("" : "+v"(y0), "+v"(y1), "+v"(z0), "+v"(z1) :: "memory");
                }
                const size_t oi = (((size_t)row * 2 + e) * 8 + h) * 64 + lane;
                Y[oi] = (y0.x + y0.y) + (y1.x + y1.y); Z[oi] = (z0.x + z0.y) + (z1.x + z1.y);
            }
        }
#undef SCAN_DMA
        float* qo = QM + (size_t)task * 4096 + lane * 64; float* po = PM + (size_t)task * 4096 + lane * 64;
#pragma unroll
        for (int q = 0; q < 16; ++q) { *(f32x4*)(qo + 4 * q) = (f32x4){S2[2 * q].x, S2[2 * q].y, S2[2 * q + 1].x, S2[2 * q + 1].y};
            *(f32x4*)(po + 4 * q) = (f32x4){X2[2 * q].x, X2[2 * q].y, X2[2 * q + 1].x, X2[2 * q + 1].y}; }
    }
}

__device__ __forceinline__ void carry_phase(KArgs a, LAS unsigned char* lds, int wave, int lane_in) {
    const int chain = blockIdx.x;
    if (chain >= NSEQ * 16) return;
    unsigned char* ws = (unsigned char*)a->ws;
    const float* QM = (const float*)(ws + WS_QM); const float* PM = (const float*)(ws + WS_PM); float* SST = (float*)(ws + WS_SST);
    const int seq = chain >> 4, e = (chain >> 3) & 1, h = chain & 7;
    const int cp0 = seq == 0 ? 0 : (SEQP / CH) + (SEQS / CH) * (seq - 1), nc = seq == 0 ? SEQP / CH : SEQS / CH;
    LAS float* ST = (LAS float*)(lds + RING_OFF); LAS float* PB = (LAS float*)(lds + RING_OFF + 16896);
    int lane = lane_in; asm volatile("" : "+v"(lane));
    const int tid = wave * 64 + lane, lr = lane & 15, quad = lane >> 4, ti = wave >> 1, tj0 = 2 * (wave & 1);
    f32x4 sreg[2] = {{0.f, 0.f, 0.f, 0.f}, {0.f, 0.f, 0.f, 0.f}};
    for (int k = tid; k < 64 * 65; k += 512) ST[k] = 0.f;
    f32x4 pn0, pn1; float qn[2][4];
    { const int cp = e ? cp0 + nc - 1 : cp0; const size_t sidx = ((size_t)cp * 2 + e) * 8 + h;
      pn0 = *(const f32x4*)(PM + sidx * 4096 + 4 * tid); pn1 = *(const f32x4*)(PM + sidx * 4096 + 2048 + 4 * tid);
#pragma unroll
      for (int t = 0; t < 2; ++t)
#pragma unroll
          for (int r = 0; r < 4; ++r) qn[t][r] = QM[sidx * 4096 + (size_t)(16 * ti + 4 * quad + r) * 64 + 16 * (tj0 + t) + lr]; }
#pragma unroll 1
    for (int c = 0; c < nc; ++c) {
        const int cp = e ? cp0 + nc - 1 - c : cp0 + c; const size_t sidx = ((size_t)cp * 2 + e) * 8 + h;
#pragma unroll
        for (int t = 0; t < 2; ++t) { const int j = 16 * (tj0 + t) + lr;
#pragma unroll
            for (int r = 0; r < 4; ++r) SST[sidx * 4096 + (size_t)((j >> 2) * 64 + 16 * ti + 4 * quad + r) * 4 + (j & 3)] = sreg[t][r]; }
        if (c == nc - 1) break;
        { const int i0 = 4 * tid, i1 = 2048 + 4 * tid; *(LAS f32x4*)(PB + (i0 >> 6) * 80 + (i0 & 63)) = pn0; *(LAS f32x4*)(PB + (i1 >> 6) * 80 + (i1 & 63)) = pn1; }
        f32x4 acc[2];
#pragma unroll
        for (int t = 0; t < 2; ++t) acc[t] = (f32x4){qn[t][0], qn[t][1], qn[t][2], qn[t][3]};
        if (c + 1 < nc - 1) { const int cpn = e ? cp0 + nc - 2 - c : cp0 + c + 1; const size_t sn = ((size_t)cpn * 2 + e) * 8 + h;
            pn0 = *(const f32x4*)(PM + sn * 4096 + 4 * tid); pn1 = *(const f32x4*)(PM + sn * 4096 + 2048 + 4 * tid);
#pragma unroll
            for (int t = 0; t < 2; ++t)
#pragma unroll
                for (int r = 0; r < 4; ++r) qn[t][r] = QM[sn * 4096 + (size_t)(16 * ti + 4 * quad + r) * 64 + 16 * (tj0 + t) + lr]; }
        __syncthreads();
#pragma unroll
        for (int kk = 0; kk < 16; ++kk) { const float a_ = ST[(16 * ti + lr) * 65 + 4 * kk + quad];
#pragma unroll
            for (int t = 0; t < 2; ++t) { const float b_ = PB[(4 * kk + quad) * 80 + 16 * (tj0 + t) + lr]; acc[t] = __builtin_amdgcn_mfma_f32_16x16x4f32(a_, b_, acc[t], 0, 0, 0); } }
        __syncthreads();
#pragma unroll
        for (int t = 0; t < 2; ++t) {
#pragma unroll
            for (int r = 0; r < 4; ++r) ST[(16 * ti + 4 * quad + r) * 65 + 16 * (tj0 + t) + lr] = acc[t][r];
            sreg[t] = acc[t]; }
    }
}

struct PostIn { float zf[4], zb[4], yv[4], rr[4], vv[4], kd[4], gt[4]; };
__device__ __forceinline__ void post_load(PostIn& q, const float* SH, const float* DIR, const float* Y, const float* Z, const bf16* G, int rowb, int h, int lane) {
#pragma unroll
    for (int u = 0; u < 4; ++u) { const int row = rowb + u; const size_t yi = (((size_t)row * 2) * 8 + h) * 64 + lane;
        q.zf[u] = Z[yi]; q.zb[u] = Z[yi + 512]; q.yv[u] = Y[yi] + Y[yi + 512];
        const float* sh = SH + ((size_t)row * 8 + h) * 192; q.rr[u] = sh[64 + lane]; q.vv[u] = sh[128 + lane];
        q.kd[u] = DIR[(((size_t)row * 2 + 0) * 8 + h) * 192 + 128 + lane] + DIR[(((size_t)row * 2 + 1) * 8 + h) * 192 + 128 + lane];
        q.gt[u] = __uint_as_float(((unsigned)G[(size_t)row * 512 + h * 64 + lane]) << 16); }
}
__device__ __forceinline__ void post_phase(KArgs a, int L, LAS unsigned char* lds, int gw, int NGW, int wave, int lane_in) {
    unsigned char* ws = (unsigned char*)a->ws;
    const float* SH = (const float*)(ws + WS_SH); const float* DIR = (const float*)(ws + WS_DIR); const float* Y = (const float*)(ws + WS_Y); const float* Z = (const float*)(ws + WS_Z);
    const float* SST = (const float*)(ws + WS_SST); const bf16* G = (const bf16*)(ws + WS_G); bf16* O = (bf16*)(ws + WS_ORWKV);
    const float* gng = ((const float*)a->in[I_GNG]) + L * 512; const float* gnb = ((const float*)a->in[I_GNB]) + L * 512; const float* rk = ((const float*)a->in[I_RK]) + L * 512;
    LAS float* zl = (LAS float*)(lds + RING_OFF + wave * 2048);
    for (int task = gw; task < NCP * 16; task += NGW) {
        int lane = lane_in; asm volatile("" : "+v"(lane));
        const int cp = task >> 4, hf = (task >> 3) & 1, h = task & 7;
        PostIn cur, nxt;
        post_load(cur, SH, DIR, Y, Z, G, cp * CH + hf * 64, h, lane);
        f32x2 Sf[32], Sb[32];
        { const float* sf = SST + (((size_t)cp * 2 + 0) * 8 + h) * 4096 + lane * 4; const float* sb = SST + (((size_t)cp * 2 + 1) * 8 + h) * 4096 + lane * 4;
#pragma unroll
          for (int q = 0; q < 16; ++q) { const f32x4 x = *(const f32x4*)(sf + q * 256), y = *(const f32x4*)(sb + q * 256); Sf[2 * q] = x.xy; Sf[2 * q + 1] = x.zw; Sb[2 * q] = y.xy; Sb[2 * q + 1] = y.zw; } }
        const float gg = gng[h * 64 + lane], gb = gnb[h * 64 + lane], rkk = rk[h * 64 + lane];
#pragma unroll 1
        for (int tb = 0; tb < 16; ++tb) {
            const int rowb = cp * CH + hf * 64 + tb * 4;
            if (tb < 15) post_load(nxt, SH, DIR, Y, Z, G, rowb + 4, h, lane);
            LDS_WAIT(); asm volatile("" ::: "memory");
#pragma unroll
            for (int u = 0; u < 4; ++u) { zl[(u * 2 + 0) * 64 + lane] = cur.zf[u]; zl[(u * 2 + 1) * 64 + lane] = cur.zb[u]; }
            LDS_WAIT(); asm volatile("" ::: "memory");
            float y[4], sbn[4];
#pragma unroll
            for (int u = 0; u < 4; ++u) {
                f32x2 c0 = {0.f, 0.f}, c1 = {0.f, 0.f};
#pragma unroll
                for (int q = 0; q < 16; ++q) { const f32x4 f4 = *(const LAS f32x4*)(zl + (u * 2 + 0) * 64 + 4 * q), b4 = *(const LAS f32x4*)(zl + (u * 2 + 1) * 64 + 4 * q);
                    c0 += Sf[2 * q] * f4.xy + Sb[2 * q] * b4.xy; c1 += Sf[2 * q + 1] * f4.zw + Sb[2 * q + 1] * b4.zw; }
                y[u] = cur.yv[u] + (c0.x + c0.y) + (c1.x + c1.y); sbn[u] = cur.rr[u] * cur.kd[u] * rkk;
            }
            float mean[4];
#pragma unroll
            for (int u = 0; u < 4; ++u) mean[u] = y[u];
#pragma unroll
            for (int o = 1; o < 64; o <<= 1)
#pragma unroll
                for (int u = 0; u < 4; ++u) { mean[u] += __shfl_xor(mean[u], o); sbn[u] += __shfl_xor(sbn[u], o); }
            float var[4];
#pragma unroll
            for (int u = 0; u < 4; ++u) { y[u] -= mean[u] * (1.f / 64.f); var[u] = y[u] * y[u]; }
#pragma unroll
            for (int o = 1; o < 64; o <<= 1)
#pragma unroll
                for (int u = 0; u < 4; ++u) var[u] += __shfl_xor(var[u], o);
#pragma unroll
            for (int u = 0; u < 4; ++u) { const float yn = y[u] * (1.f / sqrtf(var[u] * (1.f / 64.f) + GN_EPS)) * gg + gb;
                const float o = (yn + sbn[u] * cur.vv[u]) * cur.gt[u];
                O[(size_t)(rowb + u) * 512 + h * 64 + lane] = (bf16)(pk2(o, 0.f) & 0xffffu); }
            cur = nxt;
        }
    }
}

#define SEAM() do { if (a.single) { XcdBarrier b_ = bar; asm volatile("" : "+s"(b_.bar), "+s"(b_.x)); xcd_barrier(b_); } } while (0)
#ifndef PHMASK
#define PHMASK 0x1ffff
#endif
#ifndef DUPMASK
#define DUPMASK 0
#endif
#define RUN(k) ((((PHMASK) >> (k)) & 1) && a.ph_lo <= (k) && (k) < a.ph_hi)
#define REP(k) for (int rep_ = 0; rep_ < (((DUPMASK) >> (k)) & 1) + 1; ++rep_)
#define KA() KArgs ka = (KArgs)__builtin_amdgcn_kernarg_segment_ptr(); asm volatile("" : "+s"(ka)); unsigned char* ws = (unsigned char*)ka->ws; float* X = (float*)ka->out; unsigned short* XH = (unsigned short*)ka->out; unsigned short* XF = (unsigned short*)(ws + WS_GATES); (void)XH; (void)XF; bf16* XB = (bf16*)(ws + WS_XB); (void)X; (void)XB
#define IDS() KA(); const int lane = hw_lane(), wave = wave_s, tid = wave * 64 + lane, gw = blockIdx.x * NWAVES + wave, gtid = blockIdx.x * (NWAVES * 64) + tid; (void)lane; (void)gw; (void)gtid; (void)tid


template <int IT> __device__ __forceinline__ void half_layer(const Args& a, LAS unsigned char* lds, const XcdBarrier& bar, int G, int NGW, int NT, int wave_s) {
    constexpr int it = IT;
        const int L = it >> 1, s = it & 1;
        REP(0) if (s == 0 && RUN(0)) { IDS(); conv_phase(ka, L, lds, gw, NGW, wave, lane, gtid, NT); if (it == 0) prologue_phase(ka, gtid, NT); __syncthreads(); SEAM(); }
        REP(1) if (RUN(1)) {
            KA();
            pg8::Gemm g{XB, (const bf16*)(ws + WS_W1T) + (size_t)s * 2 * DFF * D, MTOK, 2 * DFF, D}; pg8::StaticOrder S; S.init(MTOK, 2 * DFF, G, (int)blockIdx.x);
            pg8::EpiSwiglu E{(bf16*)(ws + WS_H)};
            pg8::gemm_phase<pg8::EpiSwiglu, pg8::StaticOrder, true, true>(lds + RING_OFF, g, S, E, wave_s);
            SEAM();
        }
        REP(2) if (RUN(2)) {
            KA();
            pg8::Gemm g{(const bf16*)(ws + WS_H), (const bf16*)(ws + WS_W2T) + (size_t)s * D * DFF, MTOK, D, DFF}; pg8::StaticOrder S; S.init(MTOK, D, G, (int)blockIdx.x, 4);
            constexpr int pli = it == 0 ? 0 : (s == 0 ? ((L - 1) * 4 + 3) : (L * 4 + 2));
            if constexpr (it == 0) { pg8::EpiResidH<false, true, false> E{XH, XF, nullptr, (const float*)ka->in[I_XP], (const float*)ka->in[I_XS]};
                pg8::gemm_phase<pg8::EpiResidH<false, true, false>, pg8::StaticOrder, true, true>(lds + RING_OFF, g, S, E, wave_s); }
            else { constexpr bool last = (it == 2 * DEPTH - 1); pg8::EpiResidH<true, true, last> E{XH, XF, (const float*)(ws + WS_STATS), ((const float*)ka->in[I_LNG]) + pli * D, ((const float*)ka->in[I_LNB]) + pli * D};
                pg8::gemm_phase<pg8::EpiResidH<true, true, last>, pg8::StaticOrder, true, true>(lds + RING_OFF, g, S, E, wave_s); }
            SEAM();
        }
        REP(3) if (RUN(3)) { IDS(); const int li = (L * 4 + (s ? 3 : 0)) * D; if constexpr (it == 2 * DEPTH - 1) ln_phase_h<true>(XF, XB, X, ((const float*)ka->in[I_LNG]) + li, ((const float*)ka->in[I_LNB]) + li, (float*)(ws + WS_STATS), gw, NGW, lane);
            else ln_phase_h<false>(XH, XB, X, ((const float*)ka->in[I_LNG]) + li, ((const float*)ka->in[I_LNB]) + li, (float*)(ws + WS_STATS), gw, NGW, lane); SEAM(); }
        if (s == 0) {
            REP(4) if (RUN(4)) {
                KA();
                { pg8::Gemm g{XB, (const bf16*)(ws + WS_WINT), MTOK, NWIN, D}; pg8::StaticOrder S; S.init(MTOK, NWIN, G, (int)blockIdx.x);
                  pg8::EpiWin E{(bf16*)(ws + WS_UPOOL), (bf16*)(ws + WS_Q), (bf16*)(ws + WS_K), (bf16*)(ws + WS_GATES), (float*)(ws + WS_URWKV), (const float*)(ws + WS_CS), (bf16*)(ws + WS_VT)};
                  pg8::gemm_phase<pg8::EpiWin, pg8::StaticOrder, true, true>(lds + RING_OFF, g, S, E, wave_s); }
                SEAM();
            }
            REP(5) if (RUN(5)) {
                IDS();
                REP(19) prepa_phase(ka, L, gw, NGW, lane);
                SEAM();
            }
            REP(6) if (RUN(6)) {
                KA();
                pg8::Gemm g{(const bf16*)(ws + WS_AL), (const bf16*)(ws + WS_BL), MTOK, 2560, 384}; pg8::StaticOrder S; S.init(MTOK, 2560, G, (int)blockIdx.x);
                pg8::EpiLora E{((const float*)ka->in[I_W0]) + L * 1024, ((const float*)ka->in[I_A0]) + L * 1024, ((const float*)ka->in[I_KA]) + L * 512, (const float*)(ws + WS_SH), (const float*)(ws + WS_KBUF), (float*)(ws + WS_DIR), (bf16*)(ws + WS_G)};
                pg8::gemm_phase<pg8::EpiLora, pg8::StaticOrder, true, true>(lds + RING_OFF, g, S, E, wave_s);
                SEAM();
            }
            REP(7) if (RUN(7)) { IDS(); scan_phase(ka, lds, gw, NGW, wave, lane); SEAM(); }
            REP(8) if (RUN(8)) { IDS(); carry_phase(ka, lds, wave, lane); __syncthreads();
                mixq_phase(ka, L, lds, (volatile LAS unsigned*)(lds + MISC_OFF), (unsigned*)((unsigned long long)ka->ws + WS_CTL + 65536 + 256 * (L * 2 + rep_)), wave, lane); SEAM(); }
            REP(9) if (RUN(9)) { IDS(); post_phase(ka, L, lds, gw, NGW, wave, lane); SEAM(); }
            REP(10) if (RUN(10)) {
                KA();
#pragma unroll 1
                for (int b = 0; b < 3; ++b) {
                    const bf16* Ab = (const bf16*)(ws + (b == 0 ? WS_OPOOL : (b == 1 ? WS_OATT : WS_ORWKV)));
                    const bf16* Bb = (const bf16*)(ws + (b == 0 ? WS_WBR0 : (b == 1 ? WS_WBR1 : WS_WBR2)));
                    pg8::Gemm g{Ab, Bb, MTOK, D, b == 1 ? 1024 : 512}; pg8::StaticOrder S; S.init(MTOK, D, G, (int)blockIdx.x, 4);
                    pg8::EpiBranch E{(bf16*)(ws + WS_MERGED), (const bf16*)(ws + WS_GATES) + b * D, b == 0 ? 1 : 0};
                    pg8::gemm_phase<pg8::EpiBranch, pg8::StaticOrder, true, true>(lds + RING_OFF, g, S, E, wave_s);
                }
                SEAM();
            }
            REP(11) if (RUN(11)) {
                KA();
                pg8::Gemm g{(const bf16*)(ws + WS_MERGED), (const bf16*)(ws + WS_WOUT), MTOK, D, D}; pg8::StaticOrder S; S.init(MTOK, D, G, (int)blockIdx.x, 4);
                pg8::EpiResidH<true, false, false> E{XH, XF, (const float*)(ws + WS_STATS), ((const float*)ka->in[I_LNG]) + (L * 4 + 0) * D, ((const float*)ka->in[I_LNB]) + (L * 4 + 0) * D};
                pg8::gemm_phase<pg8::EpiResidH<true, false, false>, pg8::StaticOrder, true, true>(lds + RING_OFF, g, S, E, wave_s);
                SEAM();
            }
            REP(12) if (RUN(12)) { IDS(); const int li = (L * 4 + 1) * D; ln_phase_h<false>(XH, XB, X, ((const float*)ka->in[I_LNG]) + li, ((const float*)ka->in[I_LNB]) + li, (float*)(ws + WS_STATS), gw, NGW, lane); SEAM(); }
            REP(13) if (RUN(13)) {
                KA();
                static_assert((WS_XB & (MiB - 1)) == 0 && (WS_WQ & (MiB - 1)) == 0 && (WS_MEMB & (MiB - 1)) == 0 && (WS_WKV & (MiB - 1)) == 0 && WS_MEMB < WS_WKV && WS_WKV < WS_XB, "XqOrder indexes 1-MiB operand tiles of d_ws");
                pg8::Gemm g{(const bf16*)ws, (const bf16*)ws, 0, 0, D}; pg8::XqOrder S{G, (int)blockIdx.x};
                pg8::EpiXq E{(bf16*)(ws + WS_QX), (bf16*)(ws + WS_KX), (bf16*)(ws + WS_VXT)};
                pg8::gemm_phase<pg8::EpiXq, pg8::XqOrder, true, true>(lds + RING_OFF, g, S, E, wave_s);
                SEAM();
            }
            REP(14) if (RUN(14)) { IDS(); xattn_phase(ka, lds, wave, lane); SEAM(); }
            REP(15) if (RUN(15)) {
                KA();
                pg8::Gemm g{(const bf16*)(ws + WS_OX), (const bf16*)(ws + WS_WO), MTOK, D, 512}; pg8::StaticOrder S; S.init(MTOK, D, G, (int)blockIdx.x, 4);
                pg8::EpiResidH<true, false, false> E{XH, XF, (const float*)(ws + WS_STATS), ((const float*)ka->in[I_LNG]) + (L * 4 + 1) * D, ((const float*)ka->in[I_LNB]) + (L * 4 + 1) * D};
                pg8::gemm_phase<pg8::EpiResidH<true, false, false>, pg8::StaticOrder, true, true>(lds + RING_OFF, g, S, E, wave_s);
                SEAM();
            }
            REP(16) if (RUN(16)) { IDS(); const int li = (L * 4 + 2) * D; ln_phase_h<false>(XH, XB, X, ((const float*)ka->in[I_LNG]) + li, ((const float*)ka->in[I_LNB]) + li, (float*)(ws + WS_STATS), gw, NGW, lane); SEAM(); }
        }
}

__global__ void __launch_bounds__(NWAVES * 64, 2) fwd_kernel(Args a) {
    extern __shared__ __attribute__((aligned(16))) unsigned char lds_raw[];
    LAS unsigned char* lds = (LAS unsigned char*)lds_raw;
    volatile LAS unsigned* MISC = (volatile LAS unsigned*)(lds + MISC_OFF);
    const int G = gridDim.x, NGW = G * NWAVES, NT = G * NWAVES * 64, wave_s = __builtin_amdgcn_readfirstlane((int)threadIdx.x >> 6);
    { const int t0 = wave_s * 64 + hw_lane(); for (int u = t0; u < (LDS_BYTES - LDSCTL_OFF) / 4; u += NWAVES * 64) ((LAS unsigned*)(lds + LDSCTL_OFF))[u] = 0u; }
    __syncthreads();
    unsigned* const barw = (unsigned*)((unsigned long long)a.ws + WS_CTL + 4096 * 4);
    XcdBarrier bar; bar.bar = barw; bar.x = 0; bar.st = nullptr; bar.wv = (unsigned)wave_s;
    if (a.single) bar = xcd_barrier_post(barw, MISC + 8, (unsigned)wave_s);
    if (0 >= a.it_lo && 0 < a.it_hi) half_layer<0>(a, lds, bar, G, NGW, NT, wave_s);
    if (1 >= a.it_lo && 1 < a.it_hi) half_layer<1>(a, lds, bar, G, NGW, NT, wave_s);
    if (2 >= a.it_lo && 2 < a.it_hi) half_layer<2>(a, lds, bar, G, NGW, NT, wave_s);
    if (3 >= a.it_lo && 3 < a.it_hi) half_layer<3>(a, lds, bar, G, NGW, NT, wave_s);
    if (4 >= a.it_lo && 4 < a.it_hi) half_layer<4>(a, lds, bar, G, NGW, NT, wave_s);
    if (5 >= a.it_lo && 5 < a.it_hi) half_layer<5>(a, lds, bar, G, NGW, NT, wave_s);
    if (6 >= a.it_lo && 6 < a.it_hi) half_layer<6>(a, lds, bar, G, NGW, NT, wave_s);
    if (7 >= a.it_lo && 7 < a.it_hi) half_layer<7>(a, lds, bar, G, NGW, NT, wave_s);
}
#undef SEAM
#undef RUN

#ifndef MK_SINGLE
#define MK_SINGLE 1
#endif
extern "C" void kernel_launch(void* const* d_in, const int* in_sizes, int n_in, void* d_out, int out_size, void* d_ws, size_t ws_size, hipStream_t stream) {
    static int grid = 0;
    if (grid == 0) {
        if (n_in != 28 || out_size != MTOK * D || ws_size < WS_END) { fprintf(stderr, "kernel_launch: unexpected problem (n_in %d, out %d, ws %zu < %zu); nothing launched\n", n_in, out_size, ws_size, (size_t)WS_END); grid = -1; return; }
        int dev = 0, cus = 0, per_cu = 0;
        if (hipGetDevice(&dev) != hipSuccess || hipDeviceGetAttribute(&cus, hipDeviceAttributeMultiprocessorCount, dev) != hipSuccess) { grid = -1; return; }
        if (hipFuncSetAttribute((const void*)fwd_kernel, hipFuncAttributeMaxDynamicSharedMemorySize, LDS_BYTES) != hipSuccess) { fprintf(stderr, "kernel_launch: hipFuncSetAttribute failed\n"); grid = -1; return; }
        if (hipOccupancyMaxActiveBlocksPerMultiprocessor(&per_cu, (const void*)fwd_kernel, NWAVES * 64, LDS_BYTES) != hipSuccess || per_cu < 1) { fprintf(stderr, "kernel_launch: occupancy query says %d blocks per CU; nothing launched\n", per_cu); (void)hipGetLastError(); grid = -1; return; }
        grid = cus;
    }
    if (grid < 0) return;
    (void)hipMemsetAsync((char*)d_ws + WS_CTL, 0, CTL_ZERO_BYTES, stream);
    Args a{};
    for (int i = 0; i < 28; ++i) a.in[i] = (const GAS float*)d_in[i];
    a.out = (GAS float*)d_out; a.ws = (GAS unsigned char*)d_ws; a.pad = 0;
#if MK_SINGLE
    a.it_lo = 0; a.it_hi = 2 * DEPTH; a.ph_lo = 0; a.ph_hi = 17; a.single = 1;
    hipLaunchKernelGGL(fwd_kernel, dim3(grid), dim3(NWAVES * 64), LDS_BYTES, stream, a);
#else
    a.single = 0;
    for (int it = 0; it < 2 * DEPTH; ++it)
        for (int ph = 0; ph < 17; ++ph) {
            if ((it & 1) && (ph == 0 || ph > 3)) continue;
            a.it_lo = it; a.it_hi = it + 1; a.ph_lo = ph; a.ph_hi = ph + 1;
            hipLaunchKernelGGL(fwd_kernel, dim3(grid), dim3(NWAVES * 64), LDS_BYTES, stream, a);
        }
#endif
}
```

```cpp
#include <hip/hip_runtime.h>
#include <cstdio>
#include <cstdint>
#include <cmath>
constexpr int D = 2048, DFF = 5632, DEPTH = 4;
constexpr int SEQP = 16384, SEQS = 4096, NSAMP = 8, NSEQ = 9;
constexpr int MTOK = SEQP + NSAMP * SEQS;
constexpr int MEML = 256, MMEM = NSEQ * MEML;
constexpr int INC = 10112, NWIN = 10240;
constexpr int RWC = 1920;
constexpr float ALPHA = 1.681792830507429f;
constexpr float LN_EPS = 1e-5f, GN_EPS = 64e-5f;
constexpr int CH = 128;
constexpr int NCP = MTOK / CH;
constexpr float LOG2E = 1.4426950408889634f;
constexpr float ATT_C1 = 0.08838834764831845f * 1.4426950408889634f;

constexpr size_t MiB = 1u << 20;
constexpr size_t WS_CTL = 0, CTL_ZERO_BYTES = 1 * MiB;
constexpr size_t WS_CS = 1 * MiB;
constexpr size_t WS_MEMB = 9 * MiB;
constexpr size_t WS_W1T = 18 * MiB;
constexpr size_t WS_W2T = 106 * MiB;
constexpr size_t WS_WINT = 150 * MiB;
constexpr size_t WS_WBR0 = 190 * MiB;
constexpr size_t WS_WBR1 = 192 * MiB;
constexpr size_t WS_WBR2 = 196 * MiB;
constexpr size_t WS_WOUT = 198 * MiB;
constexpr size_t WS_WQ = 206 * MiB;
constexpr size_t WS_WKV = 208 * MiB;
constexpr size_t WS_WO = 212 * MiB;
constexpr size_t WS_BL = 214 * MiB;
constexpr size_t WS_XB = 216 * MiB;
constexpr size_t WS_RA = 408 * MiB;
constexpr size_t WS_Q = WS_RA;
constexpr size_t WS_K = WS_RA + 96 * MiB;
constexpr size_t WS_VT = WS_RA + 120 * MiB;
constexpr size_t WS_UPOOL = WS_RA + 144 * MiB;
constexpr size_t WS_URWKV = WS_RA + 192 * MiB;
constexpr size_t WS_GATES = WS_RA + 576 * MiB;
constexpr size_t WS_PM = WS_XB;
constexpr size_t WS_QM = WS_XB + 96 * MiB;
constexpr size_t WS_Y = WS_RA + 192 * MiB;
constexpr size_t WS_Z = WS_RA + 384 * MiB;
constexpr size_t WS_H = WS_RA;
constexpr size_t WS_QX = WS_RA;
constexpr size_t WS_KX = WS_RA + 48 * MiB;
constexpr size_t WS_VXT = WS_RA + 51 * MiB;
constexpr size_t WS_OX = WS_RA + 54 * MiB;
constexpr size_t WS_OPOOL = 1560 * MiB;
constexpr size_t WS_OATT = 1608 * MiB;
constexpr size_t WS_ORWKV = 1704 * MiB;
constexpr size_t WS_SH = 1752 * MiB;
constexpr size_t WS_MERGED = WS_SH;
constexpr size_t WS_DIR = 2040 * MiB;
constexpr size_t WS_KBUF = 2616 * MiB;
constexpr size_t WS_SST = WS_KBUF;
constexpr size_t WS_G = 2712 * MiB;
constexpr size_t WS_AL = 2760 * MiB;
constexpr size_t WS_STATS = 2796 * MiB;
constexpr size_t WS_END = 2797 * MiB;
static_assert(WS_GATES + 576 * MiB == WS_OPOOL, "region A");

typedef unsigned short bf16;
namespace pg8 {
#define PG8_LAS __attribute__((address_space(3)))
typedef unsigned short bf16_t;
typedef short bf16x8 __attribute__((ext_vector_type(8)));
typedef float f32x4 __attribute__((ext_vector_type(4)));
typedef unsigned u32x4 __attribute__((ext_vector_type(4)));
constexpr int BM = 256, BK = 64, HALF = 128, HTB = HALF * BK * 2  , STAGE_BYTES = 8 * HTB, NXCD = 8, WGM = 8;

__host__ __device__ __forceinline__ int lds_byte(int r, int c) { const int st = (r >> 4) * 2 + (c >> 5), rr = r & 15, cc = c & 31, ob = rr * 64 + cc * 2; return st * 1024 + (ob ^ (((ob >> 9) & 1) << 5)); }
__host__ __device__ __forceinline__ void stage_rc(int b, int& R, int& C) { const int st = b / 1024, sb = b % 1024, swz = sb ^ (((sb >> 9) & 1) << 5); R = (st >> 1) * 16 + swz / 64; C = (st & 1) * 32 + (swz % 64) / 2; }
__host__ __device__ __forceinline__ int perm32(int rho) { const int n = rho >> 4, i = rho & 15; return 8 * (i >> 2) + 4 * n + (i & 3); }

struct Unit { int pm, pn; };
struct Gemm { const bf16_t* A; const bf16_t* Bt; int M, N, K; };

struct StaticOrder {
    int nM, nN, nwg, G, c, wgm;
    __host__ __device__ void init(int M, int N, int G_, int c_, int wgm_ = WGM) { nM = M / BM; nN = N / BM; nwg = nM * nN; G = G_; c = c_; wgm = wgm_; }
    __host__ __device__ bool next(int i, Unit& u) const {
        const long L = (long)i * G + c; if (L >= nwg) return false;
        int wgid = (int)L; { const int q = nwg / NXCD, r = nwg % NXCD, xcd = wgid % NXCD, off = wgid / NXCD; wgid = (xcd < r ? xcd * (q + 1) : r * (q + 1) + (xcd - r) * q) + off; }
        const int nig = wgm * nN, gid = wgid / nig, fm = gid * wgm, gsz = (nM - fm) < wgm ? (nM - fm) : wgm;
        u.pm = fm + ((wgid % nig) % gsz); u.pn = (wgid % nig) / gsz; return true;
    }
    __device__ __forceinline__ void a_ready(const Unit&) const {}
    __device__ __forceinline__ void done(const Unit&) const {}
};

__device__ __forceinline__ unsigned cvt_pk_bf16(float lo, float hi) { unsigned r; asm volatile("v_cvt_pk_bf16_f32 %0, %1, %2" : "=v"(r) : "v"(lo), "v"(hi)); return r; }
typedef float f32x2 __attribute__((ext_vector_type(2)));
typedef unsigned u32x2 __attribute__((ext_vector_type(2)));
__device__ __forceinline__ int lane_now() { int l; asm volatile("v_mbcnt_lo_u32_b32 %0, -1, 0\n\tv_mbcnt_hi_u32_b32 %0, -1, %0" : "=v"(l)); return l; }
__device__ __forceinline__ float sigm(float x) { return __builtin_amdgcn_rcpf(1.f + __builtin_amdgcn_exp2f(-x * LOG2E)); }
__device__ __forceinline__ float bf_lo(unsigned w) { return __uint_as_float(w << 16); }
__device__ __forceinline__ float bf_hi(unsigned w) { return __uint_as_float(w & 0xffff0000u); }

struct EpiSwiglu {
    static constexpr bool PERM = true, AFTER_DRAIN = false;
    bf16_t* H;
    __device__ __forceinline__ void operator()(const f32x4 (&acc)[2][2][4][2], const Unit& u, int wr, int wc, int, int) const {
        const int ln_ = lane_now(), fr = ln_ & 15, fq = ln_ >> 4;
        const int row0 = u.pm * BM + wr * 64 + fr, col0 = u.pn * 128 + wc * 32 + 8 * fq;
#pragma unroll
        for (int ai = 0; ai < 2; ++ai)
#pragma unroll
            for (int m = 0; m < 4; ++m) {
                bf16_t* rowp = H + (size_t)(row0 + ai * HALF + m * 16) * DFF + col0;
                float o[8];
#pragma unroll
                for (int n = 0; n < 2; ++n)
#pragma unroll
                    for (int e = 0; e < 4; ++e) { const float g = acc[ai][0][m][n][e], up = acc[ai][1][m][n][e]; o[4 * n + e] = g * sigm(g) * up; }
                u32x4 w; w.x = cvt_pk_bf16(o[0], o[1]); w.y = cvt_pk_bf16(o[2], o[3]); w.z = cvt_pk_bf16(o[4], o[5]); w.w = cvt_pk_bf16(o[6], o[7]);
                __builtin_nontemporal_store(w, (u32x4*)rowp);
            }
    }
};
template <bool NORM, bool HALFSC> struct EpiResid {
    static constexpr bool PERM = false, AFTER_DRAIN = false;
    float* X; const float* stats; const float* g; const float* b;
    __device__ __forceinline__ void operator()(const f32x4 (&acc)[2][2][4][2], const Unit& u, int wr, int wc, int, int) const {
        const int ln_ = lane_now(), fr = ln_ & 15, fq = ln_ >> 4;
        const int row0 = u.pm * BM + wr * 64 + fr, col0 = u.pn * BM + wc * 32 + 4 * fq;
        float* const Xp = X; const float al = ALPHA, sc = HALFSC ? 0.5f : 1.f; const float* const stp = stats; const float* const gp = g + col0; const float* const bp = b + col0;
        f32x4 gg[2][2], bb[2][2]; f32x2 st_[2][4];
        if (NORM) {
#pragma unroll
            for (int bj = 0; bj < 2; ++bj)
#pragma unroll
                for (int n = 0; n < 2; ++n) { gg[bj][n] = *(const f32x4*)(gp + bj * HALF + n * 16); bb[bj][n] = *(const f32x4*)(bp + bj * HALF + n * 16); }
#pragma unroll
            for (int ai = 0; ai < 2; ++ai)
#pragma unroll
                for (int m = 0; m < 4; ++m) st_[ai][m] = *(const f32x2*)(stp + 2 * (size_t)(row0 + ai * HALF + m * 16));
        }
#pragma unroll
        for (int ai = 0; ai < 2; ++ai)
#pragma unroll
            for (int m = 0; m < 4; ++m) {
                const int row = row0 + ai * HALF + m * 16;
                float* rowp = Xp + (size_t)row * D + col0;
#pragma unroll
                for (int bj = 0; bj < 2; ++bj)
#pragma unroll
                    for (int n = 0; n < 2; ++n) { f32x4* p = (f32x4*)(rowp + bj * HALF + n * 16); f32x4 x;
                        if (NORM) { x = *p; x = (x - st_[ai][m].x) * st_[ai][m].y * gg[bj][n] + bb[bj][n]; }
                        else x = *(const f32x4*)((row < SEQP ? gp + (size_t)row * D : bp + (size_t)(row - SEQP) * D) + bj * HALF + n * 16);
                        *p = x * al + acc[ai][bj][m][n] * sc; }
                if (m & 1) asm volatile("" ::: "memory");
            }
    }
};
typedef _Float16 f16x2_t __attribute__((ext_vector_type(2)));
__device__ __forceinline__ f32x2 h2f(unsigned w) { const f16x2_t h = __builtin_bit_cast(f16x2_t, w); return (f32x2){(float)h[0], (float)h[1]}; }
__device__ __forceinline__ unsigned f2h(float a, float b) { f16x2_t h; h[0] = (_Float16)__builtin_amdgcn_fmed3f(a, -65504.f, 65504.f); h[1] = (_Float16)__builtin_amdgcn_fmed3f(b, -65504.f, 65504.f);
    return __builtin_bit_cast(unsigned, h); }
template <bool NORM, bool HALFSC, bool LAST> struct EpiResidH {
    static constexpr bool PERM = true, AFTER_DRAIN = false;
    unsigned short* XH; unsigned short* XF; const float* stats; const float* g; const float* b;
    __device__ __forceinline__ void operator()(const f32x4 (&acc)[2][2][4][2], const Unit& u, int wr, int wc, int, int) const {
        const int ln_ = lane_now(), fr = ln_ & 15, fq = ln_ >> 4;
        const int row0 = u.pm * BM + wr * 64 + fr, col0 = u.pn * BM + wc * 32 + 8 * fq;
        unsigned short* const Xp = XH; unsigned short* const Fp = XF; const float al = ALPHA, sc = HALFSC ? 0.5f : 1.f; const float* const stp = stats; const float* const gp = g + col0; const float* const bp = b + col0;
        f32x4 gg[2][2], bb[2][2]; f32x2 st_[2][4];
        if (NORM) {
#pragma unroll
            for (int bj = 0; bj < 2; ++bj)
#pragma unroll
                for (int n = 0; n < 2; ++n) { gg[bj][n] = *(const f32x4*)(gp + bj * HALF + n * 4); bb[bj][n] = *(const f32x4*)(bp + bj * HALF + n * 4); }
#pragma unroll
            for (int ai = 0; ai < 2; ++ai)
#pragma unroll
                for (int m = 0; m < 4; ++m) st_[ai][m] = *(const f32x2*)(stp + 2 * (size_t)(row0 + ai * HALF + m * 16));
        }
#pragma unroll
        for (int ai = 0; ai < 2; ++ai) {
            u32x4 hv[4][2];
            if (NORM) {
#pragma unroll
                for (int m = 0; m < 4; ++m)
#pragma unroll
                    for (int bj = 0; bj < 2; ++bj) hv[m][bj] = *(const u32x4*)(Xp + (size_t)(row0 + ai * HALF + m * 16) * D + col0 + bj * HALF);
                asm volatile("" ::: "memory");
            }
#pragma unroll
            for (int m = 0; m < 4; ++m) {
                const int row = row0 + ai * HALF + m * 16;
                unsigned short* rowp = Xp + (size_t)row * D + col0;
                f32x4 xi[2][2];
                if (!NORM) {
#pragma unroll
                    for (int bj = 0; bj < 2; ++bj) { const float* src = (row < SEQP ? gp + (size_t)row * D : bp + (size_t)(row - SEQP) * D) + bj * HALF; xi[bj][0] = *(const f32x4*)src; xi[bj][1] = *(const f32x4*)(src + 4); }
                    if (m & 1) asm volatile("" ::: "memory"); }
#pragma unroll
                for (int bj = 0; bj < 2; ++bj) { f32x4 x0, x1;
                    if (NORM) { const u32x4 h4 = hv[m][bj]; const f32x2 a0 = h2f(h4.x), a1 = h2f(h4.y), a2 = h2f(h4.z), a3 = h2f(h4.w);
                        x0 = ((f32x4){a0.x, a0.y, a1.x, a1.y} - st_[ai][m].x) * st_[ai][m].y * gg[bj][0] + bb[bj][0];
                        x1 = ((f32x4){a2.x, a2.y, a3.x, a3.y} - st_[ai][m].x) * st_[ai][m].y * gg[bj][1] + bb[bj][1]; }
                    else { x0 = xi[bj][0]; x1 = xi[bj][1]; }
                    const f32x4 o0 = x0 * al + acc[ai][bj][m][0] * sc, o1 = x1 * al + acc[ai][bj][m][1] * sc;
                    u32x4 w; w.x = f2h(o0[0], o0[1]); w.y = f2h(o0[2], o0[3]); w.z = f2h(o1[0], o1[1]); w.w = f2h(o1[2], o1[3]);
                    *(u32x4*)((LAST ? Fp + (size_t)row * D + col0 : rowp) + bj * HALF) = w; }
            }
            asm volatile("" ::: "memory");
        }
    }
};
struct EpiPlain {
    static constexpr bool PERM = true, AFTER_DRAIN = false;
    bf16_t* O; int ldc;
    __device__ __forceinline__ void operator()(const f32x4 (&acc)[2][2][4][2], const Unit& u, int wr, int wc, int, int) const {
        const int ln_ = lane_now(), fr = ln_ & 15, fq = ln_ >> 4;
        const int row0 = u.pm * BM + wr * 64 + fr, col0 = u.pn * BM + wc * 32 + 8 * fq;
#pragma unroll
        for (int ai = 0; ai < 2; ++ai)
#pragma unroll
            for (int m = 0; m < 4; ++m) {
                bf16_t* rowp = O + (size_t)(row0 + ai * HALF + m * 16) * ldc + col0;
#pragma unroll
                for (int bj = 0; bj < 2; ++bj) { const f32x4 v0 = acc[ai][bj][m][0], v1 = acc[ai][bj][m][1];
                    u32x4 w; w.x = cvt_pk_bf16(v0[0], v0[1]); w.y = cvt_pk_bf16(v0[2], v0[3]); w.z = cvt_pk_bf16(v1[0], v1[1]); w.w = cvt_pk_bf16(v1[2], v1[3]);
                    *(u32x4*)(rowp + bj * HALF) = w; }
            }
    }
};
struct EpiWin {
    static constexpr bool PERM = true, AFTER_DRAIN = false;
    bf16_t *UP, *Q, *K, *GT; float* UR; const float* CS; bf16_t* VT;
    __device__ __forceinline__ void operator()(const f32x4 (&acc)[2][2][4][2], const Unit& u, int wr, int wc, int, int) const {
        const int ln_ = lane_now(), fr = ln_ & 15, fq = ln_ >> 4;
        const int pn = u.pn, row0 = u.pm * BM + wr * 64 + fr, c8 = wc * 32 + 8 * fq;
        if (pn == 7) {
#pragma unroll
            for (int ai = 0; ai < 2; ++ai)
#pragma unroll
                for (int m = 0; m < 4; ++m) { const int row = row0 + ai * HALF + m * 16;
#pragma unroll
                    for (int bj = 0; bj < 2; ++bj)
#pragma unroll
                        for (int n = 0; n < 2; ++n) { const f32x4 v = acc[ai][bj][m][n]; const unsigned w01 = cvt_pk_bf16(v[0], v[1]), w23 = cvt_pk_bf16(v[2], v[3]);
                            bf16_t* dst = VT + (size_t)(bj * 128 + c8 + 4 * n) * MTOK + row;
                            dst[0] = (bf16_t)(w01 & 0xffffu); dst[MTOK] = (bf16_t)(w01 >> 16); dst[2 * (size_t)MTOK] = (bf16_t)(w23 & 0xffffu); dst[3 * (size_t)MTOK] = (bf16_t)(w23 >> 16); } }
            return;
        }
#pragma unroll
        for (int ai = 0; ai < 2; ++ai)
#pragma unroll
            for (int m = 0; m < 4; ++m) {
                const int row = row0 + ai * HALF + m * 16;
                if (pn >= 2 && pn < 7) {
                    const int pos = row < SEQP ? row : (row & (SEQS - 1));
                    const f32x4* csp = (const f32x4*)(CS + ((size_t)pos * 64 + 4 * (4 * wc + fq)) * 2);
                    const f32x4 c01 = csp[0], c23 = csp[1];
                    const float cs_[4] = {c01[0], c01[2], c23[0], c23[2]}, sn_[4] = {c01[1], c01[3], c23[1], c23[3]};
#pragma unroll
                    for (int bj = 0; bj < 2; ++bj) {
                        const f32x4 t1 = acc[ai][bj][m][0], t2 = acc[ai][bj][m][1]; float o1[4], o2[4];
#pragma unroll
                        for (int e = 0; e < 4; ++e) { o1[e] = t1[e] * cs_[e] - t2[e] * sn_[e]; o2[e] = t2[e] * cs_[e] + t1[e] * sn_[e]; }
                        u32x4 w; w.x = cvt_pk_bf16(o1[0], o1[1]); w.y = cvt_pk_bf16(o1[2], o1[3]); w.z = cvt_pk_bf16(o2[0], o2[1]); w.w = cvt_pk_bf16(o2[2], o2[3]);
                        bf16_t* dst = (pn == 6) ? K + (size_t)row * 256 + bj * 128 + c8 : Q + (size_t)row * 1024 + ((pn - 2) * 2 + bj) * 128 + c8;
                        __builtin_nontemporal_store(w, (u32x4*)dst);
                    }
                } else if (pn >= 8 && pn < 16) {
#pragma unroll
                    for (int bj = 0; bj < 2; ++bj) { float* p = UR + (size_t)row * 2048 + (pn - 8) * 256 + bj * 128 + c8; __builtin_nontemporal_store(acc[ai][bj][m][0], (f32x4*)p); __builtin_nontemporal_store(acc[ai][bj][m][1], (f32x4*)(p + 4)); }
                } else {
#pragma unroll
                    for (int bj = 0; bj < 2; ++bj) {
                        f32x4 v0 = acc[ai][bj][m][0], v1 = acc[ai][bj][m][1]; bf16_t* dst;
                        if (pn < 2) dst = UP + (size_t)row * 512 + pn * 256 + bj * 128 + c8;
                        else { dst = GT + (size_t)row * 6144 + (pn - 16) * 256 + bj * 128 + c8;
#pragma unroll
                            for (int e = 0; e < 4; ++e) { v0[e] = sigm(v0[e]); v1[e] = sigm(v1[e]); } }
                        u32x4 w; w.x = cvt_pk_bf16(v0[0], v0[1]); w.y = cvt_pk_bf16(v0[2], v0[3]); w.z = cvt_pk_bf16(v1[0], v1[1]); w.w = cvt_pk_bf16(v1[2], v1[3]);
                        __builtin_nontemporal_store(w, (u32x4*)dst);
                    }
                }
                asm volatile("" ::: "memory");
            }
    }
};
struct EpiBranch {
    static constexpr bool PERM = true, AFTER_DRAIN = false;
    bf16_t* MG; const bf16_t* GT; int first;
    __device__ __forceinline__ void operator()(const f32x4 (&acc)[2][2][4][2], const Unit& u, int wr, int wc, int, int) const {
        const int ln_ = lane_now(), fr = ln_ & 15, fq = ln_ >> 4;
        const int row0 = u.pm * BM + wr * 64 + fr, col0 = u.pn * BM + wc * 32 + 8 * fq;
#pragma unroll
        for (int ai = 0; ai < 2; ++ai) {
            u32x4 gwv[4][2], mwv[4][2];
#pragma unroll
            for (int m = 0; m < 4; ++m)
#pragma unroll
                for (int bj = 0; bj < 2; ++bj) { const int row = row0 + ai * HALF + m * 16, col = col0 + bj * HALF;
                    gwv[m][bj] = __builtin_nontemporal_load((const u32x4*)(GT + (size_t)row * 6144 + col));
                    mwv[m][bj] = first ? (u32x4){0u, 0u, 0u, 0u} : *(const u32x4*)(MG + (size_t)row * D + col); }
            asm volatile("" ::: "memory");
#pragma unroll
            for (int m = 0; m < 4; ++m)
#pragma unroll
                for (int bj = 0; bj < 2; ++bj) { const int row = row0 + ai * HALF + m * 16, col = col0 + bj * HALF;
                    const u32x4 gw = gwv[m][bj], mw = mwv[m][bj]; const f32x4 v0 = acc[ai][bj][m][0], v1 = acc[ai][bj][m][1];
                    u32x4 w;
                    w.x = cvt_pk_bf16(bf_lo(mw.x) + bf_lo(gw.x) * v0[0], bf_hi(mw.x) + bf_hi(gw.x) * v0[1]);
                    w.y = cvt_pk_bf16(bf_lo(mw.y) + bf_lo(gw.y) * v0[2], bf_hi(mw.y) + bf_hi(gw.y) * v0[3]);
                    w.z = cvt_pk_bf16(bf_lo(mw.z) + bf_lo(gw.z) * v1[0], bf_hi(mw.z) + bf_hi(gw.z) * v1[1]);
                    w.w = cvt_pk_bf16(bf_lo(mw.w) + bf_lo(gw.w) * v1[2], bf_hi(mw.w) + bf_hi(gw.w) * v1[3]);
                    *(u32x4*)(MG + (size_t)row * D + col) = w; }
            asm volatile("" ::: "memory");
        }
    }
};
struct EpiLora {
    static constexpr bool PERM = false, AFTER_DRAIN = false;
    const float *w0, *a0, *k_a; const float* SH; const float* KB; float* DIR; bf16_t* G;
    __device__ __forceinline__ void operator()(const f32x4 (&acc)[2][2][4][2], const Unit& u, int wr, int wc, int, int) const {
        const int ln_ = lane_now(), fr = ln_ & 15, fq = ln_ >> 4;
        const int pn = u.pn, row0 = u.pm * BM + wr * 64 + fr, cq = wc * 32 + 4 * fq;
        const int ed = (pn >> 1) & 1;
        if (pn < 4) {
            f32x4 bv[2][2];
#pragma unroll
            for (int bj = 0; bj < 2; ++bj)
#pragma unroll
                for (int n = 0; n < 2; ++n) bv[bj][n] = *(const f32x4*)(w0 + ed * 512 + ((pn * BM + bj * HALF + cq + 16 * n) & 511));
#pragma unroll
            for (int ai = 0; ai < 2; ++ai)
#pragma unroll
                for (int m = 0; m < 4; ++m) {
                    const int row = row0 + ai * HALF + m * 16;
#pragma unroll
                    for (int bj = 0; bj < 2; ++bj)
#pragma unroll
                        for (int n = 0; n < 2; ++n) {
                            const int ch = (pn * BM + bj * HALF + cq + 16 * n) & 511, hh = ch >> 6, j = ch & 63; const f32x4 v = acc[ai][bj][m][n], b = bv[bj][n]; f32x4 o;
#pragma unroll
                            for (int e = 0; e < 4; ++e) { const float x = -(b[e] + v[e]);
                                const float sp = fmaxf(x, 0.f) + 0.6931471805599453f * __builtin_amdgcn_logf(1.f + __builtin_amdgcn_exp2f(-fabsf(x) * LOG2E));
                                o[e] = __builtin_amdgcn_exp2f(-LOG2E * __builtin_amdgcn_exp2f((-sp - 0.5f) * LOG2E)); }
                            *(f32x4*)(DIR + (((size_t)row * 2 + ed) * 8 + hh) * 192 + j) = o;
                        }
                    asm volatile("" ::: "memory");
                }
        } else if (pn < 8) {
            f32x4 bv[2][2], kav[2][2];
#pragma unroll
            for (int bj = 0; bj < 2; ++bj)
#pragma unroll
                for (int n = 0; n < 2; ++n) { const int ch = (pn * BM + bj * HALF + cq + 16 * n) & 511; bv[bj][n] = *(const f32x4*)(a0 + ed * 512 + ch); kav[bj][n] = *(const f32x4*)(k_a + ch); }
#pragma unroll
            for (int ai = 0; ai < 2; ++ai)
#pragma unroll
                for (int m = 0; m < 4; ++m) {
                    const int row = row0 + ai * HALF + m * 16;
                    f32x4 nkv[2][2], kkv[2][2];
#pragma unroll
                    for (int bj = 0; bj < 2; ++bj)
#pragma unroll
                        for (int n = 0; n < 2; ++n) { const int ch = (pn * BM + bj * HALF + cq + 16 * n) & 511;
                            nkv[bj][n] = *(const f32x4*)(SH + ((size_t)row * 8 + (ch >> 6)) * 192 + (ch & 63)); kkv[bj][n] = *(const f32x4*)(KB + (size_t)row * 512 + ch); }
                    asm volatile("" ::: "memory");
#pragma unroll
                    for (int bj = 0; bj < 2; ++bj)
#pragma unroll
                        for (int n = 0; n < 2; ++n) {
                            const int ch = (pn * BM + bj * HALF + cq + 16 * n) & 511, hh = ch >> 6, j = ch & 63; const f32x4 v = acc[ai][bj][m][n], b = bv[bj][n], ka = kav[bj][n], nk = nkv[bj][n], kk_ = kkv[bj][n];
                            float* dp = DIR + (((size_t)row * 2 + ed) * 8 + hh) * 192 + j; f32x4 o1, o2;
#pragma unroll
                            for (int e = 0; e < 4; ++e) { const float a = sigm(b[e] + v[e]); o1[e] = -nk[e] * a; o2[e] = kk_[e] * (1.f + (a - 1.f) * ka[e]); }
                            *(f32x4*)(dp + 64) = o1; *(f32x4*)(dp + 128) = o2;
                        }
                    asm volatile("" ::: "memory");
                }
        } else {
#pragma unroll
            for (int ai = 0; ai < 2; ++ai)
#pragma unroll
                for (int m = 0; m < 4; ++m) {
                    const int row = row0 + ai * HALF + m * 16;
#pragma unroll
                    for (int bj = 0; bj < 2; ++bj)
#pragma unroll
                        for (int n = 0; n < 2; ++n) { const int c = pn * BM + bj * HALF + cq + 16 * n; const f32x4 v = acc[ai][bj][m][n];
                            u32x2 w; w.x = cvt_pk_bf16(v[0], v[1]); w.y = cvt_pk_bf16(v[2], v[3]);
                            *(u32x2*)(G + (size_t)row * 512 + (c - 2048)) = w; }
                    asm volatile("" ::: "memory");
                }
        }
    }
};

constexpr int XQ_UNITS = 420;
struct XqOrder {
    int G, c;
    __device__ __forceinline__ bool next(int i, Unit& u) const {
        const int L = i * G + c; if (L >= XQ_UNITS) return false;
        if (L < 384) { u.pm = (int)(WS_XB >> 20) + (L >> 1); u.pn = (int)(WS_WQ >> 20) + (L & 1); }
        else if (L < 402) { const int t = L - 384; u.pm = (int)(WS_MEMB >> 20) + (t >> 1); u.pn = (int)(WS_WKV >> 20) + (t & 1); }
        else { const int t = L - 402; u.pm = (int)(WS_WKV >> 20) + 2 + t / 9; u.pn = (int)(WS_MEMB >> 20) + t % 9; }
        return true;
    }
    __device__ __forceinline__ void a_ready(const Unit&) const {}
    __device__ __forceinline__ void done(const Unit&) const {}
};
struct EpiXq {
    static constexpr bool PERM = true, AFTER_DRAIN = false;
    bf16_t *QX, *KX, *VXT;
    __device__ __forceinline__ void operator()(const f32x4 (&acc)[2][2][4][2], const Unit& u, int wr, int wc, int, int) const {
        const int ln_ = lane_now(), fr = ln_ & 15, fq = ln_ >> 4;
        bf16_t* O; int ldc, tm, tn;
        if (u.pm >= (int)(WS_XB >> 20)) { O = QX; ldc = 512; tm = u.pm - (int)(WS_XB >> 20); tn = u.pn - (int)(WS_WQ >> 20); }
        else if (u.pm < (int)(WS_WKV >> 20)) { O = KX; ldc = 512; tm = u.pm - (int)(WS_MEMB >> 20); tn = u.pn - (int)(WS_WKV >> 20); }
        else { O = VXT; ldc = MMEM; tm = u.pm - (int)(WS_WKV >> 20) - 2; tn = u.pn - (int)(WS_MEMB >> 20); }
        const int row0 = tm * BM + wr * 64 + fr, col0 = tn * BM + wc * 32 + 8 * fq;
#pragma unroll
        for (int ai = 0; ai < 2; ++ai)
#pragma unroll
            for (int m = 0; m < 4; ++m) {
                bf16_t* rowp = O + (size_t)(row0 + ai * HALF + m * 16) * ldc + col0;
#pragma unroll
                for (int bj = 0; bj < 2; ++bj) { const f32x4 v0 = acc[ai][bj][m][0], v1 = acc[ai][bj][m][1];
                    u32x4 w; w.x = cvt_pk_bf16(v0[0], v0[1]); w.y = cvt_pk_bf16(v0[2], v0[3]); w.z = cvt_pk_bf16(v1[0], v1[1]); w.w = cvt_pk_bf16(v1[2], v1[3]);
                    *(u32x4*)(rowp + bj * HALF) = w; }
            }
    }
};
template <class Epi, class Sched, bool ALIGN_EPI = false, bool SP2 = false>
__device__ __forceinline__ void gemm_phase(PG8_LAS unsigned char* lds, const Gemm g, const Sched& S, const Epi E, int wid_in) {
    int lane_o; asm volatile("v_mbcnt_lo_u32_b32 %0, -1, 0\n\tv_mbcnt_hi_u32_b32 %0, -1, %0" : "=v"(lane_o));
    const int wid = wid_in, lane = lane_o, tid = wid * 64 + lane, wr = wid >> 2, wc = wid & 3, fr = lane & 15, fq = lane >> 4;
    const int K = g.K, nt = K / BK;
    unsigned voffA[2], voffB[2];
#pragma unroll
    for (int i = 0; i < 2; ++i) { int R, C; stage_rc(tid * 16 + i * 8192, R, C); const int Rb = Epi::PERM ? ((R & ~31) + perm32(R & 31)) : R;
        voffA[i] = (unsigned)(R * K + C) * 2u; voffB[i] = (unsigned)(Rb * K + C) * 2u; }
    const size_t kstep = (size_t)(BK * 2);
    const size_t hstep = (size_t)HALF * K * 2;
    const size_t tstep = 2 * hstep;
    const unsigned ldsw = (unsigned)wid * 1024u;
    const int aoff = lds_byte(wr * 64 + fr, fq * 8), boff = lds_byte(wc * 32 + fr, fq * 8);
#define PG8_SA(b, h) (((b) * 2 + (h)) * HTB)
#define PG8_SB(b, h) ((4 + (b) * 2 + (h)) * HTB)
#define PG8_STAGE(bufoff, gbase, voff) do { _Pragma("unroll") for (int _i = 0; _i < 2; ++_i) \
        __builtin_amdgcn_global_load_lds((const unsigned*)((const char*)(gbase) + (voff)[_i]), (PG8_LAS unsigned*)(lds + (bufoff) + ldsw + _i * 8192), 16, 0, 0); } while (0)
#define PG8_LDA(dst, b, h) do { _Pragma("unroll") for (int m = 0; m < 4; ++m) _Pragma("unroll") for (int k = 0; k < 2; ++k) dst[m][k] = *(const PG8_LAS bf16x8*)(lds + PG8_SA(b, h) + aoff + m * 2048 + k * 1024); } while (0)
#define PG8_LDB(dst, b, h) do { _Pragma("unroll") for (int n = 0; n < 2; ++n) _Pragma("unroll") for (int k = 0; k < 2; ++k) dst[n][k] = *(const PG8_LAS bf16x8*)(lds + PG8_SB(b, h) + boff + n * 2048 + k * 1024); } while (0)
#define PG8_MMA(ai, bj, At, Bt) do { __builtin_amdgcn_s_setprio(1); _Pragma("unroll") for (int m = 0; m < 4; ++m) _Pragma("unroll") for (int n = 0; n < 2; ++n) _Pragma("unroll") for (int k = 0; k < 2; ++k) \
        acc[ai][bj][m][n] = __builtin_amdgcn_mfma_f32_16x16x32_bf16(Bt[n][k], At[m][k], acc[ai][bj][m][n], 0, 0, 0); __builtin_amdgcn_s_setprio(0); } while (0)
#define PG8_WAIT_V(n) asm volatile("s_waitcnt vmcnt(" #n ")" ::: "memory")
#define PG8_WAIT_L(n) asm volatile("s_waitcnt lgkmcnt(" #n ")" ::: "memory")
#define PG8_BAR __builtin_amdgcn_s_barrier()
#define PG8_SCHED __builtin_amdgcn_sched_barrier(0)
    Unit cur, nxt; int ui = 0;
    if (!S.next(0, cur)) return;
    f32x4 acc[2][2][4][2];
#pragma unroll
    for (int a = 0; a < 2; ++a)
#pragma unroll
        for (int b = 0; b < 2; ++b)
#pragma unroll
            for (int m = 0; m < 4; ++m)
#pragma unroll
                for (int n = 0; n < 2; ++n) acc[a][b][m][n] = (f32x4){0.f, 0.f, 0.f, 0.f};
    bf16x8 At[4][2], B0[2][2], B1[2][2];
    const char* cA = (const char*)g.A + (size_t)cur.pm * tstep; const char* cB = (const char*)g.Bt + (size_t)cur.pn * tstep;
    S.a_ready(cur);
    if constexpr (SP2) {
        PG8_STAGE(PG8_SB(0, 0), cB, voffB); PG8_STAGE(PG8_SB(0, 1), cB + hstep, voffB); PG8_STAGE(PG8_SA(0, 0), cA, voffA); PG8_STAGE(PG8_SA(0, 1), cA + hstep, voffA);
        if (wr == 1) PG8_BAR;
        PG8_WAIT_V(2); PG8_BAR;
        PG8_STAGE(PG8_SB(1, 0), cB + kstep, voffB); PG8_STAGE(PG8_SA(1, 0), cA + kstep, voffA); PG8_STAGE(PG8_SB(1, 1), cB + hstep + kstep, voffB);
        PG8_WAIT_V(6); PG8_BAR;
    } else {
        PG8_STAGE(PG8_SB(0, 0), cB, voffB); PG8_STAGE(PG8_SA(0, 0), cA, voffA); PG8_STAGE(PG8_SB(0, 1), cB + hstep, voffB); PG8_STAGE(PG8_SA(0, 1), cA + hstep, voffA);
        if (wr == 1) PG8_BAR;
        PG8_WAIT_V(4); PG8_BAR;
        PG8_STAGE(PG8_SB(1, 0), cB + kstep, voffB); PG8_STAGE(PG8_SA(1, 0), cA + kstep, voffA); PG8_STAGE(PG8_SB(1, 1), cB + hstep + kstep, voffB);
        PG8_WAIT_V(6); PG8_BAR;
    }
    for (;;) {
        const bool has_next = S.next(ui + 1, nxt);
        const char* nA = has_next ? (const char*)g.A + (size_t)nxt.pm * tstep : cA; const char* nB = has_next ? (const char*)g.Bt + (size_t)nxt.pn * tstep : cB;
        for (int t = 0; t < nt; t += 2) {
            const bool last = (t == nt - 2);
            const char* a1 = cA + (size_t)(t + 1) * kstep;
            const char* a2 = last ? nA : cA + (size_t)(t + 2) * kstep; const char* b2 = last ? nB : cB + (size_t)(t + 2) * kstep;
            const char* a3 = a2 + kstep; const char* b3 = b2 + kstep;
            if (last && has_next) S.a_ready(nxt);
            if constexpr (SP2) {
            PG8_LDB(B0, 0, 0); PG8_LDB(B1, 0, 1); PG8_SCHED; PG8_LDA(At, 0, 0); PG8_STAGE(PG8_SA(1, 1), a1 + hstep, voffA);
            PG8_WAIT_V(8); PG8_WAIT_L(0); PG8_BAR; PG8_MMA(0, 0, At, B0); PG8_MMA(0, 1, At, B1); PG8_BAR; PG8_SCHED;
            PG8_LDA(At, 0, 1); PG8_STAGE(PG8_SB(0, 0), b2, voffB); PG8_STAGE(PG8_SB(0, 1), b2 + hstep, voffB); PG8_STAGE(PG8_SA(0, 0), a2, voffA);
            PG8_WAIT_V(8); PG8_WAIT_L(0); PG8_BAR; PG8_MMA(1, 0, At, B0); PG8_MMA(1, 1, At, B1); PG8_BAR; PG8_SCHED;
            PG8_LDB(B0, 1, 0); PG8_LDB(B1, 1, 1); PG8_SCHED; PG8_LDA(At, 1, 0); PG8_STAGE(PG8_SA(0, 1), a2 + hstep, voffA);
            PG8_WAIT_V(8); PG8_WAIT_L(0); PG8_BAR; PG8_MMA(0, 0, At, B0); PG8_MMA(0, 1, At, B1); PG8_BAR; PG8_SCHED;
            PG8_LDA(At, 1, 1); PG8_STAGE(PG8_SB(1, 0), b3, voffB); PG8_STAGE(PG8_SB(1, 1), b3 + hstep, voffB); PG8_STAGE(PG8_SA(1, 0), a3, voffA);
            PG8_WAIT_V(8); PG8_WAIT_L(0); PG8_BAR; PG8_MMA(1, 0, At, B0); PG8_MMA(1, 1, At, B1); PG8_BAR; PG8_SCHED;
            } else {
            PG8_LDB(B0, 0, 0); PG8_SCHED; PG8_LDA(At, 0, 0); PG8_STAGE(PG8_SA(1, 1), a1 + hstep, voffA);
            PG8_WAIT_L(8); PG8_BAR; PG8_WAIT_L(0); PG8_MMA(0, 0, At, B0); PG8_BAR; PG8_SCHED;
            PG8_LDB(B1, 0, 1); PG8_STAGE(PG8_SB(0, 0), b2, voffB);
            PG8_BAR; PG8_WAIT_L(0); PG8_MMA(0, 1, At, B1); PG8_BAR;
            PG8_LDA(At, 0, 1); PG8_STAGE(PG8_SA(0, 0), a2, voffA);
            PG8_BAR; PG8_WAIT_L(0); PG8_MMA(1, 0, At, B0); PG8_BAR; PG8_SCHED;
            PG8_STAGE(PG8_SB(0, 1), b2 + hstep, voffB);
            PG8_WAIT_V(6); PG8_BAR; PG8_MMA(1, 1, At, B1); PG8_BAR;
            PG8_LDB(B0, 1, 0); PG8_SCHED; PG8_LDA(At, 1, 0); PG8_STAGE(PG8_SA(0, 1), a2 + hstep, voffA);
            PG8_WAIT_L(8); PG8_BAR; PG8_WAIT_L(0); PG8_MMA(0, 0, At, B0); PG8_BAR; PG8_SCHED;
            PG8_LDB(B1, 1, 1); PG8_STAGE(PG8_SB(1, 0), b3, voffB);
            PG8_BAR; PG8_WAIT_L(0); PG8_MMA(0, 1, At, B1); PG8_BAR;
            PG8_LDA(At, 1, 1); PG8_STAGE(PG8_SA(1, 0), a3, voffA);
            PG8_BAR; PG8_WAIT_L(0); PG8_MMA(1, 0, At, B0); PG8_BAR; PG8_SCHED;
            PG8_STAGE(PG8_SB(1, 1), b3 + hstep, voffB);
            PG8_WAIT_V(6); PG8_BAR; PG8_MMA(1, 1, At, B1); PG8_BAR;
            }
        }
        if constexpr (ALIGN_EPI) { if (wr == 0) PG8_BAR; }
        if constexpr (!Epi::AFTER_DRAIN) { E(acc, cur, wr, wc, fr, fq); S.done(cur); }
        if (!has_next) break;
#pragma unroll
        for (int a = 0; a < 2; ++a)
#pragma unroll
            for (int b = 0; b < 2; ++b)
#pragma unroll
                for (int m = 0; m < 4; ++m)
#pragma unroll
                    for (int n = 0; n < 2; ++n) acc[a][b][m][n] = (f32x4){0.f, 0.f, 0.f, 0.f};
        cur = nxt; cA = nA; cB = nB; ++ui;
        if constexpr (ALIGN_EPI) { if (wr == 1) PG8_BAR; }
    }
    PG8_WAIT_V(0);
    if constexpr (!ALIGN_EPI) { if (wr == 0) PG8_BAR; }
    PG8_BAR;
    if constexpr (Epi::AFTER_DRAIN) { E.fused(acc, cur, wr, wc, fr, fq, lds, wid, lane); S.done(cur); }
#undef PG8_SA
#undef PG8_SB
#undef PG8_STAGE
#undef PG8_LDA
#undef PG8_LDB
#undef PG8_MMA
#undef PG8_WAIT_V
#undef PG8_WAIT_L
#undef PG8_BAR
#undef PG8_SCHED
}
}

constexpr int NWAVES = 8;
constexpr int RING_OFF = 0, RING_BYTES = 131072;
constexpr int LDSCTL_OFF = RING_BYTES, MISC_OFF = LDSCTL_OFF + 320;
constexpr int LDS_BYTES = 147456;

#define LAS __attribute__((address_space(3)))
typedef unsigned u32x2 __attribute__((ext_vector_type(2)));
typedef unsigned u32x4 __attribute__((ext_vector_type(4)));
typedef float f32x2 __attribute__((ext_vector_type(2)));
typedef float f32x4 __attribute__((ext_vector_type(4)));
typedef short bf16x8 __attribute__((ext_vector_type(8)));
#define LDS_WAIT() asm volatile("s_waitcnt lgkmcnt(0)" ::: "memory")
#define VM_WAIT() asm volatile("s_waitcnt vmcnt(0)" ::: "memory")
__device__ __forceinline__ unsigned pk2(float lo, float hi) { return pg8::cvt_pk_bf16(lo, hi); }
__device__ __forceinline__ float bflo(unsigned w) { return __uint_as_float(w << 16); }
__device__ __forceinline__ float bfhi(unsigned w) { return __uint_as_float(w & 0xffff0000u); }
__device__ __forceinline__ float wave_sum(float v) {
#pragma unroll
    for (int o = 1; o < 64; o <<= 1) v += __shfl_xor(v, o);
    return v;
}
__device__ __forceinline__ int hw_lane() { int l; asm volatile("v_mbcnt_lo_u32_b32 %0, -1, 0\n\tv_mbcnt_hi_u32_b32 %0, -1, %0" : "=v"(l)); return l; }
__device__ __forceinline__ int row_pos(int row) { return row < SEQP ? row : (row & (SEQS - 1)); }
__device__ __forceinline__ int row_slen(int row) { return row < SEQP ? SEQP : SEQS; }

__device__ const float INV_FREQ[64] = {
    1.000000000e+00f, 8.659643531e-01f, 7.498942018e-01f, 6.493816376e-01f,
    5.623413324e-01f, 4.869675338e-01f, 4.216965139e-01f, 3.651741147e-01f,
    3.162277639e-01f, 2.738419771e-01f, 2.371373773e-01f, 2.053525001e-01f,
    1.778279394e-01f, 1.539926529e-01f, 1.333521456e-01f, 1.154781953e-01f,
    1.000000015e-01f, 8.659642935e-02f, 7.498942316e-02f, 6.493816525e-02f,
    5.623413250e-02f, 4.869675264e-02f, 4.216964915e-02f, 3.651741147e-02f,
    3.162277490e-02f, 2.738419548e-02f, 2.371373773e-02f, 2.053525113e-02f,
    1.778279431e-02f, 1.539926510e-02f, 1.333521400e-02f, 1.154781971e-02f,
    9.999999776e-03f, 8.659643121e-03f, 7.498942316e-03f, 6.493816152e-03f,
    5.623413250e-03f, 4.869675264e-03f, 4.216964822e-03f, 3.651741194e-03f,
    3.162277630e-03f, 2.738419687e-03f, 2.371373819e-03f, 2.053525066e-03f,
    1.778279431e-03f, 1.539926510e-03f, 1.333521446e-03f, 1.154782018e-03f,
    1.000000047e-03f, 8.659643354e-04f, 7.498941850e-04f, 6.493816036e-04f,
    5.623413017e-04f, 4.869675322e-04f, 4.216965172e-04f, 3.651741135e-04f,
    3.162277571e-04f, 2.738419571e-04f, 2.371373703e-04f, 2.053525095e-04f,
    1.778279402e-04f, 1.539926598e-04f, 1.333521504e-04f, 1.154782003e-04f
};

#define XB_TMO      128
#define XB_XCNT(j)  (256  + 64 * (j))
#define XB_XSUB(j)  (1280 + 64 * (j))
#define XB_XGEN(j)  (2304 + 64 * (j))
#define XB_TOP      3328
#define XB_TOPGEN   3392
#define XCD_BAR_WORDS 3456
#define XB_SPIN_CAP (1u << 18)
__device__ __forceinline__ unsigned xb_ld(unsigned* p)              { return __hip_atomic_load(p, __ATOMIC_RELAXED, __HIP_MEMORY_SCOPE_AGENT); }
__device__ __forceinline__ unsigned xb_add(unsigned* p, unsigned v) { return __hip_atomic_fetch_add(p, v, __ATOMIC_RELAXED, __HIP_MEMORY_SCOPE_AGENT); }
__device__ __forceinline__ unsigned xb_xcc_id() { return (unsigned)__builtin_amdgcn_s_getreg((3 << 11) | 20) & 0xFu; }
#define XB_SPIN(cond, bar) do { unsigned _sp = 0; while (cond) { __builtin_amdgcn_s_sleep(1); \
    if ((++_sp & 255u) == 0u) { if (xb_ld(&(bar)[XB_TMO])) break; if (_sp > XB_SPIN_CAP) { atomicAdd(&(bar)[XB_TMO], 1u); break; } } } } while (0)
struct XcdBarrier { unsigned* bar; unsigned x; volatile LAS unsigned* st; unsigned wv; };
__device__ __forceinline__ bool xb_thread0(unsigned wv) { return wv == 0u && hw_lane() == 0; }
__device__ __forceinline__ XcdBarrier xcd_barrier_post(unsigned* bar, volatile LAS unsigned* st, unsigned wv) {
    XcdBarrier b; b.bar = bar; b.x = xb_xcc_id(); b.st = st; b.wv = wv;
    if (xb_thread0(wv)) (void)xb_add(&bar[XB_XCNT(b.x)], 1u);
    return b;
}
__device__ __forceinline__ void xcd_barrier_complete(unsigned* bar, unsigned x, unsigned& nloc, unsigned& nx) {
    const unsigned G = gridDim.x * gridDim.y * gridDim.z;
    unsigned sum, cnt, mine, sp = 0u;
    for (;;) {
        sum = 0u; cnt = 0u; mine = 0u;
#pragma unroll
        for (unsigned j = 0; j < 16; ++j) { const unsigned c = xb_ld(&bar[XB_XCNT(j)]); sum += c; cnt += (c > 0u) ? 1u : 0u; mine = (j == x) ? c : mine; }
        if (sum == G) break;
        __builtin_amdgcn_s_sleep(1);
        if ((++sp & 255u) == 0u) { if (xb_ld(&bar[XB_TMO])) break; if (sp > XB_SPIN_CAP) { atomicAdd(&bar[XB_TMO], 1u); break; } }
    }
    nloc = mine > 0u ? mine : 1u; nx = cnt > 0u ? cnt : 1u;
}
__device__ __forceinline__ void xcd_barrier(const XcdBarrier& b) {
    asm volatile("s_waitcnt vmcnt(0)" ::: "memory");
    __syncthreads();
    if (xb_thread0(b.wv)) {
        unsigned* bar = b.bar;
        __builtin_amdgcn_s_waitcnt(0);
        unsigned nloc = b.st[0], nx = b.st[1];
        if (nloc == 0u) { xcd_barrier_complete(bar, b.x, nloc, nx); b.st[0] = nloc; b.st[1] = nx; }
        const unsigned old = xb_add(&bar[XB_XSUB(b.x)], 1u);
        const unsigned gen = old / nloc;
        if (old + 1u == (gen + 1u) * nloc) {
            __builtin_amdgcn_fence(__ATOMIC_RELEASE, "agent");
            asm volatile("s_waitcnt vmcnt(0)" ::: "memory");
            const unsigned og = xb_add(&bar[XB_TOP], 1u);
            const unsigned tg = og / nx;
            if (og + 1u == (tg + 1u) * nx) xb_add(&bar[XB_TOPGEN], 1u);
            else XB_SPIN(xb_ld(&bar[XB_TOPGEN]) == tg, bar);
            __builtin_amdgcn_fence(__ATOMIC_ACQUIRE, "agent");
            xb_add(&bar[XB_XGEN(b.x)], 1u);
            asm volatile("s_waitcnt vmcnt(0)" ::: "memory");
        } else {
            XB_SPIN(xb_ld(&bar[XB_XGEN(b.x)]) == gen, bar);
            __builtin_amdgcn_fence(__ATOMIC_ACQUIRE, "agent");
            asm volatile("s_waitcnt vmcnt(0)" ::: "memory");
        }
    }
    __syncthreads();
}

#define GAS __attribute__((address_space(1)))
struct Args {
    const GAS float* in[28]; GAS float* out; GAS unsigned char* ws;
    int it_lo, it_hi, ph_lo, ph_hi;
    int single, pad;
};
typedef const __attribute__((address_space(4))) Args* KArgs;
enum { I_XP = 0, I_XS, I_MP, I_MS, I_LNG, I_LNB, I_FWI, I_FWO, I_WIN, I_POOLW, I_POOLS, I_SINK, I_MU, I_W0, I_W2, I_A0, I_A2, I_G2, I_KK, I_KA, I_RK, I_GNG, I_GNB, I_WBR, I_WOUT, I_XWQ, I_XWKV, I_XWO };

__device__ __forceinline__ int map_row(int kind, int n) {
    if (kind == 1) { const int up = n >= DFF ? 1 : 0; const int j = up ? n - DFF : n; return (j >> 7) * 256 + (up << 7) + (j & 127); }
    if (kind == 2) {
        if (n >= 512 && n < 1792) { const int d = n & 127; return (n & ~127) + 8 * ((d & 63) >> 2) + (d & 3) + 4 * (d >> 6); }
        return n >= 3968 ? n + 128 : n;
    }
    return n;
}
__device__ __forceinline__ void transpose_item(const float* W, int K, int N, bf16* WT, int kind, LAS float* scr, int item, int lane) {
    const int nblk = N / 32, kb = item / nblk, nb = item % nblk, k0 = 64 * kb, n0 = 32 * nb;
#pragma unroll
    for (int i = 0; i < 32; ++i) { const int kk = 2 * i + (lane >> 5); scr[kk * 33 + (lane & 31)] = __builtin_nontemporal_load(W + (size_t)(k0 + kk) * N + n0 + (lane & 31)); }
    LDS_WAIT(); asm volatile("" ::: "memory");
    const int c = lane & 7;
#pragma unroll
    for (int j = 0; j < 4; ++j) { const int n = (lane >> 3) + 8 * j; const LAS float* s = scr + (8 * c) * 33 + n;
        u32x4 o; o.x = pk2(s[0 * 33], s[1 * 33]); o.y = pk2(s[2 * 33], s[3 * 33]); o.z = pk2(s[4 * 33], s[5 * 33]); o.w = pk2(s[6 * 33], s[7 * 33]);
        *(u32x4*)(WT + (size_t)map_row(kind, n0 + n) * K + k0 + 8 * c) = o; }
    LDS_WAIT(); asm volatile("" ::: "memory");
}

__device__ __forceinline__ void conv_phase(KArgs a, int L, LAS unsigned char* lds, int gw, int NGW, int wave, int lane, int gtid, int NT) {
    unsigned char* ws = (unsigned char*)a->ws;
    LAS float* scr = (LAS float*)(lds + RING_OFF + wave * 16384);
    constexpr int N_W1 = 32 * 352, N_W2 = 88 * 64, N_WI = 32 * 316, N_B1 = 16 * 64, N_B2 = 8 * 64, N_OU = 32 * 64, N_Q = 32 * 16, N_KV = 32 * 32, N_O = 8 * 64;
    constexpr int NITEMS = 2 * N_W1 + 2 * N_W2 + N_WI + N_B1 + N_B2 + N_OU + N_Q + N_KV + N_O;
    const float* fwi = ((const float*)a->in[I_FWI]) + (size_t)L * 2 * D * 2 * DFF;
    const float* fwo = ((const float*)a->in[I_FWO]) + (size_t)L * 2 * DFF * D;
    const float* wbr = ((const float*)a->in[I_WBR]) + (size_t)L * D * D;
    for (int it = gw; it < NITEMS; it += NGW) {
        int r = it;
        if (r < N_W1) { transpose_item(fwi, D, 2 * DFF, (bf16*)(ws + WS_W1T), 1, scr, r, lane); continue; } r -= N_W1;
        if (r < N_W1) { transpose_item(fwi + (size_t)D * 2 * DFF, D, 2 * DFF, (bf16*)(ws + WS_W1T) + (size_t)2 * DFF * D, 1, scr, r, lane); continue; } r -= N_W1;
        if (r < N_W2) { transpose_item(fwo, DFF, D, (bf16*)(ws + WS_W2T), 0, scr, r, lane); continue; } r -= N_W2;
        if (r < N_W2) { transpose_item(fwo + (size_t)DFF * D, DFF, D, (bf16*)(ws + WS_W2T) + (size_t)D * DFF, 0, scr, r, lane); continue; } r -= N_W2;
        if (r < N_WI) { transpose_item(((const float*)a->in[I_WIN]) + (size_t)L * D * INC, D, INC, (bf16*)(ws + WS_WINT), 2, scr, r, lane); continue; } r -= N_WI;
        if (r < N_B1) { transpose_item(wbr + (size_t)512 * D, 1024, D, (bf16*)(ws + WS_WBR1), 0, scr, r, lane); continue; } r -= N_B1;
        if (r < N_B2) { transpose_item(wbr + (size_t)1536 * D, 512, D, (bf16*)(ws + WS_WBR2), 0, scr, r, lane); continue; } r -= N_B2;
        if (r < N_OU) { transpose_item(((const float*)a->in[I_WOUT]) + (size_t)L * D * D, D, D, (bf16*)(ws + WS_WOUT), 0, scr, r, lane); continue; } r -= N_OU;
        if (r < N_Q) { transpose_item(((const float*)a->in[I_XWQ]) + (size_t)L * D * 512, D, 512, (bf16*)(ws + WS_WQ), 0, scr, r, lane); continue; } r -= N_Q;
        if (r < N_KV) { transpose_item(((const float*)a->in[I_XWKV]) + (size_t)L * D * 1024, D, 1024, (bf16*)(ws + WS_WKV), 0, scr, r, lane); continue; } r -= N_KV;
        transpose_item(((const float*)a->in[I_XWO]) + (size_t)L * 512 * D, 512, D, (bf16*)(ws + WS_WO), 0, scr, r, lane);
    }
    {
        const float* pw = ((const float*)a->in[I_POOLW]) + (size_t)L * 4 * 128 * 128; const float* ps = ((const float*)a->in[I_POOLS]) + (size_t)L * 512;
        bf16* dst = (bf16*)(ws + WS_WBR0);
        for (int id = gtid; id < 2048 * 64; id += NT) {
            const int n = id & 2047, kg = id >> 11, g = kg >> 4, c0 = (8 * kg) & 127;
            float acc[8];
#pragma unroll
            for (int i = 0; i < 8; ++i) acc[i] = 0.f;
            const float* pwr = pw + ((size_t)g * 128 + c0) * 128;
            for (int e = 0; e < 128; ++e) {
                const float wb = wbr[(size_t)(g * 128 + e) * D + n] * ps[g * 128 + e];
#pragma unroll
                for (int i = 0; i < 8; ++i) acc[i] += pwr[i * 128 + e] * wb;
            }
            u32x4 o; o.x = pk2(acc[0], acc[1]); o.y = pk2(acc[2], acc[3]); o.z = pk2(acc[4], acc[5]); o.w = pk2(acc[6], acc[7]);
            *(u32x4*)(dst + (size_t)n * 512 + 8 * kg) = o;
        }
    }
    {
        const float* w2 = ((const float*)a->in[I_W2]) + (size_t)L * 2 * 64 * 512; const float* a2 = ((const float*)a->in[I_A2]) + (size_t)L * 2 * 64 * 512; const float* g2 = ((const float*)a->in[I_G2]) + (size_t)L * 128 * 512;
        bf16* dst = (bf16*)(ws + WS_BL);
        for (int id = gtid; id < 2560 * 48; id += NT) {
            const int n = id / 48, k0 = 8 * (id % 48);
            float v[8];
#pragma unroll
            for (int i = 0; i < 8; ++i) {
                const int k = k0 + i; float x = 0.f;
                if (n < 512) { if (k < 64) x = w2[(size_t)k * 512 + n]; }
                else if (n < 1024) { if (k >= 64 && k < 128) x = w2[(size_t)(64 + k - 64) * 512 + (n - 512)]; }
                else if (n < 1536) { if (k >= 128 && k < 192) x = a2[(size_t)(k - 128) * 512 + (n - 1024)]; }
                else if (n < 2048) { if (k >= 192 && k < 256) x = a2[(size_t)(64 + k - 192) * 512 + (n - 1536)]; }
                else { if (k >= 256) x = g2[(size_t)(k - 256) * 512 + (n - 2048)]; }
                v[i] = x;
            }
            u32x4 o; o.x = pk2(v[0], v[1]); o.y = pk2(v[2], v[3]); o.z = pk2(v[4], v[5]); o.w = pk2(v[6], v[7]);
            *(u32x4*)(dst + (size_t)n * 384 + k0) = o;
        }
    }
    { u32x4* p = (u32x4*)((bf16*)(ws + WS_WINT) + (size_t)3968 * D); for (int id = gtid; id < 128 * D / 8; id += NT) p[id] = (u32x4){0u, 0u, 0u, 0u}; }
}

__device__ __forceinline__ void prologue_phase(KArgs a, int gtid, int NT) {
    unsigned char* ws = (unsigned char*)a->ws;
    { f32x2* cs = (f32x2*)(ws + WS_CS);
      for (int id = gtid; id < SEQP * 64; id += NT) { const int t = id >> 6, j = id & 63; const float ang = (float)t * INV_FREQ[j]; float s, c; sincosf(ang, &s, &c); cs[id] = (f32x2){c, s}; } }
    { bf16* mb = (bf16*)(ws + WS_MEMB);
      for (int id = gtid; id < MMEM * D / 4; id += NT) { const int row = id / (D / 4), c4 = id % (D / 4);
          const float* src = row < MEML ? ((const float*)a->in[I_MP]) + (size_t)row * D : ((const float*)a->in[I_MS]) + (size_t)(row - MEML) * D;
          const f32x4 v = *(const f32x4*)(src + 4 * c4); u32x2 o; o.x = pk2(v[0], v[1]); o.y = pk2(v[2], v[3]); *(u32x2*)(mb + (size_t)row * D + 4 * c4) = o; } }
    { bf16* xb = (bf16*)(ws + WS_XB);
      for (int id = gtid; id < MTOK * (D / 4); id += NT) { const int row = id / (D / 4), c4 = id % (D / 4);
          const float* src = row < SEQP ? ((const float*)a->in[I_XP]) + (size_t)row * D : ((const float*)a->in[I_XS]) + (size_t)(row - SEQP) * D;
          const f32x4 v = *(const f32x4*)(src + 4 * c4);
          u32x2 o; o.x = pk2(v[0], v[1]); o.y = pk2(v[2], v[3]); *(u32x2*)(xb + (size_t)row * D + 4 * c4) = o; } }
}

__device__ __forceinline__ void ln_phase(const float* x, float* xo, bf16* xb, const float* g, const float* b, float* stats, bool write_x, int gw, int NGW, int lane) {
    f32x4 v[8], nx[8];
    if (gw < MTOK) { const f32x4* xr = (const f32x4*)(x + (size_t)gw * D) + lane;
#pragma unroll
        for (int j = 0; j < 8; ++j) v[j] = __builtin_nontemporal_load(xr + 64 * j); }
#pragma unroll 1
    for (int m = gw; m < MTOK; m += NGW) {
        f32x4* xr = (f32x4*)(xo + (size_t)m * D) + lane;
        if (m + NGW < MTOK) { const f32x4* xn = (const f32x4*)(x + (size_t)(m + NGW) * D) + lane;
#pragma unroll
            for (int j = 0; j < 8; ++j) nx[j] = __builtin_nontemporal_load(xn + 64 * j); }
        float s = 0.f;
#pragma unroll
        for (int j = 0; j < 8; ++j) s += (v[j][0] + v[j][1]) + (v[j][2] + v[j][3]);
        const float mean = wave_sum(s) * (1.f / D); float s2 = 0.f;
#pragma unroll
        for (int j = 0; j < 8; ++j) { v[j] = v[j] - mean; s2 += (v[j][0] * v[j][0] + v[j][1] * v[j][1]) + (v[j][2] * v[j][2] + v[j][3] * v[j][3]); }
        const float rstd = 1.f / sqrtf(wave_sum(s2) * (1.f / D) + LN_EPS);
        if (!write_x && lane == 0) *(f32x2*)(stats + 2 * (size_t)m) = (f32x2){mean, rstd};
        u32x2* o8 = (u32x2*)(xb + (size_t)m * D) + lane;
#pragma unroll
        for (int j = 0; j < 8; ++j) { const f32x4 gg = *((const f32x4*)g + lane + 64 * j), bb = *((const f32x4*)b + lane + 64 * j);
            const f32x4 o = v[j] * rstd * gg + bb; if (write_x) xr[64 * j] = o; u32x2 w; w.x = pk2(o[0], o[1]); w.y = pk2(o[2], o[3]); o8[64 * j] = w; }
#pragma unroll
        for (int j = 0; j < 8; ++j) v[j] = nx[j];
    }
}

template <bool FINAL> __device__ __forceinline__ void ln_phase_h(const unsigned short* xh, bf16* xb, float* xout, const float* g, const float* b, float* stats, int gw, int NGW, int lane) {
    u32x4 hv[4], nx[4];
    f32x4 gv[8], bv[8];
#pragma unroll
    for (int j = 0; j < 4; ++j) { const f32x4* gq = (const f32x4*)g + 2 * (lane + 64 * j); const f32x4* bq = (const f32x4*)b + 2 * (lane + 64 * j); gv[2 * j] = gq[0]; gv[2 * j + 1] = gq[1]; bv[2 * j] = bq[0]; bv[2 * j + 1] = bq[1]; }
    if (gw < MTOK) { const u32x4* xr = (const u32x4*)(xh + (size_t)gw * D) + lane;
#pragma unroll
        for (int j = 0; j < 4; ++j) hv[j] = __builtin_nontemporal_load(xr + 64 * j); }
#pragma unroll 1
    for (int m = gw; m < MTOK; m += NGW) {
        if (m + NGW < MTOK) { const u32x4* xn = (const u32x4*)(xh + (size_t)(m + NGW) * D) + lane;
#pragma unroll
            for (int j = 0; j < 4; ++j) nx[j] = __builtin_nontemporal_load(xn + 64 * j); }
        f32x4 v[8];
#pragma unroll
        for (int j = 0; j < 4; ++j) { const f32x2 a0 = pg8::h2f(hv[j].x), a1 = pg8::h2f(hv[j].y), a2 = pg8::h2f(hv[j].z), a3 = pg8::h2f(hv[j].w);
            v[2 * j] = (f32x4){a0.x, a0.y, a1.x, a1.y}; v[2 * j + 1] = (f32x4){a2.x, a2.y, a3.x, a3.y}; }
        float s = 0.f;
#pragma unroll
        for (int j = 0; j < 8; ++j) s += (v[j][0] + v[j][1]) + (v[j][2] + v[j][3]);
        const float mean = wave_sum(s) * (1.f / D); float s2 = 0.f;
#pragma unroll
        for (int j = 0; j < 8; ++j) { v[j] = v[j] - mean; s2 += (v[j][0] * v[j][0] + v[j][1] * v[j][1]) + (v[j][2] * v[j][2] + v[j][3] * v[j][3]); }
        const float rstd = 1.f / sqrtf(wave_sum(s2) * (1.f / D) + LN_EPS);
        if (!FINAL && lane == 0) *(f32x2*)(stats + 2 * (size_t)m) = (f32x2){mean, rstd};
        u32x4* o8 = (u32x4*)(xb + (size_t)m * D) + lane; f32x4* of = (f32x4*)(xout + (size_t)m * D) + 2 * lane;
#pragma unroll
        for (int j = 0; j < 4; ++j) {
            const f32x4 o0 = v[2 * j] * rstd * gv[2 * j] + bv[2 * j], o1 = v[2 * j + 1] * rstd * gv[2 * j + 1] + bv[2 * j + 1];
            if (FINAL) { of[128 * j] = o0; of[128 * j + 1] = o1; }
            else { u32x4 w; w.x = pk2(o0[0], o0[1]); w.y = pk2(o0[2], o0[3]); w.z = pk2(o1[0], o1[1]); w.w = pk2(o1[2], o1[3]); o8[64 * j] = w; } }
#pragma unroll
        for (int j = 0; j < 4; ++j) hv[j] = nx[j];
    }
}

__device__ __forceinline__ void pool_rows(const bf16* UP, bf16* OP, int row_lo, int row_hi, int step, int lane) {
    const int g = lane >> 4, half = 1 << g;
    for (int row = row_lo; row < row_hi; row += step) {
        const int pos = row_pos(row), S = row_slen(row), lo = max(pos - half, 0), hi = min(pos + half, S);
        const bf16* base = UP + (size_t)(row - pos) * 512 + 8 * lane;
        u32x4 w[16];
#pragma unroll
        for (int k = 0; k < 16; ++k) { const int s = pos - 8 + k; w[k] = (s >= lo && s < hi) ? *(const u32x4*)(base + (size_t)s * 512) : (u32x4){0u, 0u, 0u, 0u}; }
        float sum[8];
#pragma unroll
        for (int i = 0; i < 8; ++i) sum[i] = 0.f;
#pragma unroll
        for (int k = 0; k < 16; ++k) { sum[0] += bflo(w[k].x); sum[1] += bfhi(w[k].x); sum[2] += bflo(w[k].y); sum[3] += bfhi(w[k].y); sum[4] += bflo(w[k].z); sum[5] += bfhi(w[k].z); sum[6] += bflo(w[k].w); sum[7] += bfhi(w[k].w); }
        const u32x4 ws = w[8]; const float inv = 1.f / (float)(hi - lo);
        u32x4 o; o.x = pk2(sum[0] * inv - bflo(ws.x), sum[1] * inv - bfhi(ws.x)); o.y = pk2(sum[2] * inv - bflo(ws.y), sum[3] * inv - bfhi(ws.y));
        o.z = pk2(sum[4] * inv - bflo(ws.z), sum[5] * inv - bfhi(ws.z)); o.w = pk2(sum[6] * inv - bflo(ws.w), sum[7] * inv - bfhi(ws.w));
        *(u32x4*)(OP + (size_t)row * 512 + 8 * lane) = o;
    }
}

template <bool WINDOW>
__device__ __forceinline__ void attn_unit(LAS unsigned char* lds, int wave, int lane_in, const bf16* Qw, int ldq, const bf16* Kg, int ldk, const bf16* VTg, int ldvt, bf16* Ow, int ldo,
                                          int nkb, int qrel0, float m0, float l0) {
    int lane = lane_in; asm volatile("" : "+v"(lane));
    int lr = lane & 15, quad = lane >> 4;
    const int tid = wave * 64 + lane;
#define ATT_DMA(kb, b) do { _Pragma("unroll") for (int j_ = 0; j_ < 4; ++j_) { const int r_ = 32 * j_ + (tid >> 4), sc_ = 8 * ((tid & 15) ^ (r_ & 15)); \
        __builtin_amdgcn_global_load_lds((const GAS unsigned*)(Kg + (size_t)(128 * (kb) + r_) * ldk + sc_), (LAS unsigned*)(lds + (b) * 65536 + (j_ * 8 + wave) * 1024), 16, 0, 0); \
        __builtin_amdgcn_global_load_lds((const GAS unsigned*)(VTg + (size_t)r_ * ldvt + 128 * (kb) + sc_), (LAS unsigned*)(lds + (b) * 65536 + 32768 + (j_ * 8 + wave) * 1024), 16, 0, 0); } } while (0)
    bf16x8 qf[2][4];
#pragma unroll
    for (int G = 0; G < 2; ++G)
#pragma unroll
        for (int ds = 0; ds < 4; ++ds) qf[G][ds] = *(const bf16x8*)(Qw + (unsigned)((16 * G + lr) * ldq + 32 * ds + 8 * quad));
    ATT_DMA(0, 0);
    f32x4 oacc[2][8];
#pragma unroll
    for (int G = 0; G < 2; ++G)
#pragma unroll
        for (int dt = 0; dt < 8; ++dt) oacc[G][dt] = (f32x4){0.f, 0.f, 0.f, 0.f};
    float mrun[2] = {m0, m0}, lrun[2] = {l0, l0};
#pragma unroll 1
    for (int kb = 0; kb < nkb; ++kb) {
        asm volatile("" : "+v"(lr), "+v"(quad));
        if (kb + 1 < nkb) { ATT_DMA(kb + 1, (kb + 1) & 1); asm volatile("s_waitcnt vmcnt(8)" ::: "memory"); }
        else asm volatile("s_waitcnt vmcnt(0)" ::: "memory");
        asm volatile("" ::: "memory"); __builtin_amdgcn_s_barrier(); asm volatile("" ::: "memory");
        const LAS unsigned char* Kb = lds + (kb & 1) * 65536; const LAS unsigned char* Vb = Kb + 32768;
        f32x4 sacc[2][8];
#pragma unroll
        for (int T = 0; T < 8; ++T) {
            bf16x8 kf[4];
#pragma unroll
            for (int ds = 0; ds < 4; ++ds) kf[ds] = *(const LAS bf16x8*)(Kb + (16 * T + lr) * 256 + 16 * ((4 * ds + quad) ^ lr));
#pragma unroll
            for (int G = 0; G < 2; ++G) { f32x4 cc = (f32x4){0.f, 0.f, 0.f, 0.f};
#pragma unroll
                for (int ds = 0; ds < 4; ++ds) cc = __builtin_amdgcn_mfma_f32_16x16x32_bf16(kf[ds], qf[G][ds], cc, 0, 0, 0);
                sacc[G][T] = cc; }
        }
#pragma unroll
        for (int G = 0; G < 2; ++G) {
            float mx = -3.0e38f;
#pragma unroll
            for (int T = 0; T < 8; ++T)
#pragma unroll
                for (int r = 0; r < 4; ++r) { float t = sacc[G][T][r] * ATT_C1;
                    if (WINDOW) { const int dd = (qrel0 + 16 * G + lr) - (128 * kb + 16 * T + 4 * quad + r); if (dd > 128 || dd < -128) t = -1.0e30f; }
                    sacc[G][T][r] = t; mx = fmaxf(mx, t); }
            mx = fmaxf(mx, __shfl_xor(mx, 16)); mx = fmaxf(mx, __shfl_xor(mx, 32));
            const float mnew = fmaxf(mrun[G], mx), alpha = __builtin_amdgcn_exp2f(mrun[G] - mnew); mrun[G] = mnew;
            float sum = 0.f;
#pragma unroll
            for (int T = 0; T < 8; ++T)
#pragma unroll
                for (int r = 0; r < 4; ++r) { const float p = __builtin_amdgcn_exp2f(sacc[G][T][r] - mnew); sacc[G][T][r] = p; sum += p; }
            sum += __shfl_xor(sum, 16); sum += __shfl_xor(sum, 32);
            lrun[G] = lrun[G] * alpha + sum;
#pragma unroll
            for (int dt = 0; dt < 8; ++dt) oacc[G][dt] = oacc[G][dt] * alpha;
        }
#pragma unroll
        for (int s = 0; s < 4; ++s) {
            bf16x8 pf[2];
#pragma unroll
            for (int G = 0; G < 2; ++G) { u32x4 w; w.x = pk2(sacc[G][2 * s][0], sacc[G][2 * s][1]); w.y = pk2(sacc[G][2 * s][2], sacc[G][2 * s][3]);
                w.z = pk2(sacc[G][2 * s + 1][0], sacc[G][2 * s + 1][1]); w.w = pk2(sacc[G][2 * s + 1][2], sacc[G][2 * s + 1][3]); pf[G] = __builtin_bit_cast(bf16x8, w); }
#pragma unroll
            for (int dt = 0; dt < 8; ++dt) {
                const int p8 = 8 * s + quad;
                const LAS unsigned char* vrow = Vb + (16 * dt + lr) * 256 + 8 * (p8 & 1);
                const u32x2 lo = *(const LAS u32x2*)(vrow + 16 * ((p8 >> 1) ^ lr)), hi = *(const LAS u32x2*)(vrow + 16 * (((p8 >> 1) + 2) ^ lr));
                const bf16x8 vf = __builtin_bit_cast(bf16x8, (u32x4){lo.x, lo.y, hi.x, hi.y});
#pragma unroll
                for (int G = 0; G < 2; ++G) oacc[G][dt] = __builtin_amdgcn_mfma_f32_16x16x32_bf16(vf, pf[G], oacc[G][dt], 0, 0, 0);
            }
        }
        asm volatile("" ::: "memory"); __builtin_amdgcn_s_barrier(); asm volatile("" ::: "memory");
    }
#undef ATT_DMA
#pragma unroll
    for (int G = 0; G < 2; ++G) { const float inv = 1.f / lrun[G];
#pragma unroll
        for (int dt = 0; dt < 8; ++dt) { const f32x4 o = oacc[G][dt] * inv; u32x2 w; w.x = pk2(o[0], o[1]); w.y = pk2(o[2], o[3]);
            *(u32x2*)(Ow + (unsigned)((16 * G + lr) * ldo + 16 * dt + 4 * quad)) = w; } }
}

__device__ __forceinline__ void winattn_unit(KArgs a, int L, LAS unsigned char* lds, int wave, int lane, int unit) {
    unsigned char* ws = (unsigned char*)a->ws;
    const bf16* Q = (const bf16*)(ws + WS_Q); const bf16* K = (const bf16*)(ws + WS_K); const bf16* VT = (const bf16*)(ws + WS_VT); bf16* O = (bf16*)(ws + WS_OATT);
    const float* sink = ((const float*)a->in[I_SINK]) + L * 8;
    const int hkv = unit & 1, row0 = (unit >> 1) * 64, pos0 = row_pos(row0), S = row_slen(row0), qb = pos0 >> 7;
    const int kb_lo = max(qb - 1, 0), kb_hi = min(qb + 1, (S >> 7) - 1), keyrow0 = (row0 - pos0) + 128 * kb_lo;
    const int hq = hkv * 4 + (wave & 3), rw = row0 + 32 * (wave >> 2);
    attn_unit<true>(lds, wave, lane, Q + (size_t)rw * 1024 + hq * 128, 1024, K + (size_t)keyrow0 * 256 + hkv * 128, 256, VT + (size_t)(hkv * 128) * MTOK + keyrow0, MTOK,
                    O + (size_t)rw * 1024 + hq * 128, 1024, kb_hi - kb_lo + 1, (pos0 + 32 * (wave >> 2)) - 128 * kb_lo, sink[hq] * LOG2E, 1.f);
}
constexpr int NQ_ATT = (MTOK / 64) * 2, NQ_POOL = MTOK / 64;
__device__ __forceinline__ void mixq_phase(KArgs a, int L, LAS unsigned char* lds, volatile LAS unsigned* MISC, unsigned* ctr, int wave, int lane) {
    unsigned char* ws = (unsigned char*)a->ws;
    for (;;) {
        if (wave == 0 && lane == 0) MISC[0] = __hip_atomic_fetch_add(ctr, 1u, __ATOMIC_RELAXED, __HIP_MEMORY_SCOPE_AGENT);
        __syncthreads();
        const int u = (int)MISC[0];
        __syncthreads();
        if (u >= NQ_ATT + NQ_POOL) break;
        if (u < NQ_ATT) winattn_unit(a, L, lds, wave, lane, u);
        else { const int r0 = (u - NQ_ATT) * 64 + wave * 8; pool_rows((const bf16*)(ws + WS_UPOOL), (bf16*)(ws + WS_OPOOL), r0, r0 + 8, 1, lane); }
    }
}
__device__ __forceinline__ void xattn_phase(KArgs a, LAS unsigned char* lds, int wave, int lane) {
    unsigned char* ws = (unsigned char*)a->ws;
    const bf16* Q = (const bf16*)(ws + WS_QX); const bf16* K = (const bf16*)(ws + WS_KX); const bf16* VT = (const bf16*)(ws + WS_VXT); bf16* O = (bf16*)(ws + WS_OX);
    for (int unit = blockIdx.x; unit < (MTOK / 256) * 4; unit += gridDim.x) {
        const int h = unit & 3, row0 = (unit >> 2) * 256, seq = row0 < SEQP ? 0 : 1 + ((row0 - SEQP) >> 12), rw = row0 + 32 * wave;
        attn_unit<false>(lds, wave, lane, Q + (size_t)rw * 512 + h * 128, 512, K + (size_t)(MEML * seq) * 512 + h * 128, 512, VT + (size_t)(h * 128) * MMEM + MEML * seq, MMEM,
                         O + (size_t)rw * 512 + h * 128, 512, 2, 0, -1.0e30f, 0.f);
    }
}

__device__ __forceinline__ void prepa_phase(KArgs a, int L, int gw, int NGW, int lane_in) {
    unsigned char* ws = (unsigned char*)a->ws;
    const float* U = (const float*)(ws + WS_URWKV); float* SH = (float*)(ws + WS_SH); float* KB = (float*)(ws + WS_KBUF); bf16* AL = (bf16*)(ws + WS_AL);
    const float* mu0p = ((const float*)a->in[I_MU]) + (size_t)L * 2 * RWC; const float* mu1p = mu0p + RWC; const float* k_k = ((const float*)a->in[I_KK]) + L * 512;
    int lane = lane_in; asm volatile("" : "+v"(lane));
    f32x4 m0[8], m1[8];
#pragma unroll
    for (int j = 0; j < 8; ++j) { const int c = 256 * j + 4 * lane; const bool ok = c < RWC; m0[j] = ok ? *(const f32x4*)(mu0p + c) : (f32x4){0.f, 0.f, 0.f, 0.f}; m1[j] = ok ? *(const f32x4*)(mu1p + c) : (f32x4){0.f, 0.f, 0.f, 0.f}; }
    const f32x4 kk0 = *(const f32x4*)(k_k + 4 * lane), kk1 = *(const f32x4*)(k_k + 256 + 4 * lane);
    const f32x4 zero4 = {0.f, 0.f, 0.f, 0.f};
    for (int run = gw; run < MTOK / 8; run += NGW) {
        const int r0 = run * 8, pos0 = row_pos(r0), S = row_slen(r0);
        f32x4 P[8], C[8], N[8];
        { const float* up = U + (size_t)(r0 - 1) * 2048 + 4 * lane; const float* uc = U + (size_t)r0 * 2048 + 4 * lane; const bool hp = pos0 > 0;
#pragma unroll
          for (int j = 0; j < 8; ++j) { P[j] = hp ? *(const f32x4*)(up + 256 * j) : zero4; C[j] = *(const f32x4*)(uc + 256 * j); } }
#pragma unroll 1
        for (int t = 0; t < 8; ++t) {
            const int row = r0 + t; const bool hn = (pos0 + t) < S - 1;
            { const float* un = U + (size_t)(row + 1) * 2048 + 4 * lane;
#pragma unroll
              for (int j = 0; j < 8; ++j) N[j] = hn ? *(const f32x4*)(un + 256 * j) : zero4; }
            f32x4 xs[8];
#pragma unroll
            for (int j = 0; j < 8; ++j) xs[j] = C[j] + m0[j] * (P[j] - C[j]) + m1[j] * (N[j] - C[j]);
            const int hl = lane >> 4, jj = 4 * (lane & 15);
#pragma unroll
            for (int j2 = 0; j2 < 2; ++j2) { float* sh = SH + ((size_t)row * 8 + 4 * j2 + hl) * 192 + jj;
                *(f32x4*)(sh + 64) = xs[j2]; *(f32x4*)(sh + 128) = xs[4 + j2];
                const f32x4 kv = xs[2 + j2]; *(f32x4*)(KB + (size_t)row * 512 + 256 * j2 + 4 * lane) = kv;
                const f32x4 ku = kv * (j2 ? kk1 : kk0); float ss = (ku[0] * ku[0] + ku[1] * ku[1]) + (ku[2] * ku[2] + ku[3] * ku[3]);
                ss += __shfl_xor(ss, 1); ss += __shfl_xor(ss, 2); ss += __shfl_xor(ss, 4); ss += __shfl_xor(ss, 8);
                const float inv = -1.f / fmaxf(sqrtf(ss), 1e-12f); *(f32x4*)sh = ku * inv; }
            { const f32x4 x6 = xs[6]; f32x4 o6;
#pragma unroll
              for (int e = 0; e < 4; ++e) o6[e] = lane < 32 ? tanhf(x6[e]) : x6[e];
              u32x2 w; w.x = pk2(o6[0], o6[1]); w.y = pk2(o6[2], o6[3]); *(u32x2*)(AL + (size_t)row * 384 + 4 * lane) = w;
              if (lane < 32) { const f32x4 x7 = xs[7]; u32x2 w7; w7.x = pk2(1.f / (1.f + expf(-x7[0])), 1.f / (1.f + expf(-x7[1]))); w7.y = pk2(1.f / (1.f + expf(-x7[2])), 1.f / (1.f + expf(-x7[3])));
                  *(u32x2*)(AL + (size_t)row * 384 + 256 + 4 * lane) = w7; } }
#pragma unroll
            for (int j = 0; j < 8; ++j) { P[j] = C[j]; C[j] = N[j]; }
        }
    }
}

__device__ __forceinline__ void scan_phase(KArgs a, LAS unsigned char* lds, int gw, int NGW, int wave, int lane) {
    unsigned char* ws = (unsigned char*)a->ws;
    const float* SH = (const float*)(ws + WS_SH); const float* DIR = (const float*)(ws + WS_DIR);
    float* Y = (float*)(ws + WS_Y); float* Z = (float*)(ws + WS_Z); float* QM = (float*)(ws + WS_QM); float* PM = (float*)(ws + WS_PM);
    LAS unsigned char* wlb = lds + RING_OFF + wave * 12288;
    for (int task = gw; task < NCP * 16; task += NGW) {
        const int cp = task >> 4, e = (task >> 3) & 1, h = task & 7;
#define SCAN_DMA(bb) do { int ln_ = lane; asm volatile("" : "+v"(ln_)); _Pragma("unroll") for (int pr_ = 0; pr_ < 2; ++pr_) _Pragma("unroll") for (int k_ = 0; k_ < 3; ++k_) { \
            const int o_ = 1024 * k_ + 16 * ln_, stp_ = o_ >= 1536 ? 1 : 0, wi_ = o_ - 1536 * stp_, blk_ = wi_ >= 768 ? 1 : 0, off_ = (wi_ - 768 * blk_) >> 2; \
            const int tau_ = 4 * (bb) + 2 * pr_ + stp_, row_ = cp * CH + (e ? CH - 1 - tau_ : tau_); \
            const float* src_ = blk_ ? DIR + (((size_t)row_ * 2 + e) * 8 + h) * 192 + off_ : SH + ((size_t)row_ * 8 + h) * 192 + off_; \
            __builtin_amdgcn_global_load_lds((const GAS unsigned*)src_, (LAS unsigned*)(wlb + (((bb) & 1) * 4 + 2 * pr_) * 1536 + 1024 * k_), 16, 0, 0); } } while (0)
        LDS_WAIT(); asm volatile("" ::: "memory");
        SCAN_DMA(0);
        asm volatile("" ::: "memory");
        f32x2 S2[32], X2[32];
        { int ln = lane; asm volatile("" : "+v"(ln));
#pragma unroll
          for (int q = 0; q < 32; ++q) { S2[q] = (f32x2){0.f, 0.f}; X2[q] = (f32x2){(2 * q == ln) ? 1.f : 0.f, (2 * q + 1 == ln) ? 1.f : 0.f}; } }
        f32x4 buf[2][8];
#pragma unroll 1
        for (int bb = 0; bb < CH / 4; ++bb) {
            if (bb == 0) asm volatile("s_waitcnt vmcnt(0)" ::: "memory");
            else asm volatile("s_waitcnt vmcnt(8)" ::: "memory");
            if (bb + 1 < CH / 4) SCAN_DMA(bb + 1);
            const LAS float* p0 = (const LAS float*)(wlb + ((bb & 1) * 4) * 1536);
#pragma unroll
            for (int i = 0; i < 8; ++i) buf[0][i] = *(const LAS f32x4*)(p0 + 4 * i);
#pragma unroll 1
            for (int st = 0; st < 4; ++st) {
                const LAS float* p = p0 + st * 384;
                const int tau = 4 * bb + st, row = cp * CH + (e ? CH - 1 - tau : tau);
                const float vi = p[128 + lane];
                f32x2 sa0 = {0.f, 0.f}, sa1 = {0.f, 0.f}, sx0 = {0.f, 0.f}, sx1 = {0.f, 0.f};
#pragma unroll
                for (int i = 0; i < 8; ++i) buf[1][i] = *(const LAS f32x4*)(p + 32 + 4 * i);
                asm volatile("" : "+v"(sa0), "+v"(sx0) :: "memory");
#pragma unroll
                for (int i = 0; i < 8; ++i) { const f32x4 nk = buf[0][i]; sa0 += S2[2 * i] * nk.xy; sa1 += S2[2 * i + 1] * nk.zw; sx0 += X2[2 * i] * nk.xy; sx1 += X2[2 * i + 1] * nk.zw; }
                asm volatile("" : "+v"(sa0), "+v"(sa1), "+v"(sx0), "+v"(sx1) :: "memory");
#pragma unroll
                for (int j = 0; j < 2; ++j) { buf[0][j] = *(const LAS f32x4*)(p + 64 + 4 * j); buf[0][2 + j] = *(const LAS f32x4*)(p + 192 + 4 * j); buf[0][4 + j] = *(const LAS f32x4*)(p + 256 + 4 * j); buf[0][6 + j] = *(const LAS f32x4*)(p + 320 + 4 * j); }
                asm volatile("" : "+v"(sa0), "+v"(sx0) :: "memory");
#pragma unroll
                for (int i = 0; i < 8; ++i) { const f32x4 nk = buf[1][i]; sa0 += S2[16 + 2 * i] * nk.xy; sa1 += S2[16 + 2 * i + 1] * nk.zw; sx0 += X2[16 + 2 * i] * nk.xy; sx1 += X2[16 + 2 * i + 1] * nk.zw; }
                asm volatile("" : "+v"(sa0), "+v"(sa1), "+v"(sx0), "+v"(sx1) :: "memory");
                const float sa = (sa0.x + sa0.y) + (sa1.x + sa1.y), sx = (sx0.x + sx0.y) + (sx1.x + sx1.y);
                const f32x2 sav = {sa, sa}, sxv = {sx, sx}, vv = {vi, vi};
                f32x2 y0 = {0.f, 0.f}, y1 = {0.f, 0.f}, z0 = {0.f, 0.f}, z1 = {0.f, 0.f};
#pragma unroll
                for (int g = 0; g < 8; ++g) {
                    if (g < 7) {
#pragma unroll
                        for (int j = 0; j < 2; ++j) { const int q = 2 * (g + 1) + j; buf[(g + 1) & 1][j] = *(const LAS f32x4*)(p + 64 + 4 * q); buf[(g + 1) & 1][2 + j] = *(const LAS f32x4*)(p + 192 + 4 * q);
                            buf[(g + 1) & 1][4 + j] = *(const LAS f32x4*)(p + 256 + 4 * q); buf[(g + 1) & 1][6 + j] = *(const LAS f32x4*)(p + 320 + 4 * q); }
                    } else if (st < 3) {
#pragma unroll
                        for (int i = 0; i < 8; ++i) buf[0][i] = *(const LAS f32x4*)(p + 384 + 4 * i);
                    }
                    asm volatile("" : "+v"(y0), "+v"(z0) :: "memory");
#pragma unroll
                    for (int j = 0; j < 2; ++j) { const int q = 2 * g + j; const f32x4 r4 = buf[g & 1][j], w4 = buf[g & 1][2 + j], ka4 = buf[g & 1][4 + j], kd4 = buf[g & 1][6 + j];
                        S2[2 * q] = S2[2 * q] * w4.xy + sav * ka4.xy + vv * kd4.xy; y0 += S2[2 * q] * r4.xy;
                        S2[2 * q + 1] = S2[2 * q + 1] * w4.zw + sav * ka4.zw + vv * kd4.zw; y1 += S2[2 * q + 1] * r4.zw;
                        X2[2 * q] = X2[2 * q] * w4.xy + sxv * ka4.xy; z0 += X2[2 * q] * r4.xy;
                        X2[2 * q + 1] = X2[2 * q + 1] * w4.zw + sxv * ka4.zw; z1 += X2[2 * q + 1] * r4.zw; }
                    asm volatile("" : "+v"(y0), "+v"(y1), "+v"(z0), "+v"(z1) :: "memory");
                }
                const size_t oi = (((size_t)row * 2 + e) * 8 + h) * 64 + lane;
                Y[oi] = (y0.x + y0.y) + (y1.x + y1.y); Z[oi] = (z0.x + z0.y) + (z1.x + z1.y);
            }
        }
#undef SCAN_DMA
        float* qo = QM + (size_t)task * 4096 + lane * 64; float* po = PM + (size_t)task * 4096 + lane * 64;
#pragma unroll
        for (int q = 0; q < 16; ++q) { *(f32x4*)(qo + 4 * q) = (f32x4){S2[2 * q].x, S2[2 * q].y, S2[2 * q + 1].x, S2[2 * q + 1].y};
            *(f32x4*)(po + 4 * q) = (f32x4){X2[2 * q].x, X2[2 * q].y, X2[2 * q + 1].x, X2[2 * q + 1].y}; }
    }
}

__device__ __forceinline__ void carry_phase(KArgs a, LAS unsigned char* lds, int wave, int lane_in) {
    const int chain = blockIdx.x;
    if (chain >= NSEQ * 16) return;
    unsigned char* ws = (unsigned char*)a->ws;
    const float* QM = (const float*)(ws + WS_QM); const float* PM = (const float*)(ws + WS_PM); float* SST = (float*)(ws + WS_SST);
    const int seq = chain >> 4, e = (chain >> 3) & 1, h = chain & 7;
    const int cp0 = seq == 0 ? 0 : (SEQP / CH) + (SEQS / CH) * (seq - 1), nc = seq == 0 ? SEQP / CH : SEQS / CH;
    LAS float* ST = (LAS float*)(lds + RING_OFF); LAS float* PB = (LAS float*)(lds + RING_OFF + 16896);
    int lane = lane_in; asm volatile("" : "+v"(lane));
    const int tid = wave * 64 + lane, lr = lane & 15, quad = lane >> 4, ti = wave >> 1, tj0 = 2 * (wave & 1);
    f32x4 sreg[2] = {{0.f, 0.f, 0.f, 0.f}, {0.f, 0.f, 0.f, 0.f}};
    for (int k = tid; k < 64 * 65; k += 512) ST[k] = 0.f;
    f32x4 pn0, pn1; float qn[2][4];
    { const int cp = e ? cp0 + nc - 1 : cp0; const size_t sidx = ((size_t)cp * 2 + e) * 8 + h;
      pn0 = *(const f32x4*)(PM + sidx * 4096 + 4 * tid); pn1 = *(const f32x4*)(PM + sidx * 4096 + 2048 + 4 * tid);
#pragma unroll
      for (int t = 0; t < 2; ++t)
#pragma unroll
          for (int r = 0; r < 4; ++r) qn[t][r] = QM[sidx * 4096 + (size_t)(16 * ti + 4 * quad + r) * 64 + 16 * (tj0 + t) + lr]; }
#pragma unroll 1
    for (int c = 0; c < nc; ++c) {
        const int cp = e ? cp0 + nc - 1 - c : cp0 + c; const size_t sidx = ((size_t)cp * 2 + e) * 8 + h;
#pragma unroll
        for (int t = 0; t < 2; ++t) { const int j = 16 * (tj0 + t) + lr;
#pragma unroll
            for (int r = 0; r < 4; ++r) SST[sidx * 4096 + (size_t)((j >> 2) * 64 + 16 * ti + 4 * quad + r) * 4 + (j & 3)] = sreg[t][r]; }
        if (c == nc - 1) break;
        { const int i0 = 4 * tid, i1 = 2048 + 4 * tid; *(LAS f32x4*)(PB + (i0 >> 6) * 80 + (i0 & 63)) = pn0; *(LAS f32x4*)(PB + (i1 >> 6) * 80 + (i1 & 63)) = pn1; }
        f32x4 acc[2];
#pragma unroll
        for (int t = 0; t < 2; ++t) acc[t] = (f32x4){qn[t][0], qn[t][1], qn[t][2], qn[t][3]};
        if (c + 1 < nc - 1) { const int cpn = e ? cp0 + nc - 2 - c : cp0 + c + 1; const size_t sn = ((size_t)cpn * 2 + e) * 8 + h;
            pn0 = *(const f32x4*)(PM + sn * 4096 + 4 * tid); pn1 = *(const f32x4*)(PM + sn * 4096 + 2048 + 4 * tid);
#pragma unroll
            for (int t = 0; t < 2; ++t)
#pragma unroll
                for (int r = 0; r < 4; ++r) qn[t][r] = QM[sn * 4096 + (size_t)(16 * ti + 4 * quad + r) * 64 + 16 * (tj0 + t) + lr]; }
        __syncthreads();
#pragma unroll
        for (int kk = 0; kk < 16; ++kk) { const float a_ = ST[(16 * ti + lr) * 65 + 4 * kk + quad];
#pragma unroll
            for (int t = 0; t < 2; ++t) { const float b_ = PB[(4 * kk + quad) * 80 + 16 * (tj0 + t) + lr]; acc[t] = __builtin_amdgcn_mfma_f32_16x16x4f32(a_, b_, acc[t], 0, 0, 0); } }
        __syncthreads();
#pragma unroll
        for (int t = 0; t < 2; ++t) {
#pragma unroll
            for (int r = 0; r < 4; ++r) ST[(16 * ti + 4 * quad + r) * 65 + 16 * (tj0 + t) + lr] = acc[t][r];
            sreg[t] = acc[t]; }
    }
}

struct PostIn { float zf[4], zb[4], yv[4], rr[4], vv[4], kd[4], gt[4]; };
__device__ __forceinline__ void post_load(PostIn& q, const float* SH, const float* DIR, const float* Y, const float* Z, const bf16* G, int rowb, int h, int lane) {
#pragma unroll
    for (int u = 0; u < 4; ++u) { const int row = rowb + u; const size_t yi = (((size_t)row * 2) * 8 + h) * 64 + lane;
        q.zf[u] = Z[yi]; q.zb[u] = Z[yi + 512]; q.yv[u] = Y[yi] + Y[yi + 512];
        const float* sh = SH + ((size_t)row * 8 + h) * 192; q.rr[u] = sh[64 + lane]; q.vv[u] = sh[128 + lane];
        q.kd[u] = DIR[(((size_t)row * 2 + 0) * 8 + h) * 192 + 128 + lane] + DIR[(((size_t)row * 2 + 1) * 8 + h) * 192 + 128 + lane];
        q.gt[u] = __uint_as_float(((unsigned)G[(size_t)row * 512 + h * 64 + lane]) << 16); }
}
__device__ __forceinline__ void post_phase(KArgs a, int L, LAS unsigned char* lds, int gw, int NGW, int wave, int lane_in) {
    unsigned char* ws = (unsigned char*)a->ws;
    const float* SH = (const float*)(ws + WS_SH); const float* DIR = (const float*)(ws + WS_DIR); const float* Y = (const float*)(ws + WS_Y); const float* Z = (const float*)(ws + WS_Z);
    const float* SST = (const float*)(ws + WS_SST); const bf16* G = (const bf16*)(ws + WS_G); bf16* O = (bf16*)(ws + WS_ORWKV);
    const float* gng = ((const float*)a->in[I_GNG]) + L * 512; const float* gnb = ((const float*)a->in[I_GNB]) + L * 512; const float* rk = ((const float*)a->in[I_RK]) + L * 512;
    LAS float* zl = (LAS float*)(lds + RING_OFF + wave * 2048);
    for (int task = gw; task < NCP * 16; task += NGW) {
        int lane = lane_in; asm volatile("" : "+v"(lane));
        const int cp = task >> 4, hf = (task >> 3) & 1, h = task & 7;
        PostIn cur, nxt;
        post_load(cur, SH, DIR, Y, Z, G, cp * CH + hf * 64, h, lane);
        f32x2 Sf[32], Sb[32];
        { const float* sf = SST + (((size_t)cp * 2 + 0) * 8 + h) * 4096 + lane * 4; const float* sb = SST + (((size_t)cp * 2 + 1) * 8 + h) * 4096 + lane * 4;
#pragma unroll
          for (int q = 0; q < 16; ++q) { const f32x4 x = *(const f32x4*)(sf + q * 256), y = *(const f32x4*)(sb + q * 256); Sf[2 * q] = x.xy; Sf[2 * q + 1] = x.zw; Sb[2 * q] = y.xy; Sb[2 * q + 1] = y.zw; } }
        const float gg = gng[h * 64 + lane], gb = gnb[h * 64 + lane], rkk = rk[h * 64 + lane];
#pragma unroll 1
        for (int tb = 0; tb < 16; ++tb) {
            const int rowb = cp * CH + hf * 64 + tb * 4;
            if (tb < 15) post_load(nxt, SH, DIR, Y, Z, G, rowb + 4, h, lane);
            LDS_WAIT(); asm volatile("" ::: "memory");
#pragma unroll
            for (int u = 0; u < 4; ++u) { zl[(u * 2 + 0) * 64 + lane] = cur.zf[u]; zl[(u * 2 + 1) * 64 + lane] = cur.zb[u]; }
            LDS_WAIT(); asm volatile("" ::: "memory");
            float y[4], sbn[4];
#pragma unroll
            for (int u = 0; u < 4; ++u) {
                f32x2 c0 = {0.f, 0.f}, c1 = {0.f, 0.f};
#pragma unroll
                for (int q = 0; q < 16; ++q) { const f32x4 f4 = *(const LAS f32x4*)(zl + (u * 2 + 0) * 64 + 4 * q), b4 = *(const LAS f32x4*)(zl + (u * 2 + 1) * 64 + 4 * q);
                    c0 += Sf[2 * q] * f4.xy + Sb[2 * q] * b4.xy; c1 += Sf[2 * q + 1] * f4.zw + Sb[2 * q + 1] * b4.zw; }
                y[u] = cur.yv[u] + (c0.x + c0.y) + (c1.x + c1.y); sbn[u] = cur.rr[u] * cur.kd[u] * rkk;
            }
            float mean[4];
#pragma unroll
            for (int u = 0; u < 4; ++u) mean[u] = y[u];
#pragma unroll
            for (int o = 1; o < 64; o <<= 1)
#pragma unroll
                for (int u = 0; u < 4; ++u) { mean[u] += __shfl_xor(mean[u], o); sbn[u] += __shfl_xor(sbn[u], o); }
            float var[4];
#pragma unroll
            for (int u = 0; u < 4; ++u) { y[u] -= mean[u] * (1.f / 64.f); var[u] = y[u] * y[u]; }
#pragma unroll
            for (int o = 1; o < 64; o <<= 1)
#pragma unroll
                for (int u = 0; u < 4; ++u) var[u] += __shfl_xor(var[u], o);
#pragma unroll
            for (int u = 0; u < 4; ++u) { const float yn = y[u] * (1.f / sqrtf(var[u] * (1.f / 64.f) + GN_EPS)) * gg + gb;
                const float o = (yn + sbn[u] * cur.vv[u]) * cur.gt[u];
                O[(size_t)(rowb + u) * 512 + h * 64 + lane] = (bf16)(pk2(o, 0.f) & 0xffffu); }
            cur = nxt;
        }
    }
}

#define SEAM() do { if (a.single) { XcdBarrier b_ = bar; asm volatile("" : "+s"(b_.bar), "+s"(b_.x)); xcd_barrier(b_); } } while (0)
#ifndef PHMASK
#define PHMASK 0x1ffff
#endif
#ifndef DUPMASK
#define DUPMASK 0
#endif
#define RUN(k) ((((PHMASK) >> (k)) & 1) && a.ph_lo <= (k) && (k) < a.ph_hi)
#define REP(k) for (int rep_ = 0; rep_ < (((DUPMASK) >> (k)) & 1) + 1; ++rep_)
#define KA() KArgs ka = (KArgs)__builtin_amdgcn_kernarg_segment_ptr(); asm volatile("" : "+s"(ka)); unsigned char* ws = (unsigned char*)ka->ws; float* X = (float*)ka->out; unsigned short* XH = (unsigned short*)ka->out; unsigned short* XF = (unsigned short*)(ws + WS_GATES); (void)XH; (void)XF; bf16* XB = (bf16*)(ws + WS_XB); (void)X; (void)XB
#define IDS() KA(); const int lane = hw_lane(), wave = wave_s, tid = wave * 64 + lane, gw = blockIdx.x * NWAVES + wave, gtid = blockIdx.x * (NWAVES * 64) + tid; (void)lane; (void)gw; (void)gtid; (void)tid


template <int IT> __device__ __forceinline__ void half_layer(const Args& a, LAS unsigned char* lds, const XcdBarrier& bar, int G, int NGW, int NT, int wave_s) {
    constexpr int it = IT;
        const int L = it >> 1, s = it & 1;
        REP(0) if (s == 0 && RUN(0)) { IDS(); conv_phase(ka, L, lds, gw, NGW, wave, lane, gtid, NT); if (it == 0) prologue_phase(ka, gtid, NT); __syncthreads(); SEAM(); }
        REP(1) if (RUN(1)) {
            KA();
            pg8::Gemm g{XB, (const bf16*)(ws + WS_W1T) + (size_t)s * 2 * DFF * D, MTOK, 2 * DFF, D}; pg8::StaticOrder S; S.init(MTOK, 2 * DFF, G, (int)blockIdx.x);
            pg8::EpiSwiglu E{(bf16*)(ws + WS_H)};
            pg8::gemm_phase<pg8::EpiSwiglu, pg8::StaticOrder, true, true>(lds + RING_OFF, g, S, E, wave_s);
            SEAM();
        }
        REP(2) if (RUN(2)) {
            KA();
            pg8::Gemm g{(const bf16*)(ws + WS_H), (const bf16*)(ws + WS_W2T) + (size_t)s * D * DFF, MTOK, D, DFF}; pg8::StaticOrder S; S.init(MTOK, D, G, (int)blockIdx.x, 4);
            constexpr int pli = it == 0 ? 0 : (s == 0 ? ((L - 1) * 4 + 3) : (L * 4 + 2));
            if constexpr (it == 0) { pg8::EpiResidH<false, true, false> E{XH, XF, nullptr, (const float*)ka->in[I_XP], (const float*)ka->in[I_XS]};
                pg8::gemm_phase<pg8::EpiResidH<false, true, false>, pg8::StaticOrder, true, true>(lds + RING_OFF, g, S, E, wave_s); }
            else { constexpr bool last = (it == 2 * DEPTH - 1); pg8::EpiResidH<true, true, last> E{XH, XF, (const float*)(ws + WS_STATS), ((const float*)ka->in[I_LNG]) + pli * D, ((const float*)ka->in[I_LNB]) + pli * D};
                pg8::gemm_phase<pg8::EpiResidH<true, true, last>, pg8::StaticOrder, true, true>(lds + RING_OFF, g, S, E, wave_s); }
            SEAM();
        }
        REP(3) if (RUN(3)) { IDS(); const int li = (L * 4 + (s ? 3 : 0)) * D; if constexpr (it == 2 * DEPTH - 1) ln_phase_h<true>(XF, XB, X, ((const float*)ka->in[I_LNG]) + li, ((const float*)ka->in[I_LNB]) + li, (float*)(ws + WS_STATS), gw, NGW, lane);
            else ln_phase_h<false>(XH, XB, X, ((const float*)ka->in[I_LNG]) + li, ((const float*)ka->in[I_LNB]) + li, (float*)(ws + WS_STATS), gw, NGW, lane); SEAM(); }
        if (s == 0) {
            REP(4) if (RUN(4)) {
                KA();
                { pg8::Gemm g{XB, (const bf16*)(ws + WS_WINT), MTOK, NWIN, D}; pg8::StaticOrder S; S.init(MTOK, NWIN, G, (int)blockIdx.x);
                  pg8::EpiWin E{(bf16*)(ws + WS_UPOOL), (bf16*)(ws + WS_Q), (bf16*)(ws + WS_K), (bf16*)(ws + WS_GATES), (float*)(ws + WS_URWKV), (const float*)(ws + WS_CS), (bf16*)(ws + WS_VT)};
                  pg8::gemm_phase<pg8::EpiWin, pg8::StaticOrder, true, true>(lds + RING_OFF, g, S, E, wave_s); }
                SEAM();
            }
            REP(5) if (RUN(5)) {
                IDS();
                REP(19) prepa_phase(ka, L, gw, NGW, lane);
                SEAM();
            }
            REP(6) if (RUN(6)) {
                KA();
                pg8::Gemm g{(const bf16*)(ws + WS_AL), (const bf16*)(ws + WS_BL), MTOK, 2560, 384}; pg8::StaticOrder S; S.init(MTOK, 2560, G, (int)blockIdx.x);
                pg8::EpiLora E{((const float*)ka->in[I_W0]) + L * 1024, ((const float*)ka->in[I_A0]) + L * 1024, ((const float*)ka->in[I_KA]) + L * 512, (const float*)(ws + WS_SH), (const float*)(ws + WS_KBUF), (float*)(ws + WS_DIR), (bf16*)(ws + WS_G)};
                pg8::gemm_phase<pg8::EpiLora, pg8::StaticOrder, true, true>(lds + RING_OFF, g, S, E, wave_s);
                SEAM();
            }
            REP(7) if (RUN(7)) { IDS(); scan_phase(ka, lds, gw, NGW, wave, lane); SEAM(); }
            REP(8) if (RUN(8)) { IDS(); carry_phase(ka, lds, wave, lane); __syncthreads();
                mixq_phase(ka, L, lds, (volatile LAS unsigned*)(lds + MISC_OFF), (unsigned*)((unsigned long long)ka->ws + WS_CTL + 65536 + 256 * (L * 2 + rep_)), wave, lane); SEAM(); }
            REP(9) if (RUN(9)) { IDS(); post_phase(ka, L, lds, gw, NGW, wave, lane); SEAM(); }
            REP(10) if (RUN(10)) {
                KA();
#pragma unroll 1
                for (int b = 0; b < 3; ++b) {
                    const bf16* Ab = (const bf16*)(ws + (b == 0 ? WS_OPOOL : (b == 1 ? WS_OATT : WS_ORWKV)));
                    const bf16* Bb = (const bf16*)(ws + (b == 0 ? WS_WBR0 : (b == 1 ? WS_WBR1 : WS_WBR2)));
                    pg8::Gemm g{Ab, Bb, MTOK, D, b == 1 ? 1024 : 512}; pg8::StaticOrder S; S.init(MTOK, D, G, (int)blockIdx.x, 4);
                    pg8::EpiBranch E{(bf16*)(ws + WS_MERGED), (const bf16*)(ws + WS_GATES) + b * D, b == 0 ? 1 : 0};
                    pg8::gemm_phase<pg8::EpiBranch, pg8::StaticOrder, true, true>(lds + RING_OFF, g, S, E, wave_s);
                }
                SEAM();
            }
            REP(11) if (RUN(11)) {
                KA();
                pg8::Gemm g{(const bf16*)(ws + WS_MERGED), (const bf16*)(ws + WS_WOUT), MTOK, D, D}; pg8::StaticOrder S; S.init(MTOK, D, G, (int)blockIdx.x, 4);
                pg8::EpiResidH<true, false, false> E{XH, XF, (const float*)(ws + WS_STATS), ((const float*)ka->in[I_LNG]) + (L * 4 + 0) * D, ((const float*)ka->in[I_LNB]) + (L * 4 + 0) * D};
                pg8::gemm_phase<pg8::EpiResidH<true, false, false>, pg8::StaticOrder, true, true>(lds + RING_OFF, g, S, E, wave_s);
                SEAM();
            }
            REP(12) if (RUN(12)) { IDS(); const int li = (L * 4 + 1) * D; ln_phase_h<false>(XH, XB, X, ((const float*)ka->in[I_LNG]) + li, ((const float*)ka->in[I_LNB]) + li, (float*)(ws + WS_STATS), gw, NGW, lane); SEAM(); }
            REP(13) if (RUN(13)) {
                KA();
                static_assert((WS_XB & (MiB - 1)) == 0 && (WS_WQ & (MiB - 1)) == 0 && (WS_MEMB & (MiB - 1)) == 0 && (WS_WKV & (MiB - 1)) == 0 && WS_MEMB < WS_WKV && WS_WKV < WS_XB, "XqOrder indexes 1-MiB operand tiles of d_ws");
                pg8::Gemm g{(const bf16*)ws, (const bf16*)ws, 0, 0, D}; pg8::XqOrder S{G, (int)blockIdx.x};
                pg8::EpiXq E{(bf16*)(ws + WS_QX), (bf16*)(ws + WS_KX), (bf16*)(ws + WS_VXT)};
                pg8::gemm_phase<pg8::EpiXq, pg8::XqOrder, true, true>(lds + RING_OFF, g, S, E, wave_s);
                SEAM();
            }
            REP(14) if (RUN(14)) { IDS(); xattn_phase(ka, lds, wave, lane); SEAM(); }
            REP(15) if (RUN(15)) {
                KA();
                pg8::Gemm g{(const bf16*)(ws + WS_OX), (const bf16*)(ws + WS_WO), MTOK, D, 512}; pg8::StaticOrder S; S.init(MTOK, D, G, (int)blockIdx.x, 4);
                pg8::EpiResidH<true, false, false> E{XH, XF, (const float*)(ws + WS_STATS), ((const float*)ka->in[I_LNG]) + (L * 4 + 1) * D, ((const float*)ka->in[I_LNB]) + (L * 4 + 1) * D};
                pg8::gemm_phase<pg8::EpiResidH<true, false, false>, pg8::StaticOrder, true, true>(lds + RING_OFF, g, S, E, wave_s);
                SEAM();
            }
            REP(16) if (RUN(16)) { IDS(); const int li = (L * 4 + 2) * D; ln_phase_h<false>(XH, XB, X, ((const float*)ka->in[I_LNG]) + li, ((const float*)ka->in[I_LNB]) + li, (float*)(ws + WS_STATS), gw, NGW, lane); SEAM(); }
        }
}

__global__ void __launch_bounds__(NWAVES * 64, 2) fwd_kernel(Args a) {
    extern __shared__ __attribute__((aligned(16))) unsigned char lds_raw[];
    LAS unsigned char* lds = (LAS unsigned char*)lds_raw;
    volatile LAS unsigned* MISC = (volatile LAS unsigned*)(lds + MISC_OFF);
    const int G = gridDim.x, NGW = G * NWAVES, NT = G * NWAVES * 64, wave_s = __builtin_amdgcn_readfirstlane((int)threadIdx.x >> 6);
    { const int t0 = wave_s * 64 + hw_lane(); for (int u = t0; u < (LDS_BYTES - LDSCTL_OFF) / 4; u += NWAVES * 64) ((LAS unsigned*)(lds + LDSCTL_OFF))[u] = 0u; }
    __syncthreads();
    unsigned* const barw = (unsigned*)((unsigned long long)a.ws + WS_CTL + 4096 * 4);
    XcdBarrier bar; bar.bar = barw; bar.x = 0; bar.st = nullptr; bar.wv = (unsigned)wave_s;
    if (a.single) bar = xcd_barrier_post(barw, MISC + 8, (unsigned)wave_s);
    if (0 >= a.it_lo && 0 < a.it_hi) half_layer<0>(a, lds, bar, G, NGW, NT, wave_s);
    if (1 >= a.it_lo && 1 < a.it_hi) half_layer<1>(a, lds, bar, G, NGW, NT, wave_s);
    if (2 >= a.it_lo && 2 < a.it_hi) half_layer<2>(a, lds, bar, G, NGW, NT, wave_s);
    if (3 >= a.it_lo && 3 < a.it_hi) half_layer<3>(a, lds, bar, G, NGW, NT, wave_s);
    if (4 >= a.it_lo && 4 < a.it_hi) half_layer<4>(a, lds, bar, G, NGW, NT, wave_s);
    if (5 >= a.it_lo && 5 < a.it_hi) half_layer<5>(a, lds, bar, G, NGW, NT, wave_s);
    if (6 >= a.it_lo && 6 < a.it_hi) half_layer<6>(a, lds, bar, G, NGW, NT, wave_s);
    if (7 >= a.it_lo && 7 < a.it_hi) half_layer<7>(a, lds, bar, G, NGW, NT, wave_s);
}
#undef SEAM
#undef RUN

#ifndef MK_SINGLE
#define MK_SINGLE 1
#endif
extern "C" void kernel_launch(void* const* d_in, const int* in_sizes, int n_in, void* d_out, int out_size, void* d_ws, size_t ws_size, hipStream_t stream) {
    static int grid = 0;
    if (grid == 0) {
        if (n_in != 28 || out_size != MTOK * D || ws_size < WS_END) { fprintf(stderr, "kernel_launch: unexpected problem (n_in %d, out %d, ws %zu < %zu); nothing launched\n", n_in, out_size, ws_size, (size_t)WS_END); grid = -1; return; }
        int dev = 0, cus = 0, per_cu = 0;
        if (hipGetDevice(&dev) != hipSuccess || hipDeviceGetAttribute(&cus, hipDeviceAttributeMultiprocessorCount, dev) != hipSuccess) { grid = -1; return; }
        if (hipFuncSetAttribute((const void*)fwd_kernel, hipFuncAttributeMaxDynamicSharedMemorySize, LDS_BYTES) != hipSuccess) { fprintf(stderr, "kernel_launch: hipFuncSetAttribute failed\n"); grid = -1; return; }
        if (hipOccupancyMaxActiveBlocksPerMultiprocessor(&per_cu, (const void*)fwd_kernel, NWAVES * 64, LDS_BYTES) != hipSuccess || per_cu < 1) { fprintf(stderr, "kernel_launch: occupancy query says %d blocks per CU; nothing launched\n", per_cu); (void)hipGetLastError(); grid = -1; return; }
        grid = cus;
    }
    if (grid < 0) return;
    (void)hipMemsetAsync((char*)d_ws + WS_CTL, 0, CTL_ZERO_BYTES, stream);
    Args a{};
    for (int i = 0; i < 28; ++i) a.in[i] = (const GAS float*)d_in[i];
    a.out = (GAS float*)d_out; a.ws = (GAS unsigned char*)d_ws; a.pad = 0;
#if MK_SINGLE
    a.it_lo = 0; a.it_hi = 2 * DEPTH; a.ph_lo = 0; a.ph_hi = 17; a.single = 1;
    hipLaunchKernelGGL(fwd_kernel, dim3(grid), dim3(NWAVES * 64), LDS_BYTES, stream, a);
#else
    a.single = 0;
    for (int it = 0; it < 2 * DEPTH; ++it)
        for (int ph = 0; ph < 17; ++ph) {
            if ((it & 1) && (ph == 0 || ph > 3)) continue;
            a.it_lo = it; a.it_hi = it + 1; a.ph_lo = ph; a.ph_hi = ph + 1;
            hipLaunchKernelGGL(fwd_kernel, dim3(grid), dim3(NWAVES * 64), LDS_BYTES, stream, a);
        }
#endif
}
```

```cpp
#include <hip/hip_runtime.h>
#include <cstdio>
#include <cstdint>
#include <cmath>
constexpr int D = 2048, DFF = 5632, DEPTH = 4;
constexpr int SEQP = 16384, SEQS = 4096, NSAMP = 8, NSEQ = 9;
constexpr int MTOK = SEQP + NSAMP * SEQS;
constexpr int MEML = 256, MMEM = NSEQ * MEML;
constexpr int INC = 10112, NWIN = 10240;
constexpr int RWC = 1920;
constexpr float ALPHA = 1.681792830507429f;
constexpr float LN_EPS = 1e-5f, GN_EPS = 64e-5f;
constexpr int CH = 128;
constexpr int NCP = MTOK / CH;
constexpr float LOG2E = 1.4426950408889634f;
constexpr float ATT_C1 = 0.08838834764831845f * 1.4426950408889634f;

constexpr size_t MiB = 1u << 20;
constexpr size_t WS_CTL = 0, CTL_ZERO_BYTES = 1 * MiB;
constexpr size_t WS_CS = 1 * MiB;
constexpr size_t WS_MEMB = 9 * MiB;
constexpr size_t WS_W1T = 18 * MiB;
constexpr size_t WS_W2T = 106 * MiB;
constexpr size_t WS_WINT = 150 * MiB;
constexpr size_t WS_WBR0 = 190 * MiB;
constexpr size_t WS_WBR1 = 192 * MiB;
constexpr size_t WS_WBR2 = 196 * MiB;
constexpr size_t WS_WOUT = 198 * MiB;
constexpr size_t WS_WQ = 206 * MiB;
constexpr size_t WS_WKV = 208 * MiB;
constexpr size_t WS_WO = 212 * MiB;
constexpr size_t WS_BL = 214 * MiB;
constexpr size_t WS_XB = 216 * MiB;
constexpr size_t WS_RA = 408 * MiB;
constexpr size_t WS_Q = WS_RA;
constexpr size_t WS_K = WS_RA + 96 * MiB;
constexpr size_t WS_VT = WS_RA + 120 * MiB;
constexpr size_t WS_UPOOL = WS_RA + 144 * MiB;
constexpr size_t WS_URWKV = WS_RA + 192 * MiB;
constexpr size_t WS_GATES = WS_RA + 576 * MiB;
constexpr size_t WS_PM = WS_XB;
constexpr size_t WS_QM = WS_XB + 96 * MiB;
constexpr size_t WS_Y = WS_RA + 192 * MiB;
constexpr size_t WS_Z = WS_RA + 384 * MiB;
constexpr size_t WS_H = WS_RA;
constexpr size_t WS_QX = WS_RA;
constexpr size_t WS_KX = WS_RA + 48 * MiB;
constexpr size_t WS_VXT = WS_RA + 51 * MiB;
constexpr size_t WS_OX = WS_RA + 54 * MiB;
constexpr size_t WS_OPOOL = 1560 * MiB;
constexpr size_t WS_OATT = 1608 * MiB;
constexpr size_t WS_ORWKV = 1704 * MiB;
constexpr size_t WS_SH = 1752 * MiB;
constexpr size_t WS_MERGED = WS_SH;
constexpr size_t WS_DIR = 2040 * MiB;
constexpr size_t WS_KBUF = 2616 * MiB;
constexpr size_t WS_SST = WS_KBUF;
constexpr size_t WS_G = 2712 * MiB;
constexpr size_t WS_AL = 2760 * MiB;
constexpr size_t WS_STATS = 2796 * MiB;
constexpr size_t WS_END = 2797 * MiB;
static_assert(WS_GATES + 576 * MiB == WS_OPOOL, "region A");

typedef unsigned short bf16;
namespace pg8 {
#define PG8_LAS __attribute__((address_space(3)))
typedef unsigned short bf16_t;
typedef short bf16x8 __attribute__((ext_vector_type(8)));
typedef float f32x4 __attribute__((ext_vector_type(4)));
typedef unsigned u32x4 __attribute__((ext_vector_type(4)));
constexpr int BM = 256, BK = 64, HALF = 128, HTB = HALF * BK * 2  , STAGE_BYTES = 8 * HTB, NXCD = 8, WGM = 8;

__host__ __device__ __forceinline__ int lds_byte(int r, int c) { const int st = (r >> 4) * 2 + (c >> 5), rr = r & 15, cc = c & 31, ob = rr * 64 + cc * 2; return st * 1024 + (ob ^ (((ob >> 9) & 1) << 5)); }
__host__ __device__ __forceinline__ void stage_rc(int b, int& R, int& C) { const int st = b / 1024, sb = b % 1024, swz = sb ^ (((sb >> 9) & 1) << 5); R = (st >> 1) * 16 + swz / 64; C = (st & 1) * 32 + (swz % 64) / 2; }
__host__ __device__ __forceinline__ int perm32(int rho) { const int n = rho >> 4, i = rho & 15; return 8 * (i >> 2) + 4 * n + (i & 3); }

struct Unit { int pm, pn; };
struct Gemm { const bf16_t* A; const bf16_t* Bt; int M, N, K; };

struct StaticOrder {
    int nM, nN, nwg, G, c, wgm;
    __host__ __device__ void init(int M, int N, int G_, int c_, int wgm_ = WGM) { nM = M / BM; nN = N / BM; nwg = nM * nN; G = G_; c = c_; wgm = wgm_; }
    __host__ __device__ bool next(int i, Unit& u) const {
        const long L = (long)i * G + c; if (L >= nwg) return false;
        int wgid = (int)L; { const int q = nwg / NXCD, r = nwg % NXCD, xcd = wgid % NXCD, off = wgid / NXCD; wgid = (xcd < r ? xcd * (q + 1) : r * (q + 1) + (xcd - r) * q) + off; }
        const int nig = wgm * nN, gid = wgid / nig, fm = gid * wgm, gsz = (nM - fm) < wgm ? (nM - fm) : wgm;
        u.pm = fm + ((wgid % nig) % gsz); u.pn = (wgid % nig) / gsz; return true;
    }
    __device__ __forceinline__ void a_ready(const Unit&) const {}
    __device__ __forceinline__ void done(const Unit&) const {}
};

__device__ __forceinline__ unsigned cvt_pk_bf16(float lo, float hi) { unsigned r; asm volatile("v_cvt_pk_bf16_f32 %0, %1, %2" : "=v"(r) : "v"(lo), "v"(hi)); return r; }
typedef float f32x2 __attribute__((ext_vector_type(2)));
typedef unsigned u32x2 __attribute__((ext_vector_type(2)));
__device__ __forceinline__ int lane_now() { int l; asm volatile("v_mbcnt_lo_u32_b32 %0, -1, 0\n\tv_mbcnt_hi_u32_b32 %0, -1, %0" : "=v"(l)); return l; }
__device__ __forceinline__ float sigm(float x) { return __builtin_amdgcn_rcpf(1.f + __builtin_amdgcn_exp2f(-x * LOG2E)); }
__device__ __forceinline__ float bf_lo(unsigned w) { return __uint_as_float(w << 16); }
__device__ __forceinline__ float bf_hi(unsigned w) { return __uint_as_float(w & 0xffff0000u); }

struct EpiSwiglu {
    static constexpr bool PERM = true, AFTER_DRAIN = false;
    bf16_t* H;
    __device__ __forceinline__ void operator()(const f32x4 (&acc)[2][2][4][2], const Unit& u, int wr, int wc, int, int) const {
        const int ln_ = lane_now(), fr = ln_ & 15, fq = ln_ >> 4;
        const int row0 = u.pm * BM + wr * 64 + fr, col0 = u.pn * 128 + wc * 32 + 8 * fq;
#pragma unroll
        for (int ai = 0; ai < 2; ++ai)
#pragma unroll
            for (int m = 0; m < 4; ++m) {
                bf16_t* rowp = H + (size_t)(row0 + ai * HALF + m * 16) * DFF + col0;
                float o[8];
#pragma unroll
                for (int n = 0; n < 2; ++n)
#pragma unroll
                    for (int e = 0; e < 4; ++e) { const float g = acc[ai][0][m][n][e], up = acc[ai][1][m][n][e]; o[4 * n + e] = g * sigm(g) * up; }
                u32x4 w; w.x = cvt_pk_bf16(o[0], o[1]); w.y = cvt_pk_bf16(o[2], o[3]); w.z = cvt_pk_bf16(o[4], o[5]); w.w = cvt_pk_bf16(o[6], o[7]);
                __builtin_nontemporal_store(w, (u32x4*)rowp);
            }
    }
};
template <bool NORM, bool HALFSC> struct EpiResid {
    static constexpr bool PERM = false, AFTER_DRAIN = false;
    float* X; const float* stats; const float* g; const float* b;
    __device__ __forceinline__ void operator()(const f32x4 (&acc)[2][2][4][2], const Unit& u, int wr, int wc, int, int) const {
        const int ln_ = lane_now(), fr = ln_ & 15, fq = ln_ >> 4;
        const int row0 = u.pm * BM + wr * 64 + fr, col0 = u.pn * BM + wc * 32 + 4 * fq;
        float* const Xp = X; const float al = ALPHA, sc = HALFSC ? 0.5f : 1.f; const float* const stp = stats; const float* const gp = g + col0; const float* const bp = b + col0;
        f32x4 gg[2][2], bb[2][2]; f32x2 st_[2][4];
        if (NORM) {
#pragma unroll
            for (int bj = 0; bj < 2; ++bj)
#pragma unroll
                for (int n = 0; n < 2; ++n) { gg[bj][n] = *(const f32x4*)(gp + bj * HALF + n * 16); bb[bj][n] = *(const f32x4*)(bp + bj * HALF + n * 16); }
#pragma unroll
            for (int ai = 0; ai < 2; ++ai)
#pragma unroll
                for (int m = 0; m < 4; ++m) st_[ai][m] = *(const f32x2*)(stp + 2 * (size_t)(row0 + ai * HALF + m * 16));
        }
#pragma unroll
        for (int ai = 0; ai < 2; ++ai)
#pragma unroll
            for (int m = 0; m < 4; ++m) {
                const int row = row0 + ai * HALF + m * 16;
                float* rowp = Xp + (size_t)row * D + col0;
#pragma unroll
                for (int bj = 0; bj < 2; ++bj)
#pragma unroll
                    for (int n = 0; n < 2; ++n) { f32x4* p = (f32x4*)(rowp + bj * HALF + n * 16); f32x4 x;
                        if (NORM) { x = *p; x = (x - st_[ai][m].x) * st_[ai][m].y * gg[bj][n] + bb[bj][n]; }
                        else x = *(const f32x4*)((row < SEQP ? gp + (size_t)row * D : bp + (size_t)(row - SEQP) * D) + bj * HALF + n * 16);
                        *p = x * al + acc[ai][bj][m][n] * sc; }
                if (m & 1) asm volatile("" ::: "memory");
            }
    }
};
typedef _Float16 f16x2_t __attribute__((ext_vector_type(2)));
__device__ __forceinline__ f32x2 h2f(unsigned w) { const f16x2_t h = __builtin_bit_cast(f16x2_t, w); return (f32x2){(float)h[0], (float)h[1]}; }
__device__ __forceinline__ unsigned f2h(float a, float b) { f16x2_t h; h[0] = (_Float16)__builtin_amdgcn_fmed3f(a, -65504.f, 65504.f); h[1] = (_Float16)__builtin_amdgcn_fmed3f(b, -65504.f, 65504.f);
    return __builtin_bit_cast(unsigned, h); }
template <bool NORM, bool HALFSC, bool LAST> struct EpiResidH {
    static constexpr bool PERM = true, AFTER_DRAIN = false;
    unsigned short* XH; unsigned short* XF; const float* stats; const float* g; const float* b;
    __device__ __forceinline__ void operator()(const f32x4 (&acc)[2][2][4][2], const Unit& u, int wr, int wc, int, int) const {
        const int ln_ = lane_now(), fr = ln_ & 15, fq = ln_ >> 4;
        const int row0 = u.pm * BM + wr * 64 + fr, col0 = u.pn * BM + wc * 32 + 8 * fq;
        unsigned short* const Xp = XH; unsigned short* const Fp = XF; const float al = ALPHA, sc = HALFSC ? 0.5f : 1.f; const float* const stp = stats; const float* const gp = g + col0; const float* const bp = b + col0;
        f32x4 gg[2][2], bb[2][2]; f32x2 st_[2][4];
        if (NORM) {
#pragma unroll
            for (int bj = 0; bj < 2; ++bj)
#pragma unroll
                for (int n = 0; n < 2; ++n) { gg[bj][n] = *(const f32x4*)(gp + bj * HALF + n * 4); bb[bj][n] = *(const f32x4*)(bp + bj * HALF + n * 4); }
#pragma unroll
            for (int ai = 0; ai < 2; ++ai)
#pragma unroll
                for (int m = 0; m < 4; ++m) st_[ai][m] = *(const f32x2*)(stp + 2 * (size_t)(row0 + ai * HALF + m * 16));
        }
#pragma unroll
        for (int ai = 0; ai < 2; ++ai) {
            u32x4 hv[4][2];
            if (NORM) {
#pragma unroll
                for (int m = 0; m < 4; ++m)
#pragma unroll
                    for (int bj = 0; bj < 2; ++bj) hv[m][bj] = *(const u32x4*)(Xp + (size_t)(row0 + ai * HALF + m * 16) * D + col0 + bj * HALF);
                asm volatile("" ::: "memory");
            }
#pragma unroll
            for (int m = 0; m < 4; ++m) {
                const int row = row0 + ai * HALF + m * 16;
                unsigned short* rowp = Xp + (size_t)row * D + col0;
                f32x4 xi[2][2];
                if (!NORM) {
#pragma unroll
                    for (int bj = 0; bj < 2; ++bj) { const float* src = (row < SEQP ? gp + (size_t)row * D : bp + (size_t)(row - SEQP) * D) + bj * HALF; xi[bj][0] = *(const f32x4*)src; xi[bj][1] = *(const f32x4*)(src + 4); }
                    if (m & 1) asm volatile("" ::: "memory"); }
#pragma unroll
                for (int bj = 0; bj < 2; ++bj) { f32x4 x0, x1;
                    if (NORM) { const u32x4 h4 = hv[m][bj]; const f32x2 a0 = h2f(h4.x), a1 = h2f(h4.y), a2 = h2f(h4.z), a3 = h2f(h4.w);
                        x0 = ((f32x4){a0.x, a0.y, a1.x, a1.y} - st_[ai][m].x) * st_[ai][m].y * gg[bj][0] + bb[bj][0];
                        x1 = ((f32x4){a2.x, a2.y, a3.x, a3.y} - st_[ai][m].x) * st_[ai][m].y * gg[bj][1] + bb[bj][1]; }
                    else { x0 = xi[bj][0]; x1 = xi[bj][1]; }
                    const f32x4 o0 = x0 * al + acc[ai][bj][m][0] * sc, o1 = x1 * al + acc[ai][bj][m][1] * sc;
                    u32x4 w; w.x = f2h(o0[0], o0[1]); w.y = f2h(o0[2], o0[3]); w.z = f2h(o1[0], o1[1]); w.w = f2h(o1[2], o1[3]);
                    *(u32x4*)((LAST ? Fp + (size_t)row * D + col0 : rowp) + bj * HALF) = w; }
            }
            asm volatile("" ::: "memory");
        }
    }
};
struct EpiPlain {
    static constexpr bool PERM = true, AFTER_DRAIN = false;
    bf16_t* O; int ldc;
    __device__ __forceinline__ void operator()(const f32x4 (&acc)[2][2][4][2], const Unit& u, int wr, int wc, int, int) const {
        const int ln_ = lane_now(), fr = ln_ & 15, fq = ln_ >> 4;
        const int row0 = u.pm * BM + wr * 64 + fr, col0 = u.pn * BM + wc * 32 + 8 * fq;
#pragma unroll
        for (int ai = 0; ai < 2; ++ai)
#pragma unroll
            for (int m = 0; m < 4; ++m) {
                bf16_t* rowp = O + (size_t)(row0 + ai * HALF + m * 16) * ldc + col0;
#pragma unroll
                for (int bj = 0; bj < 2; ++bj) { const f32x4 v0 = acc[ai][bj][m][0], v1 = acc[ai][bj][m][1];
                    u32x4 w; w.x = cvt_pk_bf16(v0[0], v0[1]); w.y = cvt_pk_bf16(v0[2], v0[3]); w.z = cvt_pk_bf16(v1[0], v1[1]); w.w = cvt_pk_bf16(v1[2], v1[3]);
                    *(u32x4*)(rowp + bj * HALF) = w; }
            }
    }
};
struct EpiWin {
    static constexpr bool PERM = true, AFTER_DRAIN = false;
    bf16_t *UP, *Q, *K, *GT; float* UR; const float* CS; bf16_t* VT;
    __device__ __forceinline__ void operator()(const f32x4 (&acc)[2][2][4][2], const Unit& u, int wr, int wc, int, int) const {
        const int ln_ = lane_now(), fr = ln_ & 15, fq = ln_ >> 4;
        const int pn = u.pn, row0 = u.pm * BM + wr * 64 + fr, c8 = wc * 32 + 8 * fq;
        if (pn == 7) {
#pragma unroll
            for (int ai = 0; ai < 2; ++ai)
#pragma unroll
                for (int m = 0; m < 4; ++m) { const int row = row0 + ai * HALF + m * 16;
#pragma unroll
                    for (int bj = 0; bj < 2; ++bj)
#pragma unroll
                        for (int n = 0; n < 2; ++n) { const f32x4 v = acc[ai][bj][m][n]; const unsigned w01 = cvt_pk_bf16(v[0], v[1]), w23 = cvt_pk_bf16(v[2], v[3]);
                            bf16_t* dst = VT + (size_t)(bj * 128 + c8 + 4 * n) * MTOK + row;
                            dst[0] = (bf16_t)(w01 & 0xffffu); dst[MTOK] = (bf16_t)(w01 >> 16); dst[2 * (size_t)MTOK] = (bf16_t)(w23 & 0xffffu); dst[3 * (size_t)MTOK] = (bf16_t)(w23 >> 16); } }
            return;
        }
#pragma unroll
        for (int ai = 0; ai < 2; ++ai)
#pragma unroll
            for (int m = 0; m < 4; ++m) {
                const int row = row0 + ai * HALF + m * 16;
                if (pn >= 2 && pn < 7) {
                    const int pos = row < SEQP ? row : (row & (SEQS - 1));
                    const f32x4* csp = (const f32x4*)(CS + ((size_t)pos * 64 + 4 * (4 * wc + fq)) * 2);
                    const f32x4 c01 = csp[0], c23 = csp[1];
                    const float cs_[4] = {c01[0], c01[2], c23[0], c23[2]}, sn_[4] = {c01[1], c01[3], c23[1], c23[3]};
#pragma unroll
                    for (int bj = 0; bj < 2; ++bj) {
                        const f32x4 t1 = acc[ai][bj][m][0], t2 = acc[ai][bj][m][1]; float o1[4], o2[4];
#pragma unroll
                        for (int e = 0; e < 4; ++e) { o1[e] = t1[e] * cs_[e] - t2[e] * sn_[e]; o2[e] = t2[e] * cs_[e] + t1[e] * sn_[e]; }
                        u32x4 w; w.x = cvt_pk_bf16(o1[0], o1[1]); w.y = cvt_pk_bf16(o1[2], o1[3]); w.z = cvt_pk_bf16(o2[0], o2[1]); w.w = cvt_pk_bf16(o2[2], o2[3]);
                        bf16_t* dst = (pn == 6) ? K + (size_t)row * 256 + bj * 128 + c8 : Q + (size_t)row * 1024 + ((pn - 2) * 2 + bj) * 128 + c8;
                        __builtin_nontemporal_store(w, (u32x4*)dst);
                    }
                } else if (pn >= 8 && pn < 16) {
#pragma unroll
                    for (int bj = 0; bj < 2; ++bj) { float* p = UR + (size_t)row * 2048 + (pn - 8) * 256 + bj * 128 + c8; __builtin_nontemporal_store(acc[ai][bj][m][0], (f32x4*)p); __builtin_nontemporal_store(acc[ai][bj][m][1], (f32x4*)(p + 4)); }
                } else {
#pragma unroll
                    for (int bj = 0; bj < 2; ++bj) {
                        f32x4 v0 = acc[ai][bj][m][0], v1 = acc[ai][bj][m][1]; bf16_t* dst;
                        if (pn < 2) dst = UP + (size_t)row * 512 + pn * 256 + bj * 128 + c8;
                        else { dst = GT + (size_t)row * 6144 + (pn - 16) * 256 + bj * 128 + c8;
#pragma unroll
                            for (int e = 0; e < 4; ++e) { v0[e] = sigm(v0[e]); v1[e] = sigm(v1[e]); } }
                        u32x4 w; w.x = cvt_pk_bf16(v0[0], v0[1]); w.y = cvt_pk_bf16(v0[2], v0[3]); w.z = cvt_pk_bf16(v1[0], v1[1]); w.w = cvt_pk_bf16(v1[2], v1[3]);
                        __builtin_nontemporal_store(w, (u32x4*)dst);
                    }
                }
                asm volatile("" ::: "memory");
            }
    }
};
struct EpiBranch {
    static constexpr bool PERM = true, AFTER_DRAIN = false;
    bf16_t* MG; const bf16_t* GT; int first;
    __device__ __forceinline__ void operator()(const f32x4 (&acc)[2][2][4][2], const Unit& u, int wr, int wc, int, int) const {
        const int ln_ = lane_now(), fr = ln_ & 15, fq = ln_ >> 4;
        const int row0 = u.pm * BM + wr * 64 + fr, col0 = u.pn * BM + wc * 32 + 8 * fq;
#pragma unroll
        for (int ai = 0; ai < 2; ++ai) {
            u32x4 gwv[4][2], mwv[4][2];
#pragma unroll
            for (int m = 0; m < 4; ++m)
#pragma unroll
                for (int bj = 0; bj < 2; ++bj) { const int row = row0 + ai * HALF + m * 16, col = col0 + bj * HALF;
                    gwv[m][bj] = __builtin_nontemporal_load((const u32x4*)(GT + (size_t)row * 6144 + col));
                    mwv[m][bj] = first ? (u32x4){0u, 0u, 0u, 0u} : *(const u32x4*)(MG + (size_t)row * D + col); }
            asm volatile("" ::: "memory");
#pragma unroll
            for (int m = 0; m < 4; ++m)
#pragma unroll
                for (int bj = 0; bj < 2; ++bj) { const int row = row0 + ai * HALF + m * 16, col = col0 + bj * HALF;
                    const u32x4 gw = gwv[m][bj], mw = mwv[m][bj]; const f32x4 v0 = acc[ai][bj][m][0], v1 = acc[ai][bj][m][1];
                    u32x4 w;
                    w.x = cvt_pk_bf16(bf_lo(mw.x) + bf_lo(gw.x) * v0[0], bf_hi(mw.x) + bf_hi(gw.x) * v0[1]);
                    w.y = cvt_pk_bf16(bf_lo(mw.y) + bf_lo(gw.y) * v0[2], bf_hi(mw.y) + bf_hi(gw.y) * v0[3]);
                    w.z = cvt_pk_bf16(bf_lo(mw.z) + bf_lo(gw.z) * v1[0], bf_hi(mw.z) + bf_hi(gw.z) * v1[1]);
                    w.w = cvt_pk_bf16(bf_lo(mw.w) + bf_lo(gw.w) * v1[2], bf_hi(mw.w) + bf_hi(gw.w) * v1[3]);
                    *(u32x4*)(MG + (size_t)row * D + col) = w; }
            asm volatile("" ::: "memory");
        }
    }
};
struct EpiLora {
    static constexpr bool PERM = false, AFTER_DRAIN = false;
    const float *w0, *a0, *k_a; const float* SH; const float* KB; float* DIR; bf16_t* G;
    __device__ __forceinline__ void operator()(const f32x4 (&acc)[2][2][4][2], const Unit& u, int wr, int wc, int, int) const {
        const int ln_ = lane_now(), fr = ln_ & 15, fq = ln_ >> 4;
        const int pn = u.pn, row0 = u.pm * BM + wr * 64 + fr, cq = wc * 32 + 4 * fq;
        const int ed = (pn >> 1) & 1;
        if (pn < 4) {
            f32x4 bv[2][2];
#pragma unroll
            for (int bj = 0; bj < 2; ++bj)
#pragma unroll
                for (int n = 0; n < 2; ++n) bv[bj][n] = *(const f32x4*)(w0 + ed * 512 + ((pn * BM + bj * HALF + cq + 16 * n) & 511));
#pragma unroll
            for (int ai = 0; ai < 2; ++ai)
#pragma unroll
                for (int m = 0; m < 4; ++m) {
                    const int row = row0 + ai * HALF + m * 16;
#pragma unroll
                    for (int bj = 0; bj < 2; ++bj)
#pragma unroll
                        for (int n = 0; n < 2; ++n) {
                            const int ch = (pn * BM + bj * HALF + cq + 16 * n) & 511, hh = ch >> 6, j = ch & 63; const f32x4 v = acc[ai][bj][m][n], b = bv[bj][n]; f32x4 o;
#pragma unroll
                            for (int e = 0; e < 4; ++e) { const float x = -(b[e] + v[e]);
                                const float sp = fmaxf(x, 0.f) + 0.6931471805599453f * __builtin_amdgcn_logf(1.f + __builtin_amdgcn_exp2f(-fabsf(x) * LOG2E));
                                o[e] = __builtin_amdgcn_exp2f(-LOG2E * __builtin_amdgcn_exp2f((-sp - 0.5f) * LOG2E)); }
                            *(f32x4*)(DIR + (((size_t)row * 2 + ed) * 8 + hh) * 192 + j) = o;
                        }
                    asm volatile("" ::: "memory");
                }
        } else if (pn < 8) {
            f32x4 bv[2][2], kav[2][2];
#pragma unroll
            for (int bj = 0; bj < 2; ++bj)
#pragma unroll
                for (int n = 0; n < 2; ++n) { const int ch = (pn * BM + bj * HALF + cq + 16 * n) & 511; bv[bj][n] = *(const f32x4*)(a0 + ed * 512 + ch); kav[bj][n] = *(const f32x4*)(k_a + ch); }
#pragma unroll
            for (int ai = 0; ai < 2; ++ai)
#pragma unroll
                for (int m = 0; m < 4; ++m) {
                    const int row = row0 + ai * HALF + m * 16;
                    f32x4 nkv[2][2], kkv[2][2];
#pragma unroll
                    for (int bj = 0; bj < 2; ++bj)
#pragma unroll
                        for (int n = 0; n < 2; ++n) { const int ch = (pn * BM + bj * HALF + cq + 16 * n) & 511;
                            nkv[bj][n] = *(const f32x4*)(SH + ((size_t)row * 8 + (ch >> 6)) * 192 + (ch & 63)); kkv[bj][n] = *(const f32x4*)(KB + (size_t)row * 512 + ch); }
                    asm volatile("" ::: "memory");
#pragma unroll
                    for (int bj = 0; bj < 2; ++bj)
#pragma unroll
                        for (int n = 0; n < 2; ++n) {
                            const int ch = (pn * BM + bj * HALF + cq + 16 * n) & 511, hh = ch >> 6, j = ch & 63; const f32x4 v = acc[ai][bj][m][n], b = bv[bj][n], ka = kav[bj][n], nk = nkv[bj][n], kk_ = kkv[bj][n];
                            float* dp = DIR + (((size_t)row * 2 + ed) * 8 + hh) * 192 + j; f32x4 o1, o2;
#pragma unroll
                            for (int e = 0; e < 4; ++e) { const float a = sigm(b[e] + v[e]); o1[e] = -nk[e] * a; o2[e] = kk_[e] * (1.f + (a - 1.f) * ka[e]); }
                            *(f32x4*)(dp + 64) = o1; *(f32x4*)(dp + 128) = o2;
                        }
                    asm volatile("" ::: "memory");
                }
        } else {
#pragma unroll
            for (int ai = 0; ai < 2; ++ai)
#pragma unroll
                for (int m = 0; m < 4; ++m) {
                    const int row = row0 + ai * HALF + m * 16;
#pragma unroll
                    for (int bj = 0; bj < 2; ++bj)
#pragma unroll
                        for (int n = 0; n < 2; ++n) { const int c = pn * BM + bj * HALF + cq + 16 * n; const f32x4 v = acc[ai][bj][m][n];
                            u32x2 w; w.x = cvt_pk_bf16(v[0], v[1]); w.y = cvt_pk_bf16(v[2], v[3]);
                            *(u32x2*)(G + (size_t)row * 512 + (c - 2048)) = w; }
                    asm volatile("" ::: "memory");
                }
        }
    }
};

constexpr int XQ_UNITS = 420;
struct XqOrder {
    int G, c;
    __device__ __forceinline__ bool next(int i, Unit& u) const {
        const int L = i * G + c; if (L >= XQ_UNITS) return false;
        if (L < 384) { u.pm = (int)(WS_XB >> 20) + (L >> 1); u.pn = (int)(WS_WQ >> 20) + (L & 1); }
        else if (L < 402) { const int t = L - 384; u.pm = (int)(WS_MEMB >> 20) + (t >> 1); u.pn = (int)(WS_WKV >> 20) + (t & 1); }
        else { const int t = L - 402; u.pm = (int)(WS_WKV >> 20) + 2 + t / 9; u.pn = (int)(WS_MEMB >> 20) + t % 9; }
        return true;
    }
    __device__ __forceinline__ void a_ready(const Unit&) const {}
    __device__ __forceinline__ void done(const Unit&) const {}
};
struct EpiXq {
    static constexpr bool PERM = true, AFTER_DRAIN = false;
    bf16_t *QX, *KX, *VXT;
    __device__ __forceinline__ void operator()(const f32x4 (&acc)[2][2][4][2], const Unit& u, int wr, int wc, int, int) const {
        const int ln_ = lane_now(), fr = ln_ & 15, fq = ln_ >> 4;
        bf16_t* O; int ldc, tm, tn;
        if (u.pm >= (int)(WS_XB >> 20)) { O = QX; ldc = 512; tm = u.pm - (int)(WS_XB >> 20); tn = u.pn - (int)(WS_WQ >> 20); }
        else if (u.pm < (int)(WS_WKV >> 20)) { O = KX; ldc = 512; tm = u.pm - (int)(WS_MEMB >> 20); tn = u.pn - (int)(WS_WKV >> 20); }
        else { O = VXT; ldc = MMEM; tm = u.pm - (int)(WS_WKV >> 20) - 2; tn = u.pn - (int)(WS_MEMB >> 20); }
        const int row0 = tm * BM + wr * 64 + fr, col0 = tn * BM + wc * 32 + 8 * fq;
#pragma unroll
        for (int ai = 0; ai < 2; ++ai)
#pragma unroll
            for (int m = 0; m < 4; ++m) {
                bf16_t* rowp = O + (size_t)(row0 + ai * HALF + m * 16) * ldc + col0;
#pragma unroll
                for (int bj = 0; bj < 2; ++bj) { const f32x4 v0 = acc[ai][bj][m][0], v1 = acc[ai][bj][m][1];
                    u32x4 w; w.x = cvt_pk_bf16(v0[0], v0[1]); w.y = cvt_pk_bf16(v0[2], v0[3]); w.z = cvt_pk_bf16(v1[0], v1[1]); w.w = cvt_pk_bf16(v1[2], v1[3]);
                    *(u32x4*)(rowp + bj * HALF) = w; }
            }
    }
};
template <class Epi, class Sched, bool ALIGN_EPI = false, bool SP2 = false>
__device__ __forceinline__ void gemm_phase(PG8_LAS unsigned char* lds, const Gemm g, const Sched& S, const Epi E, int wid_in) {
    int lane_o; asm volatile("v_mbcnt_lo_u32_b32 %0, -1, 0\n\tv_mbcnt_hi_u32_b32 %0, -1, %0" : "=v"(lane_o));
    const int wid = wid_in, lane = lane_o, tid = wid * 64 + lane, wr = wid >> 2, wc = wid & 3, fr = lane & 15, fq = lane >> 4;
    const int K = g.K, nt = K / BK;
    unsigned voffA[2], voffB[2];
#pragma unroll
    for (int i = 0; i < 2; ++i) { int R, C; stage_rc(tid * 16 + i * 8192, R, C); const int Rb = Epi::PERM ? ((R & ~31) + perm32(R & 31)) : R;
        voffA[i] = (unsigned)(R * K + C) * 2u; voffB[i] = (unsigned)(Rb * K + C) * 2u; }
    const size_t kstep = (size_t)(BK * 2);
    const size_t hstep = (size_t)HALF * K * 2;
    const size_t tstep = 2 * hstep;
    const unsigned ldsw = (unsigned)wid * 1024u;
    const int aoff = lds_byte(wr * 64 + fr, fq * 8), boff = lds_byte(wc * 32 + fr, fq * 8);
#define PG8_SA(b, h) (((b) * 2 + (h)) * HTB)
#define PG8_SB(b, h) ((4 + (b) * 2 + (h)) * HTB)
#define PG8_STAGE(bufoff, gbase, voff) do { _Pragma("unroll") for (int _i = 0; _i < 2; ++_i) \
        __builtin_amdgcn_global_load_lds((const unsigned*)((const char*)(gbase) + (voff)[_i]), (PG8_LAS unsigned*)(lds + (bufoff) + ldsw + _i * 8192), 16, 0, 0); } while (0)
#define PG8_LDA(dst, b, h) do { _Pragma("unroll") for (int m = 0; m < 4; ++m) _Pragma("unroll") for (int k = 0; k < 2; ++k) dst[m][k] = *(const PG8_LAS bf16x8*)(lds + PG8_SA(b, h) + aoff + m * 2048 + k * 1024); } while (0)
#define PG8_LDB(dst, b, h) do { _Pragma("unroll") for (int n = 0; n < 2; ++n) _Pragma("unroll") for (int k = 0; k < 2; ++k) dst[n][k] = *(const PG8_LAS bf16x8*)(lds + PG8_SB(b, h) + boff + n * 2048 + k * 1024); } while (0)
#define PG8_MMA(ai, bj, At, Bt) do { __builtin_amdgcn_s_setprio(1); _Pragma("unroll") for (int m = 0; m < 4; ++m) _Pragma("unroll") for (int n = 0; n < 2; ++n) _Pragma("unroll") for (int k = 0; k < 2; ++k) \
        acc[ai][bj][m][n] = __builtin_amdgcn_mfma_f32_16x16x32_bf16(Bt[n][k], At[m][k], acc[ai][bj][m][n], 0, 0, 0); __builtin_amdgcn_s_setprio(0); } while (0)
#define PG8_WAIT_V(n) asm volatile("s_waitcnt vmcnt(" #n ")" ::: "memory")
#define PG8_WAIT_L(n) asm volatile("s_waitcnt lgkmcnt(" #n ")" ::: "memory")
#define PG8_BAR __builtin_amdgcn_s_barrier()
#define PG8_SCHED __builtin_amdgcn_sched_barrier(0)
    Unit cur, nxt; int ui = 0;
    if (!S.next(0, cur)) return;
    f32x4 acc[2][2][4][2];
#pragma unroll
    for (int a = 0; a < 2; ++a)
#pragma unroll
        for (int b = 0; b < 2; ++b)
#pragma unroll
            for (int m = 0; m < 4; ++m)
#pragma unroll
                for (int n = 0; n < 2; ++n) acc[a][b][m][n] = (f32x4){0.f, 0.f, 0.f, 0.f};
    bf16x8 At[4][2], B0[2][2], B1[2][2];
    const char* cA = (const char*)g.A + (size_t)cur.pm * tstep; const char* cB = (const char*)g.Bt + (size_t)cur.pn * tstep;
    S.a_ready(cur);
    if constexpr (SP2) {
        PG8_STAGE(PG8_SB(0, 0), cB, voffB); PG8_STAGE(PG8_SB(0, 1), cB + hstep, voffB); PG8_STAGE(PG8_SA(0, 0), cA, voffA); PG8_STAGE(PG8_SA(0, 1), cA + hstep, voffA);
        if (wr == 1) PG8_BAR;
        PG8_WAIT_V(2); PG8_BAR;
        PG8_STAGE(PG8_SB(1, 0), cB + kstep, voffB); PG8_STAGE(PG8_SA(1, 0), cA + kstep, voffA); PG8_STAGE(PG8_SB(1, 1), cB + hstep + kstep, voffB);
        PG8_WAIT_V(6); PG8_BAR;
    } else {
        PG8_STAGE(PG8_SB(0, 0), cB, voffB); PG8_STAGE(PG8_SA(0, 0), cA, voffA); PG8_STAGE(PG8_SB(0, 1), cB + hstep, voffB); PG8_STAGE(PG8_SA(0, 1), cA + hstep, voffA);
        if (wr == 1) PG8_BAR;
        PG8_WAIT_V(4); PG8_BAR;
        PG8_STAGE(PG8_SB(1, 0), cB + kstep, voffB); PG8_STAGE(PG8_SA(1, 0), cA + kstep, voffA); PG8_STAGE(PG8_SB(1, 1), cB + hstep + kstep, voffB);
        PG8_WAIT_V(6); PG8_BAR;
    }
    for (;;) {
        const bool has_next = S.next(ui + 1, nxt);
        const char* nA = has_next ? (const char*)g.A + (size_t)nxt.pm * tstep : cA; const char* nB = has_next ? (const char*)g.Bt + (size_t)nxt.pn * tstep : cB;
        for (int t = 0; t < nt; t += 2) {
            const bool last = (t == nt - 2);
            const char* a1 = cA + (size_t)(t + 1) * kstep;
            const char* a2 = last ? nA : cA + (size_t)(t + 2) * kstep; const char* b2 = last ? nB : cB + (size_t)(t + 2) * kstep;
            const char* a3 = a2 + kstep; const char* b3 = b2 + kstep;
            if (last && has_next) S.a_ready(nxt);
            if constexpr (SP2) {
            PG8_LDB(B0, 0, 0); PG8_LDB(B1, 0, 1); PG8_SCHED; PG8_LDA(At, 0, 0); PG8_STAGE(PG8_SA(1, 1), a1 + hstep, voffA);
            PG8_WAIT_V(8); PG8_WAIT_L(0); PG8_BAR; PG8_MMA(0, 0, At, B0); PG8_MMA(0, 1, At, B1); PG8_BAR; PG8_SCHED;
            PG8_LDA(At, 0, 1); PG8_STAGE(PG8_SB(0, 0), b2, voffB); PG8_STAGE(PG8_SB(0, 1), b2 + hstep, voffB); PG8_STAGE(PG8_SA(0, 0), a2, voffA);
            PG8_WAIT_V(8); PG8_WAIT_L(0); PG8_BAR; PG8_MMA(1, 0, At, B0); PG8_MMA(1, 1, At, B1); PG8_BAR; PG8_SCHED;
            PG8_LDB(B0, 1, 0); PG8_LDB(B1, 1, 1); PG8_SCHED; PG8_LDA(At, 1, 0); PG8_STAGE(PG8_SA(0, 1), a2 + hstep, voffA);
            PG8_WAIT_V(8); PG8_WAIT_L(0); PG8_BAR; PG8_MMA(0, 0, At, B0); PG8_MMA(0, 1, At, B1); PG8_BAR; PG8_SCHED;
            PG8_LDA(At, 1, 1); PG8_STAGE(PG8_SB(1, 0), b3, voffB); PG8_STAGE(PG8_SB(1, 1), b3 + hstep, voffB); PG8_STAGE(PG8_SA(1, 0), a3, voffA);
            PG8_WAIT_V(8); PG8_WAIT_L(0); PG8_BAR; PG8_MMA(1, 0, At, B0); PG8_MMA(1, 1, At, B1); PG8_BAR; PG8_SCHED;
            } else {
            PG8_LDB(B0, 0, 0); PG8_SCHED; PG8_LDA(At, 0, 0); PG8_STAGE(PG8_SA(1, 1), a1 + hstep, voffA);
            PG8_WAIT_L(8); PG8_BAR; PG8_WAIT_L(0); PG8_MMA(0, 0, At, B0); PG8_BAR; PG8_SCHED;
            PG8_LDB(B1, 0, 1); PG8_STAGE(PG8_SB(0, 0), b2, voffB);
            PG8_BAR; PG8_WAIT_L(0); PG8_MMA(0, 1, At, B1); PG8_BAR;
            PG8_LDA(At, 0, 1); PG8_STAGE(PG8_SA(0, 0), a2, voffA);
            PG8_BAR; PG8_WAIT_L(0); PG8_MMA(1, 0, At, B0); PG8_BAR; PG8_SCHED;
            PG8_STAGE(PG8_SB(0, 1), b2 + hstep, voffB);
            PG8_WAIT_V(6); PG8_BAR; PG8_MMA(1, 1, At, B1); PG8_BAR;
            PG8_LDB(B0, 1, 0); PG8_SCHED; PG8_LDA(At, 1, 0); PG8_STAGE(PG8_SA(0, 1), a2 + hstep, voffA);
            PG8_WAIT_L(8); PG8_BAR; PG8_WAIT_L(0); PG8_MMA(0, 0, At, B0); PG8_BAR; PG8_SCHED;
            PG8_LDB(B1, 1, 1); PG8_STAGE(PG8_SB(1, 0), b3, voffB);
            PG8_BAR; PG8_WAIT_L(0); PG8_MMA(0, 1, At, B1); PG8_BAR;
            PG8_LDA(At, 1, 1); PG8_STAGE(PG8_SA(1, 0), a3, voffA);
            PG8_BAR; PG8_WAIT_L(0); PG8_MMA(1, 0, At, B0); PG8_BAR; PG8_SCHED;
            PG8_STAGE(PG8_SB(1, 1), b3 + hstep, voffB);
            PG8_WAIT_V(6); PG8_BAR; PG8_MMA(1, 1, At, B1); PG8_BAR;
            }
        }
        if constexpr (ALIGN_EPI) { if (wr == 0) PG8_BAR; }
        if constexpr (!Epi::AFTER_DRAIN) { E(acc, cur, wr, wc, fr, fq); S.done(cur); }
        if (!has_next) break;
#pragma unroll
        for (int a = 0; a < 2; ++a)
#pragma unroll
            for (int b = 0; b < 2; ++b)
#pragma unroll
                for (int m = 0; m < 4; ++m)
#pragma unroll
                    for (int n = 0; n < 2; ++n) acc[a][b][m][n] = (f32x4){0.f, 0.f, 0.f, 0.f};
        cur = nxt; cA = nA; cB = nB; ++ui;
        if constexpr (ALIGN_EPI) { if (wr == 1) PG8_BAR; }
    }
    PG8_WAIT_V(0);
    if constexpr (!ALIGN_EPI) { if (wr == 0) PG8_BAR; }
    PG8_BAR;
    if constexpr (Epi::AFTER_DRAIN) { E.fused(acc, cur, wr, wc, fr, fq, lds, wid, lane); S.done(cur); }
#undef PG8_SA
#undef PG8_SB
#undef PG8_STAGE
#undef PG8_LDA
#undef PG8_LDB
#undef PG8_MMA
#undef PG8_WAIT_V
#undef PG8_WAIT_L
#undef PG8_BAR
#undef PG8_SCHED
}
}

constexpr int NWAVES = 8;
constexpr int RING_OFF = 0, RING_BYTES = 131072;
constexpr int LDSCTL_OFF = RING_BYTES, MISC_OFF = LDSCTL_OFF + 320;
constexpr int LDS_BYTES = 147456;

#define LAS __attribute__((address_space(3)))
typedef unsigned u32x2 __attribute__((ext_vector_type(2)));
typedef unsigned u32x4 __attribute__((ext_vector_type(4)));
typedef float f32x2 __attribute__((ext_vector_type(2)));
typedef float f32x4 __attribute__((ext_vector_type(4)));
typedef short bf16x8 __attribute__((ext_vector_type(8)));
#define LDS_WAIT() asm volatile("s_waitcnt lgkmcnt(0)" ::: "memory")
#define VM_WAIT() asm volatile("s_waitcnt vmcnt(0)" ::: "memory")
__device__ __forceinline__ unsigned pk2(float lo, float hi) { return pg8::cvt_pk_bf16(lo, hi); }
__device__ __forceinline__ float bflo(unsigned w) { return __uint_as_float(w << 16); }
__device__ __forceinline__ float bfhi(unsigned w) { return __uint_as_float(w & 0xffff0000u); }
__device__ __forceinline__ float wave_sum(float v) {
#pragma unroll
    for (int o = 1; o < 64; o <<= 1) v += __shfl_xor(v, o);
    return v;
}
__device__ __forceinline__ int hw_lane() { int l; asm volatile("v_mbcnt_lo_u32_b32 %0, -1, 0\n\tv_mbcnt_hi_u32_b32 %0, -1, %0" : "=v"(l)); return l; }
__device__ __forceinline__ int row_pos(int row) { return row < SEQP ? row : (row & (SEQS - 1)); }
__device__ __forceinline__ int row_slen(int row) { return row < SEQP ? SEQP : SEQS; }

__device__ const float INV_FREQ[64] = {
    1.000000000e+00f, 8.659643531e-01f, 7.498942018e-01f, 6.493816376e-01f,
    5.623413324e-01f, 4.869675338e-01f, 4.216965139e-01f, 3.651741147e-01f,
    3.162277639e-01f, 2.738419771e-01f, 2.371373773e-01f, 2.053525001e-01f,
    1.778279394e-01f, 1.539926529e-01f, 1.333521456e-01f, 1.154781953e-01f,
    1.000000015e-01f, 8.659642935e-02f, 7.498942316e-02f, 6.493816525e-02f,
    5.623413250e-02f, 4.869675264e-02f, 4.216964915e-02f, 3.651741147e-02f,
    3.162277490e-02f, 2.738419548e-02f, 2.371373773e-02f, 2.053525113e-02f,
    1.778279431e-02f, 1.539926510e-02f, 1.333521400e-02f, 1.154781971e-02f,
    9.999999776e-03f, 8.659643121e-03f, 7.498942316e-03f, 6.493816152e-03f,
    5.623413250e-03f, 4.869675264e-03f, 4.216964822e-03f, 3.651741194e-03f,
    3.162277630e-03f, 2.738419687e-03f, 2.371373819e-03f, 2.053525066e-03f,
    1.778279431e-03f, 1.539926510e-03f, 1.333521446e-03f, 1.154782018e-03f,
    1.000000047e-03f, 8.659643354e-04f, 7.498941850e-04f, 6.493816036e-04f,
    5.623413017e-04f, 4.869675322e-04f, 4.216965172e-04f, 3.651741135e-04f,
    3.162277571e-04f, 2.738419571e-04f, 2.371373703e-04f, 2.053525095e-04f,
    1.778279402e-04f, 1.539926598e-04f, 1.333521504e-04f, 1.154782003e-04f
};

#define XB_TMO      128
#define XB_XCNT(j)  (256  + 64 * (j))
#define XB_XSUB(j)  (1280 + 64 * (j))
#define XB_XGEN(j)  (2304 + 64 * (j))
#define XB_TOP      3328
#define XB_TOPGEN   3392
#define XCD_BAR_WORDS 3456
#define XB_SPIN_CAP (1u << 18)
__device__ __forceinline__ unsigned xb_ld(unsigned* p)              { return __hip_atomic_load(p, __ATOMIC_RELAXED, __HIP_MEMORY_SCOPE_AGENT); }
__device__ __forceinline__ unsigned xb_add(unsigned* p, unsigned v) { return __hip_atomic_fetch_add(p, v, __ATOMIC_RELAXED, __HIP_MEMORY_SCOPE_AGENT); }
__device__ __forceinline__ unsigned xb_xcc_id() { return (unsigned)__builtin_amdgcn_s_getreg((3 << 11) | 20) & 0xFu; }
#define XB_SPIN(cond, bar) do { unsigned _sp = 0; while (cond) { __builtin_amdgcn_s_sleep(1); \
    if ((++_sp & 255u) == 0u) { if (xb_ld(&(bar)[XB_TMO])) break; if (_sp > XB_SPIN_CAP) { atomicAdd(&(bar)[XB_TMO], 1u); break; } } } } while (0)
struct XcdBarrier { unsigned* bar; unsigned x; volatile LAS unsigned* st; unsigned wv; };
__device__ __forceinline__ bool xb_thread0(unsigned wv) { return wv == 0u && hw_lane() == 0; }
__device__ __forceinline__ XcdBarrier xcd_barrier_post(unsigned* bar, volatile LAS unsigned* st, unsigned wv) {
    XcdBarrier b; b.bar = bar; b.x = xb_xcc_id(); b.st = st; b.wv = wv;
    if (xb_thread0(wv)) (void)xb_add(&bar[XB_XCNT(b.x)], 1u);
    return b;
}
__device__ __forceinline__ void xcd_barrier_complete(unsigned* bar, unsigned x, unsigned& nloc, unsigned& nx) {
    const unsigned G = gridDim.x * gridDim.y * gridDim.z;
    unsigned sum, cnt, mine, sp = 0u;
    for (;;) {
        sum = 0u; cnt = 0u; mine = 0u;
#pragma unroll
        for (unsigned j = 0; j < 16; ++j) { const unsigned c = xb_ld(&bar[XB_XCNT(j)]); sum += c; cnt += (c > 0u) ? 1u : 0u; mine = (j == x) ? c : mine; }
        if (sum == G) break;
        __builtin_amdgcn_s_sleep(1);
        if ((++sp & 255u) == 0u) { if (xb_ld(&bar[XB_TMO])) break; if (sp > XB_SPIN_CAP) { atomicAdd(&bar[XB_TMO], 1u); break; } }
    }
    nloc = mine > 0u ? mine : 1u; nx = cnt > 0u ? cnt : 1u;
}
__device__ __forceinline__ void xcd_barrier(const XcdBarrier& b) {
    asm volatile("s_waitcnt vmcnt(0)" ::: "memory");
    __syncthreads();
    if (xb_thread0(b.wv)) {
        unsigned* bar = b.bar;
        __builtin_amdgcn_s_waitcnt(0);
        unsigned nloc = b.st[0], nx = b.st[1];
        if (nloc == 0u) { xcd_barrier_complete(bar, b.x, nloc, nx); b.st[0] = nloc; b.st[1] = nx; }
        const unsigned old = xb_add(&bar[XB_XSUB(b.x)], 1u);
        const unsigned gen = old / nloc;
        if (old + 1u == (gen + 1u) * nloc) {
            __builtin_amdgcn_fence(__ATOMIC_RELEASE, "agent");
            asm volatile("s_waitcnt vmcnt(0)" ::: "memory");
            const unsigned og = xb_add(&bar[XB_TOP], 1u);
            const unsigned tg = og / nx;
            if (og + 1u == (tg + 1u) * nx) xb_add(&bar[XB_TOPGEN], 1u);
            else XB_SPIN(xb_ld(&bar[XB_TOPGEN]) == tg, bar);
            __builtin_amdgcn_fence(__ATOMIC_ACQUIRE, "agent");
            xb_add(&bar[XB_XGEN(b.x)], 1u);
            asm volatile("s_waitcnt vmcnt(0)" ::: "memory");
        } else {
            XB_SPIN(xb_ld(&bar[XB_XGEN(b.x)]) == gen, bar);
            __builtin_amdgcn_fence(__ATOMIC_ACQUIRE, "agent");
            asm volatile("s_waitcnt vmcnt(0)" ::: "memory");
        }
    }
    __syncthreads();
}

#define GAS __attribute__((address_space(1)))
struct Args {
    const GAS float* in[28]; GAS float* out; GAS unsigned char* ws;
    int it_lo, it_hi, ph_lo, ph_hi;
    int single, pad;
};
typedef const __attribute__((address_space(4))) Args* KArgs;
enum { I_XP = 0, I_XS, I_MP, I_MS, I_LNG, I_LNB, I_FWI, I_FWO, I_WIN, I_POOLW, I_POOLS, I_SINK, I_MU, I_W0, I_W2, I_A0, I_A2, I_G2, I_KK, I_KA, I_RK, I_GNG, I_GNB, I_WBR, I_WOUT, I_XWQ, I_XWKV, I_XWO };

__device__ __forceinline__ int map_row(int kind, int n) {
    if (kind == 1) { const int up = n >= DFF ? 1 : 0; const int j = up ? n - DFF : n; return (j >> 7) * 256 + (up << 7) + (j & 127); }
    if (kind == 2) {
        if (n >= 512 && n < 1792) { const int d = n & 127; return (n & ~127) + 8 * ((d & 63) >> 2) + (d & 3) + 4 * (d >> 6); }
        return n >= 3968 ? n + 128 : n;
    }
    return n;
}
__device__ __forceinline__ void transpose_item(const float* W, int K, int N, bf16* WT, int kind, LAS float* scr, int item, int lane) {
    const int nblk = N / 32, kb = item / nblk, nb = item % nblk, k0 = 64 * kb, n0 = 32 * nb;
#pragma unroll
    for (int i = 0; i < 32; ++i) { const int kk = 2 * i + (lane >> 5); scr[kk * 33 + (lane & 31)] = __builtin_nontemporal_load(W + (size_t)(k0 + kk) * N + n0 + (lane & 31)); }
    LDS_WAIT(); asm volatile("" ::: "memory");
    const int c = lane & 7;
#pragma unroll
    for (int j = 0; j < 4; ++j) { const int n = (lane >> 3) + 8 * j; const LAS float* s = scr + (8 * c) * 33 + n;
        u32x4 o; o.x = pk2(s[0 * 33], s[1 * 33]); o.y = pk2(s[2 * 33], s[3 * 33]); o.z = pk2(s[4 * 33], s[5 * 33]); o.w = pk2(s[6 * 33], s[7 * 33]);
        *(u32x4*)(WT + (size_t)map_row(kind, n0 + n) * K + k0 + 8 * c) = o; }
    LDS_WAIT(); asm volatile("" ::: "memory");
}

__device__ __forceinline__ void conv_phase(KArgs a, int L, LAS unsigned char* lds, int gw, int NGW, int wave, int lane, int gtid, int NT) {
    unsigned char* ws = (unsigned char*)a->ws;
    LAS float* scr = (LAS float*)(lds + RING_OFF + wave * 16384);
    constexpr int N_W1 = 32 * 352, N_W2 = 88 * 64, N_WI = 32 * 316, N_B1 = 16 * 64, N_B2 = 8 * 64, N_OU = 32 * 64, N_Q = 32 * 16, N_KV = 32 * 32, N_O = 8 * 64;
    constexpr int NITEMS = 2 * N_W1 + 2 * N_W2 + N_WI + N_B1 + N_B2 + N_OU + N_Q + N_KV + N_O;
    const float* fwi = ((const float*)a->in[I_FWI]) + (size_t)L * 2 * D * 2 * DFF;
    const float* fwo = ((const float*)a->in[I_FWO]) + (size_t)L * 2 * DFF * D;
    const float* wbr = ((const float*)a->in[I_WBR]) + (size_t)L * D * D;
    for (int it = gw; it < NITEMS; it += NGW) {
        int r = it;
        if (r < N_W1) { transpose_item(fwi, D, 2 * DFF, (bf16*)(ws + WS_W1T), 1, scr, r, lane); continue; } r -= N_W1;
        if (r < N_W1) { transpose_item(fwi + (size_t)D * 2 * DFF, D, 2 * DFF, (bf16*)(ws + WS_W1T) + (size_t)2 * DFF * D, 1, scr, r, lane); continue; } r -= N_W1;
        if (r < N_W2) { transpose_item(fwo, DFF, D, (bf16*)(ws + WS_W2T), 0, scr, r, lane); continue; } r -= N_W2;
        if (r < N_W2) { transpose_item(fwo + (size_t)DFF * D, DFF, D, (bf16*)(ws + WS_W2T) + (size_t)D * DFF, 0, scr, r, lane); continue; } r -= N_W2;
        if (r < N_WI) { transpose_item(((const float*)a->in[I_WIN]) + (size_t)L * D * INC, D, INC, (bf16*)(ws + WS_WINT), 2, scr, r, lane); continue; } r -= N_WI;
        if (r < N_B1) { transpose_item(wbr + (size_t)512 * D, 1024, D, (bf16*)(ws + WS_WBR1), 0, scr, r, lane); continue; } r -= N_B1;
        if (r < N_B2) { transpose_item(wbr + (size_t)1536 * D, 512, D, (bf16*)(ws + WS_WBR2), 0, scr, r, lane); continue; } r -= N_B2;
        if (r < N_OU) { transpose_item(((const float*)a->in[I_WOUT]) + (size_t)L * D * D, D, D, (bf16*)(ws + WS_WOUT), 0, scr, r, lane); continue; } r -= N_OU;
        if (r < N_Q) { transpose_item(((const float*)a->in[I_XWQ]) + (size_t)L * D * 512, D, 512, (bf16*)(ws + WS_WQ), 0, scr, r, lane); continue; } r -= N_Q;
        if (r < N_KV) { transpose_item(((const float*)a->in[I_XWKV]) + (size_t)L * D * 1024, D, 1024, (bf16*)(ws + WS_WKV), 0, scr, r, lane); continue; } r -= N_KV;
        transpose_item(((const float*)a->in[I_XWO]) + (size_t)L * 512 * D, 512, D, (bf16*)(ws + WS_WO), 0, scr, r, lane);
    }
    {
        const float* pw = ((const float*)a->in[I_POOLW]) + (size_t)L * 4 * 128 * 128; const float* ps = ((const float*)a->in[I_POOLS]) + (size_t)L * 512;
        bf16* dst = (bf16*)(ws + WS_WBR0);
        for (int id = gtid; id < 2048 * 64; id += NT) {
            const int n = id & 2047, kg = id >> 11, g = kg >> 4, c0 = (8 * kg) & 127;
            float acc[8];
#pragma unroll
            for (int i = 0; i < 8; ++i) acc[i] = 0.f;
            const float* pwr = pw + ((size_t)g * 128 + c0) * 128;
            for (int e = 0; e < 128; ++e) {
                const float wb = wbr[(size_t)(g * 128 + e) * D + n] * ps[g * 128 + e];
#pragma unroll
                for (int i = 0; i < 8; ++i) acc[i] += pwr[i * 128 + e] * wb;
            }
            u32x4 o; o.x = pk2(acc[0], acc[1]); o.y = pk2(acc[2], acc[3]); o.z = pk2(acc[4], acc[5]); o.w = pk2(acc[6], acc[7]);
            *(u32x4*)(dst + (size_t)n * 512 + 8 * kg) = o;
        }
    }
    {
        const float* w2 = ((const float*)a->in[I_W2]) + (size_t)L * 2 * 64 * 512; const float* a2 = ((const float*)a->in[I_A2]) + (size_t)L * 2 * 64 * 512; const float* g2 = ((const float*)a->in[I_G2]) + (size_t)L * 128 * 512;
        bf16* dst = (bf16*)(ws + WS_BL);
        for (int id = gtid; id < 2560 * 48; id += NT) {
            const int n = id / 48, k0 = 8 * (id % 48);
            float v[8];
#pragma unroll
            for (int i = 0; i < 8; ++i) {
                const int k = k0 + i; float x = 0.f;
                if (n < 512) { if (k < 64) x = w2[(size_t)k * 512 + n]; }
                else if (n < 1024) { if (k >= 64 && k < 128) x = w2[(size_t)(64 + k - 64) * 512 + (n - 512)]; }
                else if (n < 1536) { if (k >= 128 && k < 192) x = a2[(size_t)(k - 128) * 512 + (n - 1024)]; }
                else if (n < 2048) { if (k >= 192 && k < 256) x = a2[(size_t)(64 + k - 192) * 512 + (n - 1536)]; }
                else { if (k >= 256) x = g2[(size_t)(k - 256) * 512 + (n - 2048)]; }
                v[i] = x;
            }
            u32x4 o; o.x = pk2(v[0], v[1]); o.y = pk2(v[2], v[3]); o.z = pk2(v[4], v[5]); o.w = pk2(v[6], v[7]);
            *(u32x4*)(dst + (size_t)n * 384 + k0) = o;
        }
    }
    { u32x4* p = (u32x4*)((bf16*)(ws + WS_WINT) + (size_t)3968 * D); for (int id = gtid; id < 128 * D / 8; id += NT) p[id] = (u32x4){0u, 0u, 0u, 0u}; }
}

__device__ __forceinline__ void prologue_phase(KArgs a, int gtid, int NT) {
    unsigned char* ws = (unsigned char*)a->ws;
    { f32x2* cs = (f32x2*)(ws + WS_CS);
      for (int id = gtid; id < SEQP * 64; id += NT) { const int t = id >> 6, j = id & 63; const float ang = (float)t * INV_FREQ[j]; float s, c; sincosf(ang, &s, &c); cs[id] = (f32x2){c, s}; } }
    { bf16* mb = (bf16*)(ws + WS_MEMB);
      for (int id = gtid; id < MMEM * D / 4; id += NT) { const int row = id / (D / 4), c4 = id % (D / 4);
          const float* src = row < MEML ? ((const float*)a->in[I_MP]) + (size_t)row * D : ((const float*)a->in[I_MS]) + (size_t)(row - MEML) * D;
          const f32x4 v = *(const f32x4*)(src + 4 * c4); u32x2 o; o.x = pk2(v[0], v[1]); o.y = pk2(v[2], v[3]); *(u32x2*)(mb + (size_t)row * D + 4 * c4) = o; } }
    { bf16* xb = (bf16*)(ws + WS_XB);
      for (int id = gtid; id < MTOK * (D / 4); id += NT) { const int row = id / (D / 4), c4 = id % (D / 4);
          const float* src = row < SEQP ? ((const float*)a->in[I_XP]) + (size_t)row * D : ((const float*)a->in[I_XS]) + (size_t)(row - SEQP) * D;
          const f32x4 v = *(const f32x4*)(src + 4 * c4);
          u32x2 o; o.x = pk2(v[0], v[1]); o.y = pk2(v[2], v[3]); *(u32x2*)(xb + (size_t)row * D + 4 * c4) = o; } }
}

__device__ __forceinline__ void ln_phase(const float* x, float* xo, bf16* xb, const float* g, const float* b, float* stats, bool write_x, int gw, int NGW, int lane) {
    f32x4 v[8], nx[8];
    if (gw < MTOK) { const f32x4* xr = (const f32x4*)(x + (size_t)gw * D) + lane;
#pragma unroll
        for (int j = 0; j < 8; ++j) v[j] = __builtin_nontemporal_load(xr + 64 * j); }
#pragma unroll 1
    for (int m = gw; m < MTOK; m += NGW) {
        f32x4* xr = (f32x4*)(xo + (size_t)m * D) + lane;
        if (m + NGW < MTOK) { const f32x4* xn = (const f32x4*)(x + (size_t)(m + NGW) * D) + lane;
#pragma unroll
            for (int j = 0; j < 8; ++j) nx[j] = __builtin_nontemporal_load(xn + 64 * j); }
        float s = 0.f;
#pragma unroll
        for (int j = 0; j < 8; ++j) s += (v[j][0] + v[j][1]) + (v[j][2] + v[j][3]);
        const float mean = wave_sum(s) * (1.f / D); float s2 = 0.f;
#pragma unroll
        for (int j = 0; j < 8; ++j) { v[j] = v[j] - mean; s2 += (v[j][0] * v[j][0] + v[j][1] * v[j][1]) + (v[j][2] * v[j][2] + v[j][3] * v[j][3]); }
        const float rstd = 1.f / sqrtf(wave_sum(s2) * (1.f / D) + LN_EPS);
        if (!write_x && lane == 0) *(f32x2*)(stats + 2 * (size_t)m) = (f32x2){mean, rstd};
        u32x2* o8 = (u32x2*)(xb + (size_t)m * D) + lane;
#pragma unroll
        for (int j = 0; j < 8; ++j) { const f32x4 gg = *((const f32x4*)g + lane + 64 * j), bb = *((const f32x4*)b + lane + 64 * j);
            const f32x4 o = v[j] * rstd * gg + bb; if (write_x) xr[64 * j] = o; u32x2 w; w.x = pk2(o[0], o[1]); w.y = pk2(o[2], o[3]); o8[64 * j] = w; }
#pragma unroll
        for (int j = 0; j < 8; ++j) v[j] = nx[j];
    }
}

template <bool FINAL> __device__ __forceinline__ void ln_phase_h(const unsigned short* xh, bf16* xb, float* xout, const float* g, const float* b, float* stats, int gw, int NGW, int lane) {
    u32x4 hv[4], n1[4], nx[4];
    f32x4 gv[8], bv[8];
#pragma unroll
    for (int j = 0; j < 4; ++j) { const f32x4* gq = (const f32x4*)g + 2 * (lane + 64 * j); const f32x4* bq = (const f32x4*)b + 2 * (lane + 64 * j); gv[2 * j] = gq[0]; gv[2 * j + 1] = gq[1]; bv[2 * j] = bq[0]; bv[2 * j + 1] = bq[1]; }
    if (gw < MTOK) { const u32x4* xr = (const u32x4*)(xh + (size_t)gw * D) + lane;
#pragma unroll
        for (int j = 0; j < 4; ++j) hv[j] = __builtin_nontemporal_load(xr + 64 * j); }
    if (gw + NGW < MTOK) { const u32x4* xr = (const u32x4*)(xh + (size_t)(gw + NGW) * D) + lane;
#pragma unroll
        for (int j = 0; j < 4; ++j) n1[j] = __builtin_nontemporal_load(xr + 64 * j); }
#pragma unroll 1
    for (int m = gw; m < MTOK; m += NGW) {
        if (m + 2 * NGW < MTOK) { const u32x4* xn = (const u32x4*)(xh + (size_t)(m + 2 * NGW) * D) + lane;
#pragma unroll
            for (int j = 0; j < 4; ++j) nx[j] = __builtin_nontemporal_load(xn + 64 * j); }
        f32x4 v[8];
#pragma unroll
        for (int j = 0; j < 4; ++j) { const f32x2 a0 = pg8::h2f(hv[j].x), a1 = pg8::h2f(hv[j].y), a2 = pg8::h2f(hv[j].z), a3 = pg8::h2f(hv[j].w);
            v[2 * j] = (f32x4){a0.x, a0.y, a1.x, a1.y}; v[2 * j + 1] = (f32x4){a2.x, a2.y, a3.x, a3.y}; }
        float s = 0.f;
#pragma unroll
        for (int j = 0; j < 8; ++j) s += (v[j][0] + v[j][1]) + (v[j][2] + v[j][3]);
        const float mean = wave_sum(s) * (1.f / D); float s2 = 0.f;
#pragma unroll
        for (int j = 0; j < 8; ++j) { v[j] = v[j] - mean; s2 += (v[j][0] * v[j][0] + v[j][1] * v[j][1]) + (v[j][2] * v[j][2] + v[j][3] * v[j][3]); }
        const float rstd = 1.f / sqrtf(wave_sum(s2) * (1.f / D) + LN_EPS);
        if (!FINAL && lane == 0) *(f32x2*)(stats + 2 * (size_t)m) = (f32x2){mean, rstd};
        u32x4* o8 = (u32x4*)(xb + (size_t)m * D) + lane; f32x4* of = (f32x4*)(xout + (size_t)m * D) + 2 * lane;
#pragma unroll
        for (int j = 0; j < 4; ++j) {
            const f32x4 o0 = v[2 * j] * rstd * gv[2 * j] + bv[2 * j], o1 = v[2 * j + 1] * rstd * gv[2 * j + 1] + bv[2 * j + 1];
            if (FINAL) { of[128 * j] = o0; of[128 * j + 1] = o1; }
            else { u32x4 w; w.x = pk2(o0[0], o0[1]); w.y = pk2(o0[2], o0[3]); w.z = pk2(o1[0], o1[1]); w.w = pk2(o1[2], o1[3]); o8[64 * j] = w; } }
#pragma unroll
        for (int j = 0; j < 4; ++j) { hv[j] = n1[j]; n1[j] = nx[j]; }
    }
}

__device__ __forceinline__ void pool_rows(const bf16* UP, bf16* OP, int row_lo, int row_hi, int step, int lane) {
    const int g = lane >> 4, half = 1 << g;
    for (int row = row_lo; row < row_hi; row += step) {
        const int pos = row_pos(row), S = row_slen(row), lo = max(pos - half, 0), hi = min(pos + half, S);
        const bf16* base = UP + (size_t)(row - pos) * 512 + 8 * lane;
        u32x4 w[16];
#pragma unroll
        for (int k = 0; k < 16; ++k) { const int s = pos - 8 + k; w[k] = (s >= lo && s < hi) ? *(const u32x4*)(base + (size_t)s * 512) : (u32x4){0u, 0u, 0u, 0u}; }
        float sum[8];
#pragma unroll
        for (int i = 0; i < 8; ++i) sum[i] = 0.f;
#pragma unroll
        for (int k = 0; k < 16; ++k) { sum[0] += bflo(w[k].x); sum[1] += bfhi(w[k].x); sum[2] += bflo(w[k].y); sum[3] += bfhi(w[k].y); sum[4] += bflo(w[k].z); sum[5] += bfhi(w[k].z); sum[6] += bflo(w[k].w); sum[7] += bfhi(w[k].w); }
        const u32x4 ws = w[8]; const float inv = 1.f / (float)(hi - lo);
        u32x4 o; o.x = pk2(sum[0] * inv - bflo(ws.x), sum[1] * inv - bfhi(ws.x)); o.y = pk2(sum[2] * inv - bflo(ws.y), sum[3] * inv - bfhi(ws.y));
        o.z = pk2(sum[4] * inv - bflo(ws.z), sum[5] * inv - bfhi(ws.z)); o.w = pk2(sum[6] * inv - bflo(ws.w), sum[7] * inv - bfhi(ws.w));
        *(u32x4*)(OP + (size_t)row * 512 + 8 * lane) = o;
    }
}

template <bool WINDOW>
__device__ __forceinline__ void attn_unit(LAS unsigned char* lds, int wave, int lane_in, const bf16* Qw, int ldq, const bf16* Kg, int ldk, const bf16* VTg, int ldvt, bf16* Ow, int ldo,
                                          int nkb, int qrel0, float m0, float l0) {
    int lane = lane_in; asm volatile("" : "+v"(lane));
    int lr = lane & 15, quad = lane >> 4;
    const int tid = wave * 64 + lane;
#define ATT_DMA(kb, b) do { _Pragma("unroll") for (int j_ = 0; j_ < 4; ++j_) { const int r_ = 32 * j_ + (tid >> 4), sc_ = 8 * ((tid & 15) ^ (r_ & 15)); \
        __builtin_amdgcn_global_load_lds((const GAS unsigned*)(Kg + (size_t)(128 * (kb) + r_) * ldk + sc_), (LAS unsigned*)(lds + (b) * 65536 + (j_ * 8 + wave) * 1024), 16, 0, 0); \
        __builtin_amdgcn_global_load_lds((const GAS unsigned*)(VTg + (size_t)r_ * ldvt + 128 * (kb) + sc_), (LAS unsigned*)(lds + (b) * 65536 + 32768 + (j_ * 8 + wave) * 1024), 16, 0, 0); } } while (0)
    bf16x8 qf[2][4];
#pragma unroll
    for (int G = 0; G < 2; ++G)
#pragma unroll
        for (int ds = 0; ds < 4; ++ds) qf[G][ds] = *(const bf16x8*)(Qw + (unsigned)((16 * G + lr) * ldq + 32 * ds + 8 * quad));
    ATT_DMA(0, 0);
    f32x4 oacc[2][8];
#pragma unroll
    for (int G = 0; G < 2; ++G)
#pragma unroll
        for (int dt = 0; dt < 8; ++dt) oacc[G][dt] = (f32x4){0.f, 0.f, 0.f, 0.f};
    float mrun[2] = {m0, m0}, lrun[2] = {l0, l0};
#pragma unroll 1
    for (int kb = 0; kb < nkb; ++kb) {
        asm volatile("" : "+v"(lr), "+v"(quad));
        if (kb + 1 < nkb) { ATT_DMA(kb + 1, (kb + 1) & 1); asm volatile("s_waitcnt vmcnt(8)" ::: "memory"); }
        else asm volatile("s_waitcnt vmcnt(0)" ::: "memory");
        asm volatile("" ::: "memory"); __builtin_amdgcn_s_barrier(); asm volatile("" ::: "memory");
        const LAS unsigned char* Kb = lds + (kb & 1) * 65536; const LAS unsigned char* Vb = Kb + 32768;
        f32x4 sacc[2][8];
#pragma unroll
        for (int T = 0; T < 8; ++T) {
            bf16x8 kf[4];
#pragma unroll
            for (int ds = 0; ds < 4; ++ds) kf[ds] = *(const LAS bf16x8*)(Kb + (16 * T + lr) * 256 + 16 * ((4 * ds + quad) ^ lr));
#pragma unroll
            for (int G = 0; G < 2; ++G) { f32x4 cc = (f32x4){0.f, 0.f, 0.f, 0.f};
#pragma unroll
                for (int ds = 0; ds < 4; ++ds) cc = __builtin_amdgcn_mfma_f32_16x16x32_bf16(kf[ds], qf[G][ds], cc, 0, 0, 0);
                sacc[G][T] = cc; }
        }
#pragma unroll
        for (int G = 0; G < 2; ++G) {
            float mx = -3.0e38f;
#pragma unroll
            for (int T = 0; T < 8; ++T)
#pragma unroll
                for (int r = 0; r < 4; ++r) { float t = sacc[G][T][r] * ATT_C1;
                    if (WINDOW) { const int dd = (qrel0 + 16 * G + lr) - (128 * kb + 16 * T + 4 * quad + r); if (dd > 128 || dd < -128) t = -1.0e30f; }
                    sacc[G][T][r] = t; mx = fmaxf(mx, t); }
            mx = fmaxf(mx, __shfl_xor(mx, 16)); mx = fmaxf(mx, __shfl_xor(mx, 32));
            const float mnew = fmaxf(mrun[G], mx), alpha = __builtin_amdgcn_exp2f(mrun[G] - mnew); mrun[G] = mnew;
            float sum = 0.f;
#pragma unroll
            for (int T = 0; T < 8; ++T)
#pragma unroll
                for (int r = 0; r < 4; ++r) { const float p = __builtin_amdgcn_exp2f(sacc[G][T][r] - mnew); sacc[G][T][r] = p; sum += p; }
            sum += __shfl_xor(sum, 16); sum += __shfl_xor(sum, 32);
            lrun[G] = lrun[G] * alpha + sum;
#pragma unroll
            for (int dt = 0; dt < 8; ++dt) oacc[G][dt] = oacc[G][dt] * alpha;
        }
#pragma unroll
        for (int s = 0; s < 4; ++s) {
            bf16x8 pf[2];
#pragma unroll
            for (int G = 0; G < 2; ++G) { u32x4 w; w.x = pk2(sacc[G][2 * s][0], sacc[G][2 * s][1]); w.y = pk2(sacc[G][2 * s][2], sacc[G][2 * s][3]);
                w.z = pk2(sacc[G][2 * s + 1][0], sacc[G][2 * s + 1][1]); w.w = pk2(sacc[G][2 * s + 1][2], sacc[G][2 * s + 1][3]); pf[G] = __builtin_bit_cast(bf16x8, w); }
#pragma unroll
            for (int dt = 0; dt < 8; ++dt) {
                const int p8 = 8 * s + quad;
                const LAS unsigned char* vrow = Vb + (16 * dt + lr) * 256 + 8 * (p8 & 1);
                const u32x2 lo = *(const LAS u32x2*)(vrow + 16 * ((p8 >> 1) ^ lr)), hi = *(const LAS u32x2*)(vrow + 16 * (((p8 >> 1) + 2) ^ lr));
                const bf16x8 vf = __builtin_bit_cast(bf16x8, (u32x4){lo.x, lo.y, hi.x, hi.y});
#pragma unroll
                for (int G = 0; G < 2; ++G) oacc[G][dt] = __builtin_amdgcn_mfma_f32_16x16x32_bf16(vf, pf[G], oacc[G][dt], 0, 0, 0);
            }
        }
        asm volatile("" ::: "memory"); __builtin_amdgcn_s_barrier(); asm volatile("" ::: "memory");
    }
#undef ATT_DMA
#pragma unroll
    for (int G = 0; G < 2; ++G) { const float inv = 1.f / lrun[G];
#pragma unroll
        for (int dt = 0; dt < 8; ++dt) { const f32x4 o = oacc[G][dt] * inv; u32x2 w; w.x = pk2(o[0], o[1]); w.y = pk2(o[2], o[3]);
            *(u32x2*)(Ow + (unsigned)((16 * G + lr) * ldo + 16 * dt + 4 * quad)) = w; } }
}

__device__ __forceinline__ void winattn_unit(KArgs a, int L, LAS unsigned char* lds, int wave, int lane, int unit) {
    unsigned char* ws = (unsigned char*)a->ws;
    const bf16* Q = (const bf16*)(ws + WS_Q); const bf16* K = (const bf16*)(ws + WS_K); const bf16* VT = (const bf16*)(ws + WS_VT); bf16* O = (bf16*)(ws + WS_OATT);
    const float* sink = ((const float*)a->in[I_SINK]) + L * 8;
    const int hkv = unit & 1, row0 = (unit >> 1) * 64, pos0 = row_pos(row0), S = row_slen(row0), qb = pos0 >> 7;
    const int kb_lo = max(qb - 1, 0), kb_hi = min(qb + 1, (S >> 7) - 1), keyrow0 = (row0 - pos0) + 128 * kb_lo;
    const int hq = hkv * 4 + (wave & 3), rw = row0 + 32 * (wave >> 2);
    attn_unit<true>(lds, wave, lane, Q + (size_t)rw * 1024 + hq * 128, 1024, K + (size_t)keyrow0 * 256 + hkv * 128, 256, VT + (size_t)(hkv * 128) * MTOK + keyrow0, MTOK,
                    O + (size_t)rw * 1024 + hq * 128, 1024, kb_hi - kb_lo + 1, (pos0 + 32 * (wave >> 2)) - 128 * kb_lo, sink[hq] * LOG2E, 1.f);
}
constexpr int NQ_ATT = (MTOK / 64) * 2, NQ_POOL = MTOK / 64;
__device__ __forceinline__ void mixq_phase(KArgs a, int L, LAS unsigned char* lds, volatile LAS unsigned* MISC, unsigned* ctr, int wave, int lane) {
    unsigned char* ws = (unsigned char*)a->ws;
    for (;;) {
        if (wave == 0 && lane == 0) MISC[0] = __hip_atomic_fetch_add(ctr, 1u, __ATOMIC_RELAXED, __HIP_MEMORY_SCOPE_AGENT);
        __syncthreads();
        const int u = (int)MISC[0];
        __syncthreads();
        if (u >= NQ_ATT + NQ_POOL) break;
        if (u < NQ_ATT) winattn_unit(a, L, lds, wave, lane, u);
        else { const int r0 = (u - NQ_ATT) * 64 + wave * 8; pool_rows((const bf16*)(ws + WS_UPOOL), (bf16*)(ws + WS_OPOOL), r0, r0 + 8, 1, lane); }
    }
}
__device__ __forceinline__ void xattn_phase(KArgs a, LAS unsigned char* lds, int wave, int lane) {
    unsigned char* ws = (unsigned char*)a->ws;
    const bf16* Q = (const bf16*)(ws + WS_QX); const bf16* K = (const bf16*)(ws + WS_KX); const bf16* VT = (const bf16*)(ws + WS_VXT); bf16* O = (bf16*)(ws + WS_OX);
    for (int unit = blockIdx.x; unit < (MTOK / 256) * 4; unit += gridDim.x) {
        const int h = unit & 3, row0 = (unit >> 2) * 256, seq = row0 < SEQP ? 0 : 1 + ((row0 - SEQP) >> 12), rw = row0 + 32 * wave;
        attn_unit<false>(lds, wave, lane, Q + (size_t)rw * 512 + h * 128, 512, K + (size_t)(MEML * seq) * 512 + h * 128, 512, VT + (size_t)(h * 128) * MMEM + MEML * seq, MMEM,
                         O + (size_t)rw * 512 + h * 128, 512, 2, 0, -1.0e30f, 0.f);
    }
}

__device__ __forceinline__ void prepa_phase(KArgs a, int L, int gw, int NGW, int lane_in) {
    unsigned char* ws = (unsigned char*)a->ws;
    const float* U = (const float*)(ws + WS_URWKV); float* SH = (float*)(ws + WS_SH); float* KB = (float*)(ws + WS_KBUF); bf16* AL = (bf16*)(ws + WS_AL);
    const float* mu0p = ((const float*)a->in[I_MU]) + (size_t)L * 2 * RWC; const float* mu1p = mu0p + RWC; const float* k_k = ((const float*)a->in[I_KK]) + L * 512;
    int lane = lane_in; asm volatile("" : "+v"(lane));
    f32x4 m0[8], m1[8];
#pragma unroll
    for (int j = 0; j < 8; ++j) { const int c = 256 * j + 4 * lane; const bool ok = c < RWC; m0[j] = ok ? *(const f32x4*)(mu0p + c) : (f32x4){0.f, 0.f, 0.f, 0.f}; m1[j] = ok ? *(const f32x4*)(mu1p + c) : (f32x4){0.f, 0.f, 0.f, 0.f}; }
    const f32x4 kk0 = *(const f32x4*)(k_k + 4 * lane), kk1 = *(const f32x4*)(k_k + 256 + 4 * lane);
    const f32x4 zero4 = {0.f, 0.f, 0.f, 0.f};
    for (int run = gw; run < MTOK / 8; run += NGW) {
        const int r0 = run * 8, pos0 = row_pos(r0), S = row_slen(r0);
        f32x4 P[8], C[8], N[8];
        { const float* up = U + (size_t)(r0 - 1) * 2048 + 4 * lane; const float* uc = U + (size_t)r0 * 2048 + 4 * lane; const bool hp = pos0 > 0;
#pragma unroll
          for (int j = 0; j < 8; ++j) { P[j] = hp ? *(const f32x4*)(up + 256 * j) : zero4; C[j] = *(const f32x4*)(uc + 256 * j); } }
#pragma unroll 1
        for (int t = 0; t < 8; ++t) {
            const int row = r0 + t; const bool hn = (pos0 + t) < S - 1;
            { const float* un = U + (size_t)(row + 1) * 2048 + 4 * lane;
#pragma unroll
              for (int j = 0; j < 8; ++j) N[j] = hn ? *(const f32x4*)(un + 256 * j) : zero4; }
            f32x4 xs[8];
#pragma unroll
            for (int j = 0; j < 8; ++j) xs[j] = C[j] + m0[j] * (P[j] - C[j]) + m1[j] * (N[j] - C[j]);
            const int hl = lane >> 4, jj = 4 * (lane & 15);
#pragma unroll
            for (int j2 = 0; j2 < 2; ++j2) { float* sh = SH + ((size_t)row * 8 + 4 * j2 + hl) * 192 + jj;
                *(f32x4*)(sh + 64) = xs[j2]; *(f32x4*)(sh + 128) = xs[4 + j2];
                const f32x4 kv = xs[2 + j2]; *(f32x4*)(KB + (size_t)row * 512 + 256 * j2 + 4 * lane) = kv;
                const f32x4 ku = kv * (j2 ? kk1 : kk0); float ss = (ku[0] * ku[0] + ku[1] * ku[1]) + (ku[2] * ku[2] + ku[3] * ku[3]);
                ss += __shfl_xor(ss, 1); ss += __shfl_xor(ss, 2); ss += __shfl_xor(ss, 4); ss += __shfl_xor(ss, 8);
                const float inv = -1.f / fmaxf(sqrtf(ss), 1e-12f); *(f32x4*)sh = ku * inv; }
            { const f32x4 x6 = xs[6]; f32x4 o6;
#pragma unroll
              for (int e = 0; e < 4; ++e) o6[e] = lane < 32 ? tanhf(x6[e]) : x6[e];
              u32x2 w; w.x = pk2(o6[0], o6[1]); w.y = pk2(o6[2], o6[3]); *(u32x2*)(AL + (size_t)row * 384 + 4 * lane) = w;
              if (lane < 32) { const f32x4 x7 = xs[7]; u32x2 w7; w7.x = pk2(1.f / (1.f + expf(-x7[0])), 1.f / (1.f + expf(-x7[1]))); w7.y = pk2(1.f / (1.f + expf(-x7[2])), 1.f / (1.f + expf(-x7[3])));
                  *(u32x2*)(AL + (size_t)row * 384 + 256 + 4 * lane) = w7; } }
#pragma unroll
            for (int j = 0; j < 8; ++j) { P[j] = C[j]; C[j] = N[j]; }
        }
    }
}

__device__ __forceinline__ void scan_phase(KArgs a, LAS unsigned char* lds, int gw, int NGW, int wave, int lane) {
    unsigned char* ws = (unsigned char*)a->ws;
    const float* SH = (const float*)(ws + WS_SH); const float* DIR = (const float*)(ws + WS_DIR);
    float* Y = (float*)(ws + WS_Y); float* Z = (float*)(ws + WS_Z); float* QM = (float*)(ws + WS_QM); float* PM = (float*)(ws + WS_PM);
    LAS unsigned char* wlb = lds + RING_OFF + wave * 12288;
    for (int task = gw; task < NCP * 16; task += NGW) {
        const int cp = task >> 4, e = (task >> 3) & 1, h = task & 7;
#define SCAN_DMA(bb) do { int ln_ = lane; asm volatile("" : "+v"(ln_)); _Pragma("unroll") for (int pr_ = 0; pr_ < 2; ++pr_) _Pragma("unroll") for (int k_ = 0; k_ < 3; ++k_) { \
            const int o_ = 1024 * k_ + 16 * ln_, stp_ = o_ >= 1536 ? 1 : 0, wi_ = o_ - 1536 * stp_, blk_ = wi_ >= 768 ? 1 : 0, off_ = (wi_ - 768 * blk_) >> 2; \
            const int tau_ = 4 * (bb) + 2 * pr_ + stp_, row_ = cp * CH + (e ? CH - 1 - tau_ : tau_); \
            const float* src_ = blk_ ? DIR + (((size_t)row_ * 2 + e) * 8 + h) * 192 + off_ : SH + ((size_t)row_ * 8 + h) * 192 + off_; \
            __builtin_amdgcn_global_load_lds((const GAS unsigned*)src_, (LAS unsigned*)(wlb + (((bb) & 1) * 4 + 2 * pr_) * 1536 + 1024 * k_), 16, 0, 0); } } while (0)
        LDS_WAIT(); asm volatile("" ::: "memory");
        SCAN_DMA(0);
        asm volatile("" ::: "memory");
        f32x2 S2[32], X2[32];
        { int ln = lane; asm volatile("" : "+v"(ln));
#pragma unroll
          for (int q = 0; q < 32; ++q) { S2[q] = (f32x2){0.f, 0.f}; X2[q] = (f32x2){(2 * q == ln) ? 1.f : 0.f, (2 * q + 1 == ln) ? 1.f : 0.f}; } }
        f32x4 buf[2][8];
#pragma unroll 1
        for (int bb = 0; bb < CH / 4; ++bb) {
            if (bb == 0) asm volatile("s_waitcnt vmcnt(0)" ::: "memory");
            else asm volatile("s_waitcnt vmcnt(8)" ::: "memory");
            if (bb + 1 < CH / 4) SCAN_DMA(bb + 1);
            const LAS float* p0 = (const LAS float*)(wlb + ((bb & 1) * 4) * 1536);
#pragma unroll
            for (int i = 0; i < 8; ++i) buf[0][i] = *(const LAS f32x4*)(p0 + 4 * i);
#pragma unroll 1
            for (int st = 0; st < 4; ++st) {
                const LAS float* p = p0 + st * 384;
                const int tau = 4 * bb + st, row = cp * CH + (e ? CH - 1 - tau : tau);
                const float vi = p[128 + lane];
                f32x2 sa0 = {0.f, 0.f}, sa1 = {0.f, 0.f}, sx0 = {0.f, 0.f}, sx1 = {0.f, 0.f};
#pragma unroll
                for (int i = 0; i < 8; ++i) buf[1][i] = *(const LAS f32x4*)(p + 32 + 4 * i);
                asm volatile("" : "+v"(sa0), "+v"(sx0) :: "memory");
#pragma unroll
                for (int i = 0; i < 8; ++i) { const f32x4 nk = buf[0][i]; sa0 += S2[2 * i] * nk.xy; sa1 += S2[2 * i + 1] * nk.zw; sx0 += X2[2 * i] * nk.xy; sx1 += X2[2 * i + 1] * nk.zw; }
                asm volatile("" : "+v"(sa0), "+v"(sa1), "+v"(sx0), "+v"(sx1) :: "memory");
#pragma unroll
                for (int j = 0; j < 2; ++j) { buf[0][j] = *(const LAS f32x4*)(p + 64 + 4 * j); buf[0][2 + j] = *(const LAS f32x4*)(p + 192 + 4 * j); buf[0][4 + j] = *(const LAS f32x4*)(p + 256 + 4 * j); buf[0][6 + j] = *(const LAS f32x4*)(p + 320 + 4 * j); }
                asm volatile("" : "+v"(sa0), "+v"(sx0) :: "memory");
#pragma unroll
                for (int i = 0; i < 8; ++i) { const f32x4 nk = buf[1][i]; sa0 += S2[16 + 2 * i] * nk.xy; sa1 += S2[16 + 2 * i + 1] * nk.zw; sx0 += X2[16 + 2 * i] * nk.xy; sx1 += X2[16 + 2 * i + 1] * nk.zw; }
                asm volatile("" : "+v"(sa0), "+v"(sa1), "+v"(sx0), "+v"(sx1) :: "memory");
                const float sa = (sa0.x + sa0.y) + (sa1.x + sa1.y), sx = (sx0.x + sx0.y) + (sx1.x + sx1.y);
                const f32x2 sav = {sa, sa}, sxv = {sx, sx}, vv = {vi, vi};
                f32x2 y0 = {0.f, 0.f}, y1 = {0.f, 0.f}, z0 = {0.f, 0.f}, z1 = {0.f, 0.f};
#pragma unroll
                for (int g = 0; g < 8; ++g) {
                    if (g < 7) {
#pragma unroll
                        for (int j = 0; j < 2; ++j) { const int q = 2 * (g + 1) + j; buf[(g + 1) & 1][j] = *(const LAS f32x4*)(p + 64 + 4 * q); buf[(g + 1) & 1][2 + j] = *(const LAS f32x4*)(p + 192 + 4 * q);
                            buf[(g + 1) & 1][4 + j] = *(const LAS f32x4*)(p + 256 + 4 * q); buf[(g + 1) & 1][6 + j] = *(const LAS f32x4*)(p + 320 + 4 * q); }
                    } else if (st < 3) {
#pragma unroll
                        for (int i = 0; i < 8; ++i) buf[0][i] = *(const LAS f32x4*)(p + 384 + 4 * i);
                    }
                    asm volatile("" : "+v"(y0), "+v"(z0) :: "memory");
#pragma unroll
                    for (int j = 0; j < 2; ++j) { const int q = 2 * g + j; const f32x4 r4 = buf[g & 1][j], w4 = buf[g & 1][2 + j], ka4 = buf[g & 1][4 + j], kd4 = buf[g & 1][6 + j];
                        S2[2 * q] = S2[2 * q] * w4.xy + sav * ka4.xy + vv * kd4.xy; y0 += S2[2 * q] * r4.xy;
                        S2[2 * q + 1] = S2[2 * q + 1] * w4.zw + sav * ka4.zw + vv * kd4.zw; y1 += S2[2 * q + 1] * r4.zw;
                        X2[2 * q] = X2[2 * q] * w4.xy + sxv * ka4.xy; z0 += X2[2 * q] * r4.xy;
                        X2[2 * q + 1] = X2[2 * q + 1] * w4.zw + sxv * ka4.zw; z1 += X2[2 * q + 1] * r4.zw; }
                    asm volatile("" : "+v"(y0), "+v"(y1), "+v"(z0), "+v"(z1) :: "memory");
                }
                const size_t oi = (((size_t)row * 2 + e) * 8 + h) * 64 + lane;
                Y[oi] = (y0.x + y0.y) + (y1.x + y1.y); Z[oi] = (z0.x + z0.y) + (z1.x + z1.y);
            }
        }
#undef SCAN_DMA
        float* qo = QM + (size_t)task * 4096 + lane * 64; float* po = PM + (size_t)task * 4096 + lane * 64;
#pragma unroll
        for (int q = 0; q < 16; ++q) { *(f32x4*)(qo + 4 * q) = (f32x4){S2[2 * q].x, S2[2 * q].y, S2[2 * q + 1].x, S2[2 * q + 1].y};
            *(f32x4*)(po + 4 * q) = (f32x4){X2[2 * q].x, X2[2 * q].y, X2[2 * q + 1].x, X2[2 * q + 1].y}; }
    }
}

__device__ __forceinline__ void carry_phase(KArgs a, LAS unsigned char* lds, int wave, int lane_in) {
    const int chain = blockIdx.x;
    if (chain >= NSEQ * 16) return;
    unsigned char* ws = (unsigned char*)a->ws;
    const float* QM = (const float*)(ws + WS_QM); const float* PM = (const float*)(ws + WS_PM); float* SST = (float*)(ws + WS_SST);
    const int seq = chain >> 4, e = (chain >> 3) & 1, h = chain & 7;
    const int cp0 = seq == 0 ? 0 : (SEQP / CH) + (SEQS / CH) * (seq - 1), nc = seq == 0 ? SEQP / CH : SEQS / CH;
    LAS float* ST = (LAS float*)(lds + RING_OFF); LAS float* PB = (LAS float*)(lds + RING_OFF + 16896);
    int lane = lane_in; asm volatile("" : "+v"(lane));
    const int tid = wave * 64 + lane, lr = lane & 15, quad = lane >> 4, ti = wave >> 1, tj0 = 2 * (wave & 1);
    f32x4 sreg[2] = {{0.f, 0.f, 0.f, 0.f}, {0.f, 0.f, 0.f, 0.f}};
    for (int k = tid; k < 64 * 65; k += 512) ST[k] = 0.f;
    f32x4 pn0, pn1; float qn[2][4];
    { const int cp = e ? cp0 + nc - 1 : cp0; const size_t sidx = ((size_t)cp * 2 + e) * 8 + h;
      pn0 = *(const f32x4*)(PM + sidx * 4096 + 4 * tid); pn1 = *(const f32x4*)(PM + sidx * 4096 + 2048 + 4 * tid);
#pragma unroll
      for (int t = 0; t < 2; ++t)
#pragma unroll
          for (int r = 0; r < 4; ++r) qn[t][r] = QM[sidx * 4096 + (size_t)(16 * ti + 4 * quad + r) * 64 + 16 * (tj0 + t) + lr]; }
#pragma unroll 1
    for (int c = 0; c < nc; ++c) {
        const int cp = e ? cp0 + nc - 1 - c : cp0 + c; const size_t sidx = ((size_t)cp * 2 + e) * 8 + h;
#pragma unroll
        for (int t = 0; t < 2; ++t) { const int j = 16 * (tj0 + t) + lr;
#pragma unroll
            for (int r = 0; r < 4; ++r) SST[sidx * 4096 + (size_t)((j >> 2) * 64 + 16 * ti + 4 * quad + r) * 4 + (j & 3)] = sreg[t][r]; }
        if (c == nc - 1) break;
        { const int i0 = 4 * tid, i1 = 2048 + 4 * tid; *(LAS f32x4*)(PB + (i0 >> 6) * 80 + (i0 & 63)) = pn0; *(LAS f32x4*)(PB + (i1 >> 6) * 80 + (i1 & 63)) = pn1; }
        f32x4 acc[2];
#pragma unroll
        for (int t = 0; t < 2; ++t) acc[t] = (f32x4){qn[t][0], qn[t][1], qn[t][2], qn[t][3]};
        if (c + 1 < nc - 1) { const int cpn = e ? cp0 + nc - 2 - c : cp0 + c + 1; const size_t sn = ((size_t)cpn * 2 + e) * 8 + h;
            pn0 = *(const f32x4*)(PM + sn * 4096 + 4 * tid); pn1 = *(const f32x4*)(PM + sn * 4096 + 2048 + 4 * tid);
#pragma unroll
            for (int t = 0; t < 2; ++t)
#pragma unroll
                for (int r = 0; r < 4; ++r) qn[t][r] = QM[sn * 4096 + (size_t)(16 * ti + 4 * quad + r) * 64 + 16 * (tj0 + t) + lr]; }
        __syncthreads();
#pragma unroll
        for (int kk = 0; kk < 16; ++kk) { const float a_ = ST[(16 * ti + lr) * 65 + 4 * kk + quad];
#pragma unroll
            for (int t = 0; t < 2; ++t) { const float b_ = PB[(4 * kk + quad) * 80 + 16 * (tj0 + t) + lr]; acc[t] = __builtin_amdgcn_mfma_f32_16x16x4f32(a_, b_, acc[t], 0, 0, 0); } }
        __syncthreads();
#pragma unroll
        for (int t = 0; t < 2; ++t) {
#pragma unroll
            for (int r = 0; r < 4; ++r) ST[(16 * ti + 4 * quad + r) * 65 + 16 * (tj0 + t) + lr] = acc[t][r];
            sreg[t] = acc[t]; }
    }
}

struct PostIn { float zf[4], zb[4], yv[4], rr[4], vv[4], kd[4], gt[4]; };
__device__ __forceinline__ void post_load(PostIn& q, const float* SH, const float* DIR, const float* Y, const float* Z, const bf16* G, int rowb, int h, int lane) {
#pragma unroll
    for (int u = 0; u < 4; ++u) { const int row = rowb + u; const size_t yi = (((size_t)row * 2) * 8 + h) * 64 + lane;
        q.zf[u] = Z[yi]; q.zb[u] = Z[yi + 512]; q.yv[u] = Y[yi] + Y[yi + 512];
        const float* sh = SH + ((size_t)row * 8 + h) * 192; q.rr[u] = sh[64 + lane]; q.vv[u] = sh[128 + lane];
        q.kd[u] = DIR[(((size_t)row * 2 + 0) * 8 + h) * 192 + 128 + lane] + DIR[(((size_t)row * 2 + 1) * 8 + h) * 192 + 128 + lane];
        q.gt[u] = __uint_as_float(((unsigned)G[(size_t)row * 512 + h * 64 + lane]) << 16); }
}
__device__ __forceinline__ void post_phase(KArgs a, int L, LAS unsigned char* lds, int gw, int NGW, int wave, int lane_in) {
    unsigned char* ws = (unsigned char*)a->ws;
    const float* SH = (const float*)(ws + WS_SH); const float* DIR = (const float*)(ws + WS_DIR); const float* Y = (const float*)(ws + WS_Y); const float* Z = (const float*)(ws + WS_Z);
    const float* SST = (const float*)(ws + WS_SST); const bf16* G = (const bf16*)(ws + WS_G); bf16* O = (bf16*)(ws + WS_ORWKV);
    const float* gng = ((const float*)a->in[I_GNG]) + L * 512; const float* gnb = ((const float*)a->in[I_GNB]) + L * 512; const float* rk = ((const float*)a->in[I_RK]) + L * 512;
    LAS float* zl = (LAS float*)(lds + RING_OFF + wave * 2048);
    for (int task = gw; task < NCP * 16; task += NGW) {
        int lane = lane_in; asm volatile("" : "+v"(lane));
        const int cp = task >> 4, hf = (task >> 3) & 1, h = task & 7;
        PostIn cur, nxt;
        post_load(cur, SH, DIR, Y, Z, G, cp * CH + hf * 64, h, lane);
        f32x2 Sf[32], Sb[32];
        { const float* sf = SST + (((size_t)cp * 2 + 0) * 8 + h) * 4096 + lane * 4; const float* sb = SST + (((size_t)cp * 2 + 1) * 8 + h) * 4096 + lane * 4;
#pragma unroll
          for (int q = 0; q < 16; ++q) { const f32x4 x = *(const f32x4*)(sf + q * 256), y = *(const f32x4*)(sb + q * 256); Sf[2 * q] = x.xy; Sf[2 * q + 1] = x.zw; Sb[2 * q] = y.xy; Sb[2 * q + 1] = y.zw; } }
        const float gg = gng[h * 64 + lane], gb = gnb[h * 64 + lane], rkk = rk[h * 64 + lane];
#pragma unroll 1
        for (int tb = 0; tb < 16; ++tb) {
            const int rowb = cp * CH + hf * 64 + tb * 4;
            if (tb < 15) post_load(nxt, SH, DIR, Y, Z, G, rowb + 4, h, lane);
            LDS_WAIT(); asm volatile("" ::: "memory");
#pragma unroll
            for (int u = 0; u < 4; ++u) { zl[(u * 2 + 0) * 64 + lane] = cur.zf[u]; zl[(u * 2 + 1) * 64 + lane] = cur.zb[u]; }
            LDS_WAIT(); asm volatile("" ::: "memory");
            float y[4], sbn[4];
#pragma unroll
            for (int u = 0; u < 4; ++u) {
                f32x2 c0 = {0.f, 0.f}, c1 = {0.f, 0.f};
#pragma unroll
                for (int q = 0; q < 16; ++q) { const f32x4 f4 = *(const LAS f32x4*)(zl + (u * 2 + 0) * 64 + 4 * q), b4 = *(const LAS f32x4*)(zl + (u * 2 + 1) * 64 + 4 * q);
                    c0 += Sf[2 * q] * f4.xy + Sb[2 * q] * b4.xy; c1 += Sf[2 * q + 1] * f4.zw + Sb[2 * q + 1] * b4.zw; }
                y[u] = cur.yv[u] + (c0.x + c0.y) + (c1.x + c1.y); sbn[u] = cur.rr[u] * cur.kd[u] * rkk;
            }
            float mean[4];
#pragma unroll
            for (int u = 0; u < 4; ++u) mean[u] = y[u];
#pragma unroll
            for (int o = 1; o < 64; o <<= 1)
#pragma unroll
                for (int u = 0; u < 4; ++u) { mean[u] += __shfl_xor(mean[u], o); sbn[u] += __shfl_xor(sbn[u], o); }
            float var[4];
#pragma unroll
            for (int u = 0; u < 4; ++u) { y[u] -= mean[u] * (1.f / 64.f); var[u] = y[u] * y[u]; }
#pragma unroll
            for (int o = 1; o < 64; o <<= 1)
#pragma unroll
                for (int u = 0; u < 4; ++u) var[u] += __shfl_xor(var[u], o);
#pragma unroll
            for (int u = 0; u < 4; ++u) { const float yn = y[u] * (1.f / sqrtf(var[u] * (1.f / 64.f) + GN_EPS)) * gg + gb;
                const float o = (yn + sbn[u] * cur.vv[u]) * cur.gt[u];
                O[(size_t)(rowb + u) * 512 + h * 64 + lane] = (bf16)(pk2(o, 0.f) & 0xffffu); }
            cur = nxt;
        }
    }
}

#define SEAM() do { if (a.single) { XcdBarrier b_ = bar; asm volatile("" : "+s"(b_.bar), "+s"(b_.x)); xcd_barrier(b_); } } while (0)
#ifndef PHMASK
#define PHMASK 0x1ffff
#endif
#ifndef DUPMASK
#define DUPMASK 0
#endif
#define RUN(k) ((((PHMASK) >> (k)) & 1) && a.ph_lo <= (k) && (k) < a.ph_hi)
#define REP(k) for (int rep_ = 0; rep_ < (((DUPMASK) >> (k)) & 1) + 1; ++rep_)
#define KA() KArgs ka = (KArgs)__builtin_amdgcn_kernarg_segment_ptr(); asm volatile("" : "+s"(ka)); unsigned char* ws = (unsigned char*)ka->ws; float* X = (float*)ka->out; unsigned short* XH = (unsigned short*)ka->out; unsigned short* XF = (unsigned short*)(ws + WS_GATES); (void)XH; (void)XF; bf16* XB = (bf16*)(ws + WS_XB); (void)X; (void)XB
#define IDS() KA(); const int lane = hw_lane(), wave = wave_s, tid = wave * 64 + lane, gw = blockIdx.x * NWAVES + wave, gtid = blockIdx.x * (NWAVES * 64) + tid; (void)lane; (void)gw; (void)gtid; (void)tid


template <int IT> __device__ __forceinline__ void half_layer(const Args& a, LAS unsigned char* lds, const XcdBarrier& bar, int G, int NGW, int NT, int wave_s) {
    constexpr int it = IT;
        const int L = it >> 1, s = it & 1;
        REP(0) if (s == 0 && RUN(0)) { IDS(); conv_phase(ka, L, lds, gw, NGW, wave, lane, gtid, NT); if (it == 0) prologue_phase(ka, gtid, NT); __syncthreads(); SEAM(); }
        REP(1) if (RUN(1)) {
            KA();
            pg8::Gemm g{XB, (const bf16*)(ws + WS_W1T) + (size_t)s * 2 * DFF * D, MTOK, 2 * DFF, D}; pg8::StaticOrder S; S.init(MTOK, 2 * DFF, G, (int)blockIdx.x);
            pg8::EpiSwiglu E{(bf16*)(ws + WS_H)};
            pg8::gemm_phase<pg8::EpiSwiglu, pg8::StaticOrder, true, true>(lds + RING_OFF, g, S, E, wave_s);
            SEAM();
        }
        REP(2) if (RUN(2)) {
            KA();
            pg8::Gemm g{(const bf16*)(ws + WS_H), (const bf16*)(ws + WS_W2T) + (size_t)s * D * DFF, MTOK, D, DFF}; pg8::StaticOrder S; S.init(MTOK, D, G, (int)blockIdx.x, 4);
            constexpr int pli = it == 0 ? 0 : (s == 0 ? ((L - 1) * 4 + 3) : (L * 4 + 2));
            if constexpr (it == 0) { pg8::EpiResidH<false, true, false> E{XH, XF, nullptr, (const float*)ka->in[I_XP], (const float*)ka->in[I_XS]};
                pg8::gemm_phase<pg8::EpiResidH<false, true, false>, pg8::StaticOrder, true, true>(lds + RING_OFF, g, S, E, wave_s); }
            else { constexpr bool last = (it == 2 * DEPTH - 1); pg8::EpiResidH<true, true, last> E{XH, XF, (const float*)(ws + WS_STATS), ((const float*)ka->in[I_LNG]) + pli * D, ((const float*)ka->in[I_LNB]) + pli * D};
                pg8::gemm_phase<pg8::EpiResidH<true, true, last>, pg8::StaticOrder, true, true>(lds + RING_OFF, g, S, E, wave_s); }
            SEAM();
        }
        REP(3) if (RUN(3)) { IDS(); const int li = (L * 4 + (s ? 3 : 0)) * D; if constexpr (it == 2 * DEPTH - 1) ln_phase_h<true>(XF, XB, X, ((const float*)ka->in[I_LNG]) + li, ((const float*)ka->in[I_LNB]) + li, (float*)(ws + WS_STATS), gw, NGW, lane);
            else ln_phase_h<false>(XH, XB, X, ((const float*)ka->in[I_LNG]) + li, ((const float*)ka->in[I_LNB]) + li, (float*)(ws + WS_STATS), gw, NGW, lane); SEAM(); }
        if (s == 0) {
            REP(4) if (RUN(4)) {
                KA();
                { pg8::Gemm g{XB, (const bf16*)(ws + WS_WINT), MTOK, NWIN, D}; pg8::StaticOrder S; S.init(MTOK, NWIN, G, (int)blockIdx.x);
                  pg8::EpiWin E{(bf16*)(ws + WS_UPOOL), (bf16*)(ws + WS_Q), (bf16*)(ws + WS_K), (bf16*)(ws + WS_GATES), (float*)(ws + WS_URWKV), (const float*)(ws + WS_CS), (bf16*)(ws + WS_VT)};
                  pg8::gemm_phase<pg8::EpiWin, pg8::StaticOrder, true, true>(lds + RING_OFF, g, S, E, wave_s); }
                SEAM();
            }
            REP(5) if (RUN(5)) {
                IDS();
                REP(19) prepa_phase(ka, L, gw, NGW, lane);
                SEAM();
            }
            REP(6) if (RUN(6)) {
                KA();
                pg8::Gemm g{(const bf16*)(ws + WS_AL), (const bf16*)(ws + WS_BL), MTOK, 2560, 384}; pg8::StaticOrder S; S.init(MTOK, 2560, G, (int)blockIdx.x);
                pg8::EpiLora E{((const float*)ka->in[I_W0]) + L * 1024, ((const float*)ka->in[I_A0]) + L * 1024, ((const float*)ka->in[I_KA]) + L * 512, (const float*)(ws + WS_SH), (const float*)(ws + WS_KBUF), (float*)(ws + WS_DIR), (bf16*)(ws + WS_G)};
                pg8::gemm_phase<pg8::EpiLora, pg8::StaticOrder, true, true>(lds + RING_OFF, g, S, E, wave_s);
                SEAM();
            }
            REP(7) if (RUN(7)) { IDS(); scan_phase(ka, lds, gw, NGW, wave, lane); SEAM(); }
            REP(8) if (RUN(8)) { IDS(); carry_phase(ka, lds, wave, lane); __syncthreads();
                mixq_phase(ka, L, lds, (volatile LAS unsigned*)(lds + MISC_OFF), (unsigned*)((unsigned long long)ka->ws + WS_CTL + 65536 + 256 * (L * 2 + rep_)), wave, lane); SEAM(); }
            REP(9) if (RUN(9)) { IDS(); post_phase(ka, L, lds, gw, NGW, wave, lane); SEAM(); }
            REP(10) if (RUN(10)) {
                KA();
#pragma unroll 1
                for (int b = 0; b < 3; ++b) {
                    const bf16* Ab = (const bf16*)(ws + (b == 0 ? WS_OPOOL : (b == 1 ? WS_OATT : WS_ORWKV)));
                    const bf16* Bb = (const bf16*)(ws + (b == 0 ? WS_WBR0 : (b == 1 ? WS_WBR1 : WS_WBR2)));
                    pg8::Gemm g{Ab, Bb, MTOK, D, b == 1 ? 1024 : 512}; pg8::StaticOrder S; S.init(MTOK, D, G, (int)blockIdx.x, 4);
                    pg8::EpiBranch E{(bf16*)(ws + WS_MERGED), (const bf16*)(ws + WS_GATES) + b * D, b == 0 ? 1 : 0};
                    pg8::gemm_phase<pg8::EpiBranch, pg8::StaticOrder, true, true>(lds + RING_OFF, g, S, E, wave_s);
                }
                SEAM();
            }
            REP(11) if (RUN(11)) {
                KA();
                pg8::Gemm g{(const bf16*)(ws + WS_MERGED), (const bf16*)(ws + WS_WOUT), MTOK, D, D}; pg8::StaticOrder S; S.init(MTOK, D, G, (int)blockIdx.x, 4);
                pg8::EpiResidH<true, false, false> E{XH, XF, (const float*)(ws + WS_STATS), ((const float*)ka->in[I_LNG]) + (L * 4 + 0) * D, ((const float*)ka->in[I_LNB]) + (L * 4 + 0) * D};
                pg8::gemm_phase<pg8::EpiResidH<true, false, false>, pg8::StaticOrder, true, true>(lds + RING_OFF, g, S, E, wave_s);
                SEAM();
            }
            REP(12) if (RUN(12)) { IDS(); const int li = (L * 4 + 1) * D; ln_phase_h<false>(XH, XB, X, ((const float*)ka->in[I_LNG]) + li, ((const float*)ka->in[I_LNB]) + li, (float*)(ws + WS_STATS), gw, NGW, lane); SEAM(); }
            REP(13) if (RUN(13)) {
                KA();
                static_assert((WS_XB & (MiB - 1)) == 0 && (WS_WQ & (MiB - 1)) == 0 && (WS_MEMB & (MiB - 1)) == 0 && (WS_WKV & (MiB - 1)) == 0 && WS_MEMB < WS_WKV && WS_WKV < WS_XB, "XqOrder indexes 1-MiB operand tiles of d_ws");
                pg8::Gemm g{(const bf16*)ws, (const bf16*)ws, 0, 0, D}; pg8::XqOrder S{G, (int)blockIdx.x};
                pg8::EpiXq E{(bf16*)(ws + WS_QX), (bf16*)(ws + WS_KX), (bf16*)(ws + WS_VXT)};
                pg8::gemm_phase<pg8::EpiXq, pg8::XqOrder, true, true>(lds + RING_OFF, g, S, E, wave_s);
                SEAM();
            }
            REP(14) if (RUN(14)) { IDS(); xattn_phase(ka, lds, wave, lane); SEAM(); }
            REP(15) if (RUN(15)) {
                KA();
                pg8::Gemm g{(const bf16*)(ws + WS_OX), (const bf16*)(ws + WS_WO), MTOK, D, 512}; pg8::StaticOrder S; S.init(MTOK, D, G, (int)blockIdx.x, 4);
                pg8::EpiResidH<true, false, false> E{XH, XF, (const float*)(ws + WS_STATS), ((const float*)ka->in[I_LNG]) + (L * 4 + 1) * D, ((const float*)ka->in[I_LNB]) + (L * 4 + 1) * D};
                pg8::gemm_phase<pg8::EpiResidH<true, false, false>, pg8::StaticOrder, true, true>(lds + RING_OFF, g, S, E, wave_s);
                SEAM();
            }
            REP(16) if (RUN(16)) { IDS(); const int li = (L * 4 + 2) * D; ln_phase_h<false>(XH, XB, X, ((const float*)ka->in[I_LNG]) + li, ((const float*)ka->in[I_LNB]) + li, (float*)(ws + WS_STATS), gw, NGW, lane); SEAM(); }
        }
}

__global__ void __launch_bounds__(NWAVES * 64, 2) fwd_kernel(Args a) {
    extern __shared__ __attribute__((aligned(16))) unsigned char lds_raw[];
    LAS unsigned char* lds = (LAS unsigned char*)lds_raw;
    volatile LAS unsigned* MISC = (volatile LAS unsigned*)(lds + MISC_OFF);
    const int G = gridDim.x, NGW = G * NWAVES, NT = G * NWAVES * 64, wave_s = __builtin_amdgcn_readfirstlane((int)threadIdx.x >> 6);
    { const int t0 = wave_s * 64 + hw_lane(); for (int u = t0; u < (LDS_BYTES - LDSCTL_OFF) / 4; u += NWAVES * 64) ((LAS unsigned*)(lds + LDSCTL_OFF))[u] = 0u; }
    __syncthreads();
    unsigned* const barw = (unsigned*)((unsigned long long)a.ws + WS_CTL + 4096 * 4);
    XcdBarrier bar; bar.bar = barw; bar.x = 0; bar.st = nullptr; bar.wv = (unsigned)wave_s;
    if (a.single) bar = xcd_barrier_post(barw, MISC + 8, (unsigned)wave_s);
    if (0 >= a.it_lo && 0 < a.it_hi) half_layer<0>(a, lds, bar, G, NGW, NT, wave_s);
    if (1 >= a.it_lo && 1 < a.it_hi) half_layer<1>(a, lds, bar, G, NGW, NT, wave_s);
    if (2 >= a.it_lo && 2 < a.it_hi) half_layer<2>(a, lds, bar, G, NGW, NT, wave_s);
    if (3 >= a.it_lo && 3 < a.it_hi) half_layer<3>(a, lds, bar, G, NGW, NT, wave_s);
    if (4 >= a.it_lo && 4 < a.it_hi) half_layer<4>(a, lds, bar, G, NGW, NT, wave_s);
    if (5 >= a.it_lo && 5 < a.it_hi) half_layer<5>(a, lds, bar, G, NGW, NT, wave_s);
    if (6 >= a.it_lo && 6 < a.it_hi) half_layer<6>(a, lds, bar, G, NGW, NT, wave_s);
    if (7 >= a.it_lo && 7 < a.it_hi) half_layer<7>(a, lds, bar, G, NGW, NT, wave_s);
}
#undef SEAM
#undef RUN

#ifndef MK_SINGLE
#define MK_SINGLE 1
#endif
extern "C" void kernel_launch(void* const* d_in, const int* in_sizes, int n_in, void* d_out, int out_size, void* d_ws, size_t ws_size, hipStream_t stream) {
    static int grid = 0;
    if (grid == 0) {
        if (n_in != 28 || out_size != MTOK * D || ws_size < WS_END) { fprintf(stderr, "kernel_launch: unexpected problem (n_in %d, out %d, ws %zu < %zu); nothing launched\n", n_in, out_size, ws_size, (size_t)WS_END); grid = -1; return; }
        int dev = 0, cus = 0, per_cu = 0;
        if (hipGetDevice(&dev) != hipSuccess || hipDeviceGetAttribute(&cus, hipDeviceAttributeMultiprocessorCount, dev) != hipSuccess) { grid = -1; return; }
        if (hipFuncSetAttribute((const void*)fwd_kernel, hipFuncAttributeMaxDynamicSharedMemorySize, LDS_BYTES) != hipSuccess) { fprintf(stderr, "kernel_launch: hipFuncSetAttribute failed\n"); grid = -1; return; }
        if (hipOccupancyMaxActiveBlocksPerMultiprocessor(&per_cu, (const void*)fwd_kernel, NWAVES * 64, LDS_BYTES) != hipSuccess || per_cu < 1) { fprintf(stderr, "kernel_launch: occupancy query says %d blocks per CU; nothing launched\n", per_cu); (void)hipGetLastError(); grid = -1; return; }
        grid = cus;
    }
    if (grid < 0) return;
    (void)hipMemsetAsync((char*)d_ws + WS_CTL, 0, CTL_ZERO_BYTES, stream);
    Args a{};
    for (int i = 0; i < 28; ++i) a.in[i] = (const GAS float*)d_in[i];
    a.out = (GAS float*)d_out; a.ws = (GAS unsigned char*)d_ws; a.pad = 0;
#if MK_SINGLE
    a.it_lo = 0; a.it_hi = 2 * DEPTH; a.ph_lo = 0; a.ph_hi = 17; a.single = 1;
    hipLaunchKernelGGL(fwd_kernel, dim3(grid), dim3(NWAVES * 64), LDS_BYTES, stream, a);
#else
    a.single = 0;
    for (int it = 0; it < 2 * DEPTH; ++it)
        for (int ph = 0; ph < 17; ++ph) {
            if ((it & 1) && (ph == 0 || ph > 3)) continue;
            a.it_lo = it; a.it_hi = it + 1; a.ph_lo = ph; a.ph_hi = ph + 1;
            hipLaunchKernelGGL(fwd_kernel, dim3(grid), dim3(NWAVES * 64), LDS_BYTES, stream, a);
        }
#endif
}
```
